# Optimizing an MI355X kernel written in HIP

```python
import math
import jax, jax.numpy as jnp
from jax import lax
import numpy as np

D_MODEL = 1024
BATCH = 4
SEQ = 4096
DEPTH = 4

GRID_W = 64
CTX_LEN = 256
N_MIXERS = 3
Q_BLOCK = 128
NORM_EPS = 1e-6
ROPE_THETA = 10000.0
NEG_INF = -1e30

A_HEADS = 16
A_KV_HEADS = 4
A_REP = A_HEADS // A_KV_HEADS
HEAD_DIM = 64
B_HEADS = 16
WIN_R = 8
WIN_C = 16
C_HEADS = 16
Q_LORA = 384
KV_LORA = 256
NOPE_DIM = 64
ROPE_DIM = 32
V_DIM = 64
D_FF = 2816
N_EXPERTS = 8
TOP_K = 2
D_FF_EXPERT = 3584

kernel_name = 'hybrid_dit_gqa_natten_mla_moe'


def _rmsnorm(x, g):
    xf = x.astype(jnp.float32)
    y = xf * lax.rsqrt(jnp.mean(xf * xf, axis=-1, keepdims=True) + NORM_EPS)
    return (y * g.astype(jnp.float32)).astype(x.dtype)


def _modulate(h, shift, scale):
    return h * (1 + scale) + shift


def _adaln(cvec, w_mod, b_mod):
    return jnp.split(jax.nn.silu(cvec) @ w_mod + b_mod, 6, axis=-1)


def _rope_1d(x, pos):
    half = x.shape[-1] // 2
    inv_freq = jnp.exp(-math.log(ROPE_THETA) * jnp.arange(half, dtype=jnp.float32) / half)
    ang = pos.astype(jnp.float32)[:, None] * inv_freq[None, :]
    cos, sin = jnp.cos(ang), jnp.sin(ang)
    xf = x.astype(jnp.float32)
    x1, x2 = xf[..., :half], xf[..., half:]
    return jnp.concatenate([x1 * cos - x2 * sin, x1 * sin + x2 * cos], axis=-1).astype(x.dtype)


def _rope_2d(x, rows, cols):
    h = x.shape[-1] // 2
    return jnp.concatenate([_rope_1d(x[..., :h], rows), _rope_1d(x[..., h:], cols)], axis=-1)


def _block_attention(q, k, v):
    B, G, R, T, dk = q.shape
    dv = v.shape[-1]
    nb = T // Q_BLOCK
    scale = dk ** -0.5
    qb = jnp.moveaxis(q.reshape(B, G, R, nb, Q_BLOCK, dk), 3, 0)

    def one_block(qi):
        s = jnp.einsum('bgrqd,bgkd->bgrqk', qi, k, preferred_element_type=jnp.float32) * scale
        p = jax.nn.softmax(s, axis=-1)
        return jnp.einsum('bgrqk,bgkd->bgrqd', p.astype(v.dtype), v)

    o = lax.map(one_block, qb)
    return jnp.moveaxis(o, 0, 3).reshape(B, G, R, T, dv)


def _gqa_project(h, w_qkv, q_gain, k_gain):
    B, N, _ = h.shape
    q, k, v = jnp.split(h @ w_qkv, [A_HEADS * HEAD_DIM, (A_HEADS + A_KV_HEADS) * HEAD_DIM], axis=-1)
    q = _rmsnorm(q.reshape(B, N, A_KV_HEADS, A_REP, HEAD_DIM), q_gain).transpose(0, 2, 3, 1, 4)
    k = _rmsnorm(k.reshape(B, N, A_KV_HEADS, HEAD_DIM), k_gain).transpose(0, 2, 1, 3)
    v = v.reshape(B, N, A_KV_HEADS, HEAD_DIM).transpose(0, 2, 1, 3)
    return q, k, v


def _gqa_mixer(h_lat, h_ctx, rows, cols, need_ctx, w_qkv, q_gain, k_gain, w_o):
    B, T, _ = h_lat.shape
    q_l, k_l, v_l = _gqa_project(h_lat, w_qkv, q_gain, k_gain)
    q_l = _rope_2d(q_l, rows, cols)
    k_l = _rope_2d(k_l, rows, cols)
    q_c, k_c, v_c = _gqa_project(h_ctx, w_qkv, q_gain, k_gain)
    k_all = jnp.concatenate([k_c, k_l], axis=2)
    v_all = jnp.concatenate([v_c, v_l], axis=2)
    o_l = _block_attention(q_l, k_all, v_all)
    o_l = o_l.transpose(0, 3, 1, 2, 4).reshape(B, T, A_HEADS * HEAD_DIM) @ w_o
    o_c = None
    if need_ctx:
        n_ctx = h_ctx.shape[1]
        o_c = _block_attention(q_c, k_c, v_c)
        o_c = o_c.transpose(0, 3, 1, 2, 4).reshape(B, n_ctx, A_HEADS * HEAD_DIM) @ w_o
    return o_l, o_c


def _mha_project(h, w_qkv, q_gain, k_gain):
    B, N, _ = h.shape
    q, k, v = jnp.split(h @ w_qkv, 3, axis=-1)
    q = _rmsnorm(q.reshape(B, N, B_HEADS, HEAD_DIM), q_gain).transpose(0, 2, 1, 3)
    k = _rmsnorm(k.reshape(B, N, B_HEADS, HEAD_DIM), k_gain).transpose(0, 2, 1, 3)
    v = v.reshape(B, N, B_HEADS, HEAD_DIM).transpose(0, 2, 1, 3)
    return q, k, v


def _natten_mixer(h_lat, h_ctx, need_ctx, w_qkv, q_gain, k_gain, rel_bias, w_o):
    B, T, _ = h_lat.shape
    rows_n = T // GRID_W
    wr = min(WIN_R, rows_n)
    scale = HEAD_DIM ** -0.5
    q_l, k_l, v_l = _mha_project(h_lat, w_qkv, q_gain, k_gain)
    q_c, k_c, v_c = _mha_project(h_ctx, w_qkv, q_gain, k_gain)
    n_ctx = k_c.shape[2]
    kg = k_l.reshape(B, B_HEADS, rows_n, GRID_W, HEAD_DIM)
    vg = v_l.reshape(B, B_HEADS, rows_n, GRID_W, HEAD_DIM)
    qg = jnp.moveaxis(q_l.reshape(B, B_HEADS, rows_n, GRID_W, HEAD_DIM), 2, 0)
    col = jnp.arange(GRID_W, dtype=jnp.int32)
    c0 = jnp.clip(col - WIN_C // 2, 0, GRID_W - WIN_C)
    col_ok = (col[None, :] >= c0[:, None]) & (col[None, :] < c0[:, None] + WIN_C)
    col_idx = jnp.clip(col[None, :] - col[:, None] + WIN_C - 1, 0, 2 * WIN_C - 2)
    band_ok = jnp.tile(col_ok, (1, wr))

    def one_row(args):
        r, qr = args
        r0 = jnp.clip(r - wr // 2, 0, rows_n - wr)
        kr = lax.dynamic_slice_in_dim(kg, r0, wr, axis=2).reshape(B, B_HEADS, wr * GRID_W, HEAD_DIM)
        vr = lax.dynamic_slice_in_dim(vg, r0, wr, axis=2).reshape(B, B_HEADS, wr * GRID_W, HEAD_DIM)
        row_idx = r0 + jnp.arange(wr, dtype=jnp.int32) - r + WIN_R - 1
        bias = rel_bias[:, row_idx][:, :, col_idx]
        bias = bias.transpose(0, 2, 1, 3).reshape(B_HEADS, GRID_W, wr * GRID_W).astype(jnp.float32)
        s_l = jnp.einsum('bhqd,bhkd->bhqk', qr, kr, preferred_element_type=jnp.float32) * scale + bias
        s_l = jnp.where(band_ok, s_l, NEG_INF)
        s_c = jnp.einsum('bhqd,bhkd->bhqk', qr, k_c, preferred_element_type=jnp.float32) * scale
        p = jax.nn.softmax(jnp.concatenate([s_c, s_l], axis=-1), axis=-1).astype(v_l.dtype)
        return (jnp.einsum('bhqk,bhkd->bhqd', p[..., :n_ctx], v_c)
                + jnp.einsum('bhqk,bhkd->bhqd', p[..., n_ctx:], vr))

    o = lax.map(one_row, (jnp.arange(rows_n, dtype=jnp.int32), qg))
    o_l = o.transpose(1, 0, 3, 2, 4).reshape(B, T, B_HEADS * HEAD_DIM) @ w_o
    o_c = None
    if need_ctx:
        o_c = _block_attention(q_c[:, :, None], k_c, v_c)[:, :, 0]
        o_c = o_c.transpose(0, 2, 1, 3).reshape(B, n_ctx, B_HEADS * HEAD_DIM) @ w_o
    return o_l, o_c


def _mla_project(h, w_in, g_dq, g_dkv, w_uq, w_ukv, q_gain, k_gain):
    B, N, _ = h.shape
    cq, ckv, kr = jnp.split(h @ w_in, [Q_LORA, Q_LORA + KV_LORA], axis=-1)
    q = (_rmsnorm(cq, g_dq) @ w_uq).reshape(B, N, C_HEADS, NOPE_DIM + ROPE_DIM)
    kv = (_rmsnorm(ckv, g_dkv) @ w_ukv).reshape(B, N, C_HEADS, NOPE_DIM + V_DIM)
    k_nope, v = jnp.split(kv, [NOPE_DIM], axis=-1)
    q_nope = _rmsnorm(q[..., :NOPE_DIM], q_gain[:NOPE_DIM]).transpose(0, 2, 1, 3)
    q_rope = _rmsnorm(q[..., NOPE_DIM:], q_gain[NOPE_DIM:]).transpose(0, 2, 1, 3)
    k_nope = _rmsnorm(k_nope, k_gain[:NOPE_DIM]).transpose(0, 2, 1, 3)
    k_rope = _rmsnorm(kr, k_gain[NOPE_DIM:])
    return q_nope, q_rope, k_nope, k_rope, v.transpose(0, 2, 1, 3)


def _mla_assemble(q_nope, q_rope, k_nope, k_rope):
    q = jnp.concatenate([q_nope, q_rope], axis=-1)[:, :, None]
    k_rope_h = jnp.broadcast_to(k_rope[:, None], k_nope.shape[:-1] + (ROPE_DIM,))
    k = jnp.concatenate([k_nope, k_rope_h], axis=-1)
    return q, k


def _mla_mixer(h_lat, h_ctx, rows, cols, need_ctx, w_in, g_dq, g_dkv, w_uq, w_ukv, q_gain, k_gain, w_o):
    B, T, _ = h_lat.shape
    qn_l, qr_l, kn_l, kr_l, v_l = _mla_project(h_lat, w_in, g_dq, g_dkv, w_uq, w_ukv, q_gain, k_gain)
    qn_c, qr_c, kn_c, kr_c, v_c = _mla_project(h_ctx, w_in, g_dq, g_dkv, w_uq, w_ukv, q_gain, k_gain)
    q_l, k_l = _mla_assemble(qn_l, _rope_2d(qr_l, rows, cols), kn_l, _rope_2d(kr_l, rows, cols))
    q_c, k_c = _mla_assemble(qn_c, qr_c, kn_c, kr_c)
    k_all = jnp.concatenate([k_c, k_l], axis=2)
    v_all = jnp.concatenate([v_c, v_l], axis=2)
    o_l = _block_attention(q_l, k_all, v_all)[:, :, 0]
    o_l = o_l.transpose(0, 2, 1, 3).reshape(B, T, C_HEADS * V_DIM) @ w_o
    o_c = None
    if need_ctx:
        n_ctx = h_ctx.shape[1]
        o_c = _block_attention(q_c, k_c, v_c)[:, :, 0]
        o_c = o_c.transpose(0, 2, 1, 3).reshape(B, n_ctx, C_HEADS * V_DIM) @ w_o
    return o_l, o_c


def _swiglu(h, w_gu, w_down):
    g, u = jnp.split(h @ w_gu, 2, axis=-1)
    return (jax.nn.silu(g) * u) @ w_down


def _moe(h, w_router, we_gu, we_down):
    shape = h.shape
    t = h.reshape(-1, shape[-1])
    logits = jnp.dot(t, w_router, preferred_element_type=jnp.float32)
    top_val, top_idx = lax.top_k(logits, TOP_K)
    top_w = jax.nn.softmax(top_val, axis=-1)
    combine = jnp.einsum('nk,nke->ne', top_w,
                         jax.nn.one_hot(top_idx, N_EXPERTS, dtype=jnp.float32)).astype(h.dtype)
    out = jnp.zeros_like(t)
    for e in range(N_EXPERTS):
        out = out + combine[:, e:e + 1] * _swiglu(t, we_gu[e], we_down[e])
    return out.reshape(shape)


def setup_inputs(seed: int = 0) -> dict:
    key = jax.random.key(seed)
    keys = jax.random.split(key, 96)
    counter = iter(range(96))

    def rnd(shape, scale):
        return jax.random.normal(keys[next(counter)], shape, jnp.float32) * scale

    def gain(n):
        return 1.0 + rnd((n,), 0.05)

    D = D_MODEL
    inp = {}
    inp['x'] = rnd((BATCH, SEQ, D), 1.0)
    inp['c'] = rnd((BATCH, D), 1.0)
    inp['ctx'] = rnd((BATCH, CTX_LEN, D), 1.0)
    inp['c_ctx'] = rnd((D,), 1.0)
    for i in range(DEPTH):
        p = 'l%d_' % i
        inp[p + 'w_mod'] = rnd((D, 6 * D), 0.5 * D ** -0.5)
        inp[p + 'b_mod'] = rnd((6 * D,), 0.02)
        inp[p + 'g_mix'] = gain(D)
        inp[p + 'g_ffn'] = gain(D)
        kind = i % N_MIXERS
        if kind == 0:
            inp[p + 'w_qkv'] = rnd((D, (A_HEADS + 2 * A_KV_HEADS) * HEAD_DIM), D ** -0.5)
            inp[p + 'q_gain'] = gain(HEAD_DIM)
            inp[p + 'k_gain'] = gain(HEAD_DIM)
            inp[p + 'w_o'] = rnd((A_HEADS * HEAD_DIM, D), (A_HEADS * HEAD_DIM) ** -0.5)
        elif kind == 1:
            inp[p + 'w_qkv'] = rnd((D, 3 * B_HEADS * HEAD_DIM), D ** -0.5)
            inp[p + 'q_gain'] = gain(HEAD_DIM)
            inp[p + 'k_gain'] = gain(HEAD_DIM)
            inp[p + 'rel_bias'] = rnd((B_HEADS, 2 * WIN_R - 1, 2 * WIN_C - 1), 0.2)
            inp[p + 'w_o'] = rnd((B_HEADS * HEAD_DIM, D), (B_HEADS * HEAD_DIM) ** -0.5)
        else:
            inp[p + 'w_in'] = rnd((D, Q_LORA + KV_LORA + ROPE_DIM), D ** -0.5)
            inp[p + 'g_dq'] = gain(Q_LORA)
            inp[p + 'g_dkv'] = gain(KV_LORA)
            inp[p + 'w_uq'] = rnd((Q_LORA, C_HEADS * (NOPE_DIM + ROPE_DIM)), Q_LORA ** -0.5)
            inp[p + 'w_ukv'] = rnd((KV_LORA, C_HEADS * (NOPE_DIM + V_DIM)), KV_LORA ** -0.5)
            inp[p + 'q_gain'] = gain(NOPE_DIM + ROPE_DIM)
            inp[p + 'k_gain'] = gain(NOPE_DIM + ROPE_DIM)
            inp[p + 'w_o'] = rnd((C_HEADS * V_DIM, D), (C_HEADS * V_DIM) ** -0.5)
        if i % 2 == 0:
            inp[p + 'w_gu'] = rnd((D, 2 * D_FF), D ** -0.5)
            inp[p + 'w_down'] = rnd((D_FF, D), D_FF ** -0.5)
        else:
            inp[p + 'w_router'] = rnd((D, N_EXPERTS), D ** -0.5)
            inp[p + 'we_gu'] = rnd((N_EXPERTS, D, 2 * D_FF_EXPERT), D ** -0.5)
            inp[p + 'we_down'] = rnd((N_EXPERTS, D_FF_EXPERT, D), D_FF_EXPERT ** -0.5)
    return inp


def reference(x, c, ctx, c_ctx,
              l0_w_mod, l0_b_mod, l0_g_mix, l0_g_ffn, l0_w_qkv, l0_q_gain, l0_k_gain, l0_w_o, l0_w_gu, l0_w_down,
              l1_w_mod, l1_b_mod, l1_g_mix, l1_g_ffn, l1_w_qkv, l1_q_gain, l1_k_gain, l1_rel_bias, l1_w_o,
              l1_w_router, l1_we_gu, l1_we_down,
              l2_w_mod, l2_b_mod, l2_g_mix, l2_g_ffn, l2_w_in, l2_g_dq, l2_g_dkv, l2_w_uq, l2_w_ukv, l2_q_gain,
              l2_k_gain, l2_w_o, l2_w_gu, l2_w_down,
              l3_w_mod, l3_b_mod, l3_g_mix, l3_g_ffn, l3_w_qkv, l3_q_gain, l3_k_gain, l3_w_o,
              l3_w_router, l3_we_gu, l3_we_down):
    layers = [
        dict(w_mod=l0_w_mod, b_mod=l0_b_mod, g_mix=l0_g_mix, g_ffn=l0_g_ffn,
             mix=dict(w_qkv=l0_w_qkv, q_gain=l0_q_gain, k_gain=l0_k_gain, w_o=l0_w_o),
             ffn=dict(w_gu=l0_w_gu, w_down=l0_w_down)),
        dict(w_mod=l1_w_mod, b_mod=l1_b_mod, g_mix=l1_g_mix, g_ffn=l1_g_ffn,
             mix=dict(w_qkv=l1_w_qkv, q_gain=l1_q_gain, k_gain=l1_k_gain, rel_bias=l1_rel_bias, w_o=l1_w_o),
             ffn=dict(w_router=l1_w_router, we_gu=l1_we_gu, we_down=l1_we_down)),
        dict(w_mod=l2_w_mod, b_mod=l2_b_mod, g_mix=l2_g_mix, g_ffn=l2_g_ffn,
             mix=dict(w_in=l2_w_in, g_dq=l2_g_dq, g_dkv=l2_g_dkv, w_uq=l2_w_uq, w_ukv=l2_w_ukv,
                      q_gain=l2_q_gain, k_gain=l2_k_gain, w_o=l2_w_o),
             ffn=dict(w_gu=l2_w_gu, w_down=l2_w_down)),
        dict(w_mod=l3_w_mod, b_mod=l3_b_mod, g_mix=l3_g_mix, g_ffn=l3_g_ffn,
             mix=dict(w_qkv=l3_w_qkv, q_gain=l3_q_gain, k_gain=l3_k_gain, w_o=l3_w_o),
             ffn=dict(w_router=l3_w_router, we_gu=l3_we_gu, we_down=l3_we_down)),
    ]
    T = x.shape[1]
    pos = jnp.arange(T, dtype=jnp.int32)
    rows = pos // GRID_W
    cols = pos % GRID_W
    x_lat, x_ctx = x, ctx
    for i in range(DEPTH):
        p = layers[i]
        need_ctx = i < DEPTH - 1
        sh1, sc1, g1, sh2, sc2, g2 = [m[:, None, :] for m in _adaln(c, p['w_mod'], p['b_mod'])]
        csh1, csc1, cg1, csh2, csc2, cg2 = _adaln(c_ctx, p['w_mod'], p['b_mod'])
        h_lat = _modulate(_rmsnorm(x_lat, p['g_mix']), sh1, sc1)
        h_ctx = _modulate(_rmsnorm(x_ctx, p['g_mix']), csh1, csc1)
        kind = i % N_MIXERS
        if kind == 0:
            o_lat, o_ctx = _gqa_mixer(h_lat, h_ctx, rows, cols, need_ctx, **p['mix'])
        elif kind == 1:
            o_lat, o_ctx = _natten_mixer(h_lat, h_ctx, need_ctx, **p['mix'])
        else:
            o_lat, o_ctx = _mla_mixer(h_lat, h_ctx, rows, cols, need_ctx, **p['mix'])
        x_lat = x_lat + g1 * o_lat
        channel = _swiglu if i % 2 == 0 else _moe
        h2_lat = _modulate(_rmsnorm(x_lat, p['g_ffn']), sh2, sc2)
        if need_ctx:
            x_ctx = x_ctx + cg1 * o_ctx
            h2_ctx = _modulate(_rmsnorm(x_ctx, p['g_ffn']), csh2, csc2)
            n_ctx = x_ctx.shape[1]
            f = channel(jnp.concatenate([h2_ctx, h2_lat], axis=1), **p['ffn'])
            x_ctx = x_ctx + cg2 * f[:, :n_ctx]
            x_lat = x_lat + g2 * f[:, n_ctx:]
        else:
            x_lat = x_lat + g2 * channel(h2_lat, **p['ffn'])
    return x_lat
```

```cpp
#include <hip/hip_runtime.h>
#include <cstdio>
#include <cstdint>

#ifndef N_LAUNCH_MODE
#define N_LAUNCH_MODE 0
#endif

constexpr int D = 1024, NB = 4, SEQ = 4096, NCTX = 256, SB = SEQ + NCTX  , M = NB * SB  ;
constexpr int NHEAD = 16, HD = 64;
constexpr int FF = 2816, FFE = 3584, NEXP = 8;
constexpr int QLORA = 384, KVLORA = 256, MLA_QK = 96;
constexpr int MAXSLOT = 36864;
constexpr float EPS = 1e-6f;
constexpr float LOG2E = 1.4426950408889634f;
constexpr float C2_64 = 0.125f * LOG2E;
constexpr float C2_96 = 0.10206207261596575f * LOG2E;

constexpr size_t MiB = 1u << 20;
constexpr size_t WS_CTL = 0, CTL_BYTES = 1 * MiB;
constexpr size_t WS_MOD = 1 * MiB;
constexpr size_t WS_ROPE = WS_MOD + 512 * 1024;
constexpr size_t WS_ROUTE = 2 * MiB;
constexpr size_t WS_X = 3 * MiB;
constexpr size_t WS_H = 71 * MiB;
constexpr size_t WS_HP = 105 * MiB;
constexpr size_t WS_ATT = 177 * MiB;
constexpr size_t WS_RAW = WS_ATT;
constexpr size_t WS_QB = WS_ATT + 166 * MiB;
constexpr size_t WS_KB = WS_QB + 51 * MiB;
constexpr size_t WS_VB = WS_KB + 51 * MiB;
constexpr size_t WS_O = WS_VB + 34 * MiB;
constexpr size_t WS_ACT = WS_ATT;
constexpr size_t WS_W = 513 * MiB;
constexpr size_t WS_WE = 571 * MiB;
constexpr size_t WS_END = WS_WE + 2 * 168 * MiB;
constexpr size_t RAW_IN = WS_RAW;
constexpr size_t RAW_CQ = RAW_IN + (size_t)M * 768 * 2;
constexpr size_t RAW_CKV = RAW_CQ + (size_t)M * 384 * 2;
constexpr size_t RAW_Q = RAW_CKV + (size_t)M * 256 * 2;
constexpr size_t RAW_KV = RAW_Q + (size_t)M * 1536 * 2;
static_assert(RAW_KV + (size_t)M * 2048 * 2 <= WS_QB, "raw region");
static_assert(WS_ACT + (size_t)MAXSLOT * FFE * 2 <= WS_W, "act overlay");
constexpr size_t W_QKV0 = WS_W, W_QKV1 = W_QKV0 + 3 * MiB, W_IN = W_QKV1 + 6 * MiB, W_UQ = W_IN + 3 * MiB / 2, W_UKV = W_UQ + 1179648, W_QKV3 = W_UKV + 1 * MiB;
constexpr size_t W_O = W_QKV3 + 3 * MiB;
constexpr size_t W_GU = W_O + 8 * MiB;
constexpr size_t W_DN = W_GU + 22 * MiB;
static_assert(W_DN + 11 * MiB <= WS_WE, "dense weights");
constexpr size_t WE_GU(int i) { return WS_WE + (size_t)i * 168 * MiB; }
constexpr size_t WE_DN(int i) { return WS_WE + (size_t)i * 168 * MiB + 112 * MiB; }
constexpr int CW_CNT = 64;
constexpr int CW_BAR = 4096;

#define LAS __attribute__((address_space(3)))
typedef unsigned short bf16;
typedef float f32x4 __attribute__((ext_vector_type(4)));
typedef float f32x16 __attribute__((ext_vector_type(16)));
typedef short bf16x8 __attribute__((ext_vector_type(8)));
typedef unsigned u32x4 __attribute__((ext_vector_type(4)));
typedef unsigned u32x2 __attribute__((ext_vector_type(2)));
#define DI __device__ __forceinline__
DI float bf2f(unsigned v) { return __uint_as_float(v << 16); }
DI unsigned f2bf(float f) { unsigned u = __float_as_uint(f); return (u + 0x7fffu + ((u >> 16) & 1u)) >> 16; }
DI unsigned pk2(float lo, float hi) { return f2bf(lo) | (f2bf(hi) << 16); }
DI float wave_sum(float v) {
#pragma unroll
    for (int o = 1; o < 64; o <<= 1) v += __shfl_xor(v, o);
    return v;
}
DI void unpack8(const u32x4 w, float* f) {
    f[0] = bf2f(w.x & 0xffffu); f[1] = bf2f(w.x >> 16); f[2] = bf2f(w.y & 0xffffu); f[3] = bf2f(w.y >> 16);
    f[4] = bf2f(w.z & 0xffffu); f[5] = bf2f(w.z >> 16); f[6] = bf2f(w.w & 0xffffu); f[7] = bf2f(w.w >> 16);
}
DI u32x4 pack8(const float* f) { u32x4 w; w.x = pk2(f[0], f[1]); w.y = pk2(f[2], f[3]); w.z = pk2(f[4], f[5]); w.w = pk2(f[6], f[7]); return w; }

#define XB_TMO      128
#define XB_XCNT(j)  (256  + 64 * (j))
#define XB_XSUB(j)  (1280 + 64 * (j))
#define XB_XGEN(j)  (2304 + 64 * (j))
#define XB_TOP      3328
#define XB_TOPGEN   3392
#define XCD_BAR_WORDS 3456
#define XB_SPIN_CAP (1u << 18)
DI unsigned xb_ld(unsigned* p)              { return __hip_atomic_load(p, __ATOMIC_RELAXED, __HIP_MEMORY_SCOPE_AGENT); }
DI unsigned xb_add(unsigned* p, unsigned v) { return __hip_atomic_fetch_add(p, v, __ATOMIC_RELAXED, __HIP_MEMORY_SCOPE_AGENT); }
DI unsigned xb_xcc_id() { return (unsigned)__builtin_amdgcn_s_getreg((3 << 11) | 20) & 0xFu; }
#define XB_SPIN(cond, bar) do { unsigned _sp = 0; while (cond) { __builtin_amdgcn_s_sleep(1); \
    if ((++_sp & 255u) == 0u) { if (xb_ld(&(bar)[XB_TMO])) break; if (_sp > XB_SPIN_CAP) { atomicAdd(&(bar)[XB_TMO], 1u); break; } } } } while (0)
struct XcdBarrier { unsigned* bar; unsigned x; volatile LAS unsigned* st; };
DI XcdBarrier xcd_barrier_post(unsigned* bar, volatile LAS unsigned* st) {
    XcdBarrier b; b.bar = bar; b.x = xb_xcc_id(); b.st = st;
    if (threadIdx.x == 0) (void)xb_add(&bar[XB_XCNT(b.x)], 1u);
    return b;
}
DI void xcd_barrier_complete(unsigned* bar, unsigned x, unsigned& nloc, unsigned& nx) {
    const unsigned G = gridDim.x * gridDim.y * gridDim.z;
    unsigned sum, cnt, mine, sp = 0u;
    for (;;) {
        sum = 0u; cnt = 0u; mine = 0u;
#pragma unroll
        for (unsigned j = 0; j < 16; ++j) { const unsigned c = xb_ld(&bar[XB_XCNT(j)]); sum += c; cnt += (c > 0u) ? 1u : 0u; mine = (j == x) ? c : mine; }
        if (sum == G) break;
        __builtin_amdgcn_s_sleep(1);
        if ((++sp & 255u) == 0u) { if (xb_ld(&bar[XB_TMO])) break; if (sp > XB_SPIN_CAP) { atomicAdd(&bar[XB_TMO], 1u); break; } }
    }
    nloc = mine > 0u ? mine : 1u; nx = cnt > 0u ? cnt : 1u;
}
DI void xcd_barrier(const XcdBarrier& b) {
    asm volatile("s_waitcnt vmcnt(0)" ::: "memory");
    __syncthreads();
    if (threadIdx.x == 0) {
        unsigned* bar = b.bar;
        __builtin_amdgcn_s_waitcnt(0);
        unsigned nloc = b.st[0], nx = b.st[1];
        if (nloc == 0u) { xcd_barrier_complete(bar, b.x, nloc, nx); b.st[0] = nloc; b.st[1] = nx; }
        const unsigned old = xb_add(&bar[XB_XSUB(b.x)], 1u);
        const unsigned gen = old / nloc;
        if (old + 1u == (gen + 1u) * nloc) {
            __builtin_amdgcn_fence(__ATOMIC_RELEASE, "agent");
            asm volatile("s_waitcnt vmcnt(0)" ::: "memory");
            const unsigned og = xb_add(&bar[XB_TOP], 1u);
            const unsigned tg = og / nx;
            if (og + 1u == (tg + 1u) * nx) xb_add(&bar[XB_TOPGEN], 1u);
            else XB_SPIN(xb_ld(&bar[XB_TOPGEN]) == tg, bar);
            __builtin_amdgcn_fence(__ATOMIC_ACQUIRE, "agent");
            xb_add(&bar[XB_XGEN(b.x)], 1u);
            asm volatile("s_waitcnt vmcnt(0)" ::: "memory");
        } else {
            XB_SPIN(xb_ld(&bar[XB_XGEN(b.x)]) == gen, bar);
            __builtin_amdgcn_fence(__ATOMIC_ACQUIRE, "agent");
            asm volatile("s_waitcnt vmcnt(0)" ::: "memory");
        }
    }
    __syncthreads();
}

constexpr int NJOBS = 18;
struct Job { const float* src; unsigned long long dst_off; int K, N, Nd, nb, mode, item0; };
struct Args {
    const float* x; const float* c; const float* ctx; const float* cctx;
    const float* w_mod[4]; const float* b_mod[4]; const float* g_mix[4]; const float* g_ffn[4];
    const float* q_gain[4]; const float* k_gain[4]; const float* w_router[4];
    const float* rel_bias; const float* g_dq; const float* g_dkv;
    float* out; unsigned char* ws;
    Job jobs[NJOBS];
    int n_items; int lo; int hi; int pad;
};

struct Frame {
    LAS unsigned char* lds;
    int tid, lane, wave, gw, NGW;
    unsigned char* ws;
    float* MOD; float* X; bf16* H;
};
DI void refresh(Frame& F) { int t = threadIdx.x; asm volatile("" : "+v"(t)); F.tid = t; F.lane = t & 63; F.wave = __builtin_amdgcn_readfirstlane(t >> 6); F.gw = blockIdx.x * 8 + F.wave; }
DI int row_mod_idx(int m) { const int b = m / SB, p = m - b * SB; return p < NCTX ? 4 : b; }

DI void conv_item(const Args& a, Frame& F, LAS float* scr, int item) {
    int j = 0;
#pragma unroll 1
    for (int t = 1; t < NJOBS; ++t) if (item >= a.jobs[t].item0) j = t;
    const Job jb = a.jobs[j];
    const int it = item - jb.item0, nblk = jb.N / 32, kb = it / nblk, nbk = it % nblk;
    const int k0g = 64 * kb, n0 = 32 * nbk, e = k0g / jb.K, k0 = k0g - e * jb.K;
    const float* W = jb.src + (size_t)k0g * jb.N + n0;
    const int lane = F.lane;
#pragma unroll 8
    for (int i = 0; i < 32; ++i) { const int kk = 2 * i + (lane >> 5); scr[kk * 33 + (lane & 31)] = W[(size_t)kk * jb.N + (lane & 31)]; }
    asm volatile("s_waitcnt lgkmcnt(0)" ::: "memory");
    int drow = n0;
    if (jb.mode == 1) { const int Fh = jb.N / 2; if (n0 < Fh) drow = (n0 / 128) * 256 + (n0 % 128); else { const int n1 = n0 - Fh; drow = (n1 / 128) * 256 + 128 + (n1 % 128); } }
    bf16* dst = (bf16*)(a.ws + jb.dst_off) + ((size_t)e * jb.Nd + drow) * jb.K + k0;
    const int c = lane & 7;
#pragma unroll
    for (int jj = 0; jj < 4; ++jj) { const int n = (lane >> 3) + 8 * jj; const LAS float* s = scr + (8 * c) * 33 + n;
        u32x4 o; o.x = pk2(s[0 * 33], s[1 * 33]); o.y = pk2(s[2 * 33], s[3 * 33]); o.z = pk2(s[4 * 33], s[5 * 33]); o.w = pk2(s[6 * 33], s[7 * 33]);
        *(u32x4*)(dst + (size_t)n * jb.K + 8 * c) = o; }
    asm volatile("s_waitcnt lgkmcnt(0)" ::: "memory");
}
DI float silu_f(float v) { return v / (1.f + __expf(-v)); }
DI void p0_prologue(const Args& a, Frame& F) {
    refresh(F);
    LAS float* red = (LAS float*)F.lds;
    for (int it = blockIdx.x; it < 4 * 96; it += gridDim.x) {
        const int l = it / 96, j0 = (it % 96) * 64;
        const float* wm = a.w_mod[l] + (size_t)(128 * F.wave) * 6144 + j0 + F.lane;
        float acc[5] = {0.f, 0.f, 0.f, 0.f, 0.f};
#pragma unroll 4
        for (int k = 0; k < 128; ++k) {
            const float w = wm[(size_t)k * 6144]; const int kk = 128 * F.wave + k;
#pragma unroll
            for (int s = 0; s < 4; ++s) acc[s] += silu_f(a.c[s * 1024 + kk]) * w;
            acc[4] += silu_f(a.cctx[kk]) * w;
        }
#pragma unroll
        for (int s = 0; s < 5; ++s) red[(F.wave * 5 + s) * 64 + F.lane] = acc[s];
        __syncthreads();
        if (F.tid < 320) { const int s = F.tid >> 6, ln = F.tid & 63; float t = a.b_mod[l][j0 + ln];
#pragma unroll
            for (int w = 0; w < 8; ++w) t += red[(w * 5 + s) * 64 + ln];
            F.MOD[((size_t)l * 5 + s) * 6144 + j0 + ln] = t; }
        __syncthreads();
    }
    if (blockIdx.x == 0) {
        float* R64 = (float*)(a.ws + WS_ROPE); float* R32 = R64 + 64 * 16 * 2;
        for (int t = F.tid; t < 64 * 16; t += 512) { const int pos = t >> 4, i = t & 15; const float f = expf(-9.210340371976184f * (float)i / 16.f), ang = (float)pos * f; R64[2 * t] = cosf(ang); R64[2 * t + 1] = sinf(ang); }
        for (int t = F.tid; t < 64 * 8; t += 512) { const int pos = t >> 3, i = t & 7; const float f = expf(-9.210340371976184f * (float)i / 8.f), ang = (float)pos * f; R32[2 * t] = cosf(ang); R32[2 * t + 1] = sinf(ang); }
    }
    { u32x4* z = (u32x4*)(a.ws + W_IN + (size_t)672 * 1024 * 2); const int n16 = 96 * 1024 * 2 / 16;
      for (int t = blockIdx.x * 512 + F.tid; t < n16; t += gridDim.x * 512) z[t] = (u32x4){0u, 0u, 0u, 0u}; }
    __syncthreads();
    LAS float* scr = (LAS float*)(F.lds + F.wave * 16384);
    for (int it = F.gw; it < a.n_items; it += F.NGW) conv_item(a, F, scr, it);
}

template <bool ROUTE>
DI void norm_rows(const Args& a, Frame& F, int l, int which  , bool first, bool skip_ctx, int moe_idx) {
    refresh(F);
    const float* gvec = which == 0 ? a.g_mix[l] : a.g_ffn[l];
    f32x4 g[4];
#pragma unroll
    for (int j = 0; j < 4; ++j) g[j] = *(const f32x4*)(gvec + 4 * F.lane + 256 * j);
    for (int m = F.gw; m < M; m += F.NGW) {
        const int b = m / SB, p = m - b * SB; const bool isctx = p < NCTX;
        if (skip_ctx && isctx) continue;
        const float* src = first ? (isctx ? a.ctx + ((size_t)b * NCTX + p) * D : a.x + ((size_t)b * SEQ + (p - NCTX)) * D) : F.X + (size_t)m * D;
        f32x4 v[4]; float ss = 0.f;
#pragma unroll
        for (int j = 0; j < 4; ++j) { v[j] = *(const f32x4*)(src + 4 * F.lane + 256 * j); ss += (v[j].x * v[j].x + v[j].y * v[j].y) + (v[j].z * v[j].z + v[j].w * v[j].w); }
        if (first) {
#pragma unroll
            for (int j = 0; j < 4; ++j) *(f32x4*)(F.X + (size_t)m * D + 4 * F.lane + 256 * j) = v[j];
        }
        const float rstd = 1.0f / sqrtf(wave_sum(ss) * (1.f / D) + EPS);
        const float* md = F.MOD + ((size_t)l * 5 + (isctx ? 4 : b)) * 6144 + (which ? 3072 : 0);
        f32x4 hv[4];
#pragma unroll
        for (int j = 0; j < 4; ++j) { const f32x4 sh = *(const f32x4*)(md + 4 * F.lane + 256 * j), sc = *(const f32x4*)(md + 1024 + 4 * F.lane + 256 * j);
            hv[j] = (v[j] * rstd) * g[j] * (1.f + sc) + sh;
            u32x2 o; o.x = pk2(hv[j].x, hv[j].y); o.y = pk2(hv[j].z, hv[j].w);
            *(u32x2*)(F.H + (size_t)m * D + 4 * F.lane + 256 * j) = o; }
        if (ROUTE) {
            float lg[8] = {0.f, 0.f, 0.f, 0.f, 0.f, 0.f, 0.f, 0.f}; const float* wr = a.w_router[l];
#pragma unroll
            for (int j = 0; j < 4; ++j)
#pragma unroll
                for (int i = 0; i < 4; ++i) { const int k = 4 * F.lane + 256 * j + i; const f32x4 w0 = *(const f32x4*)(wr + (size_t)k * 8), w1 = *(const f32x4*)(wr + (size_t)k * 8 + 4); const float hx = hv[j][i];
                    lg[0] += hx * w0.x; lg[1] += hx * w0.y; lg[2] += hx * w0.z; lg[3] += hx * w0.w; lg[4] += hx * w1.x; lg[5] += hx * w1.y; lg[6] += hx * w1.z; lg[7] += hx * w1.w; }
#pragma unroll
            for (int e = 0; e < 8; ++e) lg[e] = wave_sum(lg[e]);
            int e0 = 0; float v0 = lg[0];
#pragma unroll
            for (int e = 1; e < 8; ++e) if (lg[e] > v0) { v0 = lg[e]; e0 = e; }
            int e1 = -1; float v1 = -INFINITY;
#pragma unroll
            for (int e = 0; e < 8; ++e) if (e != e0 && lg[e] > v1) { v1 = lg[e]; e1 = e; }
            const float ex = __expf(v1 - v0), w0 = 1.f / (1.f + ex), w1 = ex / (1.f + ex);
            if (F.lane == 0) {
                unsigned* cnt = (unsigned*)(a.ws + WS_CTL) + CW_CNT + 64 * moe_idx;
                const unsigned p0 = atomicAdd(cnt + e0, 1u), p1 = atomicAdd(cnt + e1, 1u);
                int* r = (int*)(a.ws + WS_ROUTE) + (size_t)m * 8;
                r[0] = e0; r[1] = e1; r[2] = (int)p0; r[3] = (int)p1; r[4] = __float_as_int(w0); r[5] = __float_as_int(w1);
            }
        }
    }
}

struct MoeOff { int o[9]; };
DI MoeOff moe_offsets(const Args& a, int moe_idx) {
    const unsigned* cnt = (const unsigned*)(a.ws + WS_CTL) + CW_CNT + 64 * moe_idx;
    MoeOff r; r.o[0] = 0;
#pragma unroll
    for (int e = 0; e < 8; ++e) { const int c = (int)__builtin_amdgcn_readfirstlane((int)__hip_atomic_load(cnt + e, __ATOMIC_RELAXED, __HIP_MEMORY_SCOPE_AGENT)); r.o[e + 1] = r.o[e] + ((c + 255) & ~255); }
    return r;
}
DI int moe_off_of(const MoeOff& mo, int e) { int r = 0;
#pragma unroll
    for (int i = 1; i < 8; ++i) if (e >= i) r = mo.o[i];
    return r; }
DI int moe_expert_of_slot(const MoeOff& mo, int slot) { int e = 0;
#pragma unroll
    for (int i = 1; i < 8; ++i) if (slot >= mo.o[i]) e = i;
    return e; }

DI void moe_gather(const Args& a, Frame& F, int moe_idx, bool skip_ctx) {
    refresh(F);
    const MoeOff mo = moe_offsets(a, moe_idx);
    bf16* HP = (bf16*)(a.ws + WS_HP);
    for (int it = F.gw; it < 2 * M; it += F.NGW) {
        const int m = it >> 1, k = it & 1; const int p = m % SB; if (skip_ctx && p < NCTX) continue;
        const int* r = (const int*)(a.ws + WS_ROUTE) + (size_t)m * 8;
        const int e = r[k], pos = r[2 + k]; const int slot = moe_off_of(mo, e) + pos;
        const u32x4* s = (const u32x4*)(F.H + (size_t)m * D); u32x4* d = (u32x4*)(HP + (size_t)slot * D);
        d[F.lane] = s[F.lane]; d[F.lane + 64] = s[F.lane + 64];
    }
}
DI void moe_combine(const Args& a, Frame& F, int l, int moe_idx) {
    refresh(F);
    const MoeOff mo = moe_offsets(a, moe_idx);
    const bf16* Y = (const bf16*)(a.ws + WS_HP);
    const bool last = (l == 3);
    f32x4 g[4];
#pragma unroll
    for (int j = 0; j < 4; ++j) g[j] = last ? (f32x4){0.f, 0.f, 0.f, 0.f} : *(const f32x4*)(a.g_mix[l + 1] + 4 * F.lane + 256 * j);
    for (int m = F.gw; m < M; m += F.NGW) {
        const int b = m / SB, p = m - b * SB; const bool isctx = p < NCTX;
        if (last && isctx) continue;
        const int* r = (const int*)(a.ws + WS_ROUTE) + (size_t)m * 8;
        const int s0 = moe_off_of(mo, r[0]) + r[2], s1 = moe_off_of(mo, r[1]) + r[3]; const float w0 = __int_as_float(r[4]), w1 = __int_as_float(r[5]);
        const float* md = F.MOD + ((size_t)l * 5 + (isctx ? 4 : b)) * 6144 + 5 * 1024;
        f32x4 v[4]; float ss = 0.f;
#pragma unroll
        for (int j = 0; j < 4; ++j) { const int col = 4 * F.lane + 256 * j;
            const u32x2 y0 = *(const u32x2*)(Y + (size_t)s0 * D + col), y1 = *(const u32x2*)(Y + (size_t)s1 * D + col);
            const f32x4 g2 = *(const f32x4*)(md + col); const f32x4 xv = *(const f32x4*)(F.X + (size_t)m * D + col);
            f32x4 f; f.x = w0 * bf2f(y0.x & 0xffffu) + w1 * bf2f(y1.x & 0xffffu); f.y = w0 * bf2f(y0.x >> 16) + w1 * bf2f(y1.x >> 16);
            f.z = w0 * bf2f(y0.y & 0xffffu) + w1 * bf2f(y1.y & 0xffffu); f.w = w0 * bf2f(y0.y >> 16) + w1 * bf2f(y1.y >> 16);
            v[j] = xv + g2 * f; ss += (v[j].x * v[j].x + v[j].y * v[j].y) + (v[j].z * v[j].z + v[j].w * v[j].w); }
        if (last) {
            float* o = a.out + ((size_t)b * SEQ + (p - NCTX)) * D;
#pragma unroll
            for (int j = 0; j < 4; ++j) *(f32x4*)(o + 4 * F.lane + 256 * j) = v[j];
        } else {
#pragma unroll
            for (int j = 0; j < 4; ++j) *(f32x4*)(F.X + (size_t)m * D + 4 * F.lane + 256 * j) = v[j];
            const float rstd = 1.0f / sqrtf(wave_sum(ss) * (1.f / D) + EPS);
            const float* md2 = F.MOD + ((size_t)(l + 1) * 5 + (isctx ? 4 : b)) * 6144;
#pragma unroll
            for (int j = 0; j < 4; ++j) { const f32x4 sh = *(const f32x4*)(md2 + 4 * F.lane + 256 * j), sc = *(const f32x4*)(md2 + 1024 + 4 * F.lane + 256 * j);
                const f32x4 hv = (v[j] * rstd) * g[j] * (1.f + sc) + sh; u32x2 o; o.x = pk2(hv.x, hv.y); o.y = pk2(hv.z, hv.w);
                *(u32x2*)(F.H + (size_t)m * D + 4 * F.lane + 256 * j) = o; }
        }
    }
}

DI void load16(const bf16* p, float* v) { const u32x4 a = *(const u32x4*)p, b = *(const u32x4*)(p + 8); unpack8(a, v); unpack8(b, v + 8); }
DI void store16(bf16* p, const float* v) { *(u32x4*)p = pack8(v); *(u32x4*)(p + 8) = pack8(v + 8); }
DI void rms64_gain(float* v, const float* gain, int part) {
    float ss = 0.f;
#pragma unroll
    for (int i = 0; i < 16; ++i) ss += v[i] * v[i];
    ss += __shfl_xor(ss, 1); ss += __shfl_xor(ss, 2);
    const float r = 1.0f / sqrtf(ss * (1.f / 64.f) + EPS);
#pragma unroll
    for (int i = 0; i < 16; ++i) v[i] = v[i] * r * gain[part * 16 + i];
}
DI void rope64(float* v, const float* R64, int part, int gr, int gc) {
    const int pos = part < 2 ? gr : gc; const float* cs = R64 + pos * 32;
#pragma unroll
    for (int i = 0; i < 16; ++i) { const float other = __shfl_xor(v[i], 1); const float c = cs[2 * i], s = cs[2 * i + 1];
        v[i] = (part & 1) ? (other * s + v[i] * c) : (v[i] * c - other * s); }
}
DI void rms32_rope(float* v, const float* gain  , int part, bool do_rope, const float* R32, int gr, int gc) {
    float ss = 0.f;
#pragma unroll
    for (int i = 0; i < 16; ++i) ss += v[i] * v[i];
    ss += __shfl_xor(ss, 1);
    const float r = 1.0f / sqrtf(ss * (1.f / 32.f) + EPS);
#pragma unroll
    for (int i = 0; i < 16; ++i) v[i] = v[i] * r * gain[part * 16 + i];
    if (do_rope) { const int pos = part == 0 ? gr : gc; const float* cs = R32 + pos * 16;
#pragma unroll
        for (int i = 0; i < 8; ++i) { const float c = cs[2 * i], s = cs[2 * i + 1]; const float x1 = v[i], x2 = v[i + 8]; v[i] = x1 * c - x2 * s; v[i + 8] = x1 * s + x2 * c; } }
}
DI void prep_rows(const Args& a, Frame& F, int l, int kind) {
    refresh(F);
    const float* R64 = (const float*)(a.ws + WS_ROPE); const float* R32 = R64 + 64 * 16 * 2;
    const float* qg = a.q_gain[l]; const float* kg = a.k_gain[l];
    bf16* QB = (bf16*)(a.ws + WS_QB); bf16* KB = (bf16*)(a.ws + WS_KB); bf16* VB = (bf16*)(a.ws + WS_VB);
    const int lane = F.lane, part = lane & 3;
    for (int m = F.gw; m < M; m += F.NGW) {
        const int p = m % SB; const bool isctx = p < NCTX; const int t = isctx ? 0 : p - NCTX; const int gr = t >> 6, gc = t & 63;
        float v[16];
        if (kind == 0) {
            const bf16* raw = (const bf16*)(a.ws + WS_RAW) + (size_t)m * 1536;
            load16(raw + lane * 16, v); rms64_gain(v, qg, part); if (!isctx) rope64(v, R64, part, gr, gc);
#pragma unroll
            for (int i = 0; i < 16; ++i) v[i] *= C2_64;
            store16(QB + (size_t)m * 1024 + lane * 16, v);
            const int l16 = lane & 15;
            load16(raw + 1024 + l16 * 16, v); rms64_gain(v, kg, part); if (!isctx) rope64(v, R64, part, gr, gc);
            if (lane < 16) store16(KB + (size_t)m * 256 + l16 * 16, v);
            if (lane >= 16 && lane < 32) { const u32x4* s = (const u32x4*)(raw + 1280 + l16 * 16); u32x4* d = (u32x4*)(VB + (size_t)m * 256 + l16 * 16); d[0] = s[0]; d[1] = s[1]; }
        } else if (kind == 1) {
            const bf16* raw = (const bf16*)(a.ws + WS_RAW) + (size_t)m * 3072;
            load16(raw + lane * 16, v); rms64_gain(v, qg, part);
#pragma unroll
            for (int i = 0; i < 16; ++i) v[i] *= C2_64;
            store16(QB + (size_t)m * 1024 + lane * 16, v);
            load16(raw + 1024 + lane * 16, v); rms64_gain(v, kg, part); store16(KB + (size_t)m * 1024 + lane * 16, v);
            { const u32x4* s = (const u32x4*)(raw + 2048 + lane * 16); u32x4* d = (u32x4*)(VB + (size_t)m * 1024 + lane * 16); d[0] = s[0]; d[1] = s[1]; }
        } else {
            const bf16* qraw = (const bf16*)(a.ws + RAW_Q) + (size_t)m * 1536; const bf16* kvraw = (const bf16*)(a.ws + RAW_KV) + (size_t)m * 2048; const bf16* rin = (const bf16*)(a.ws + RAW_IN) + (size_t)m * 768;
            const int h = lane >> 2;
            load16(qraw + h * 96 + part * 16, v); rms64_gain(v, qg, part);
#pragma unroll
            for (int i = 0; i < 16; ++i) v[i] *= C2_96;
            store16(QB + (size_t)m * 1536 + h * 96 + part * 16, v);
            { const int h2 = (lane >> 1) & 15, p2 = lane & 1;
              load16(qraw + h2 * 96 + 64 + p2 * 16, v); rms32_rope(v, qg + 64, p2, !isctx, R32, gr, gc);
#pragma unroll
              for (int i = 0; i < 16; ++i) v[i] *= C2_96;
              if (lane < 32) store16(QB + (size_t)m * 1536 + h2 * 96 + 64 + p2 * 16, v); }
            load16(kvraw + h * 128 + part * 16, v); rms64_gain(v, kg, part); store16(KB + (size_t)m * 1536 + h * 96 + part * 16, v);
            { const u32x4* s = (const u32x4*)(kvraw + h * 128 + 64 + part * 16); u32x4* d = (u32x4*)(VB + (size_t)m * 1024 + h * 64 + part * 16); d[0] = s[0]; d[1] = s[1]; }
            { const int h2 = (lane >> 1) & 15, p2 = lane & 1;
              load16(rin + 640 + p2 * 16, v); rms32_rope(v, kg + 64, p2, !isctx, R32, gr, gc);
              if (lane < 32) store16(KB + (size_t)m * 1536 + h2 * 96 + 64 + p2 * 16, v); }
        }
    }
}
DI void mla_mid(const Args& a, Frame& F) {
    refresh(F);
    const int lane = F.lane;
    for (int m = F.gw; m < M; m += F.NGW) {
        const bf16* rin = (const bf16*)(a.ws + RAW_IN) + (size_t)m * 768;
        const unsigned* q3 = (const unsigned*)(rin + 6 * lane); float q[6]; float ss = 0.f;
#pragma unroll
        for (int i = 0; i < 3; ++i) { const unsigned w = q3[i]; q[2 * i] = bf2f(w & 0xffffu); q[2 * i + 1] = bf2f(w >> 16); }
#pragma unroll
        for (int i = 0; i < 6; ++i) ss += q[i] * q[i];
        float r = 1.0f / sqrtf(wave_sum(ss) * (1.f / 384.f) + EPS);
        unsigned* oq = (unsigned*)((bf16*)(a.ws + RAW_CQ) + (size_t)m * 384 + 6 * lane);
#pragma unroll
        for (int i = 0; i < 3; ++i) oq[i] = pk2(q[2 * i] * r * a.g_dq[6 * lane + 2 * i], q[2 * i + 1] * r * a.g_dq[6 * lane + 2 * i + 1]);
        const u32x2 kw = *(const u32x2*)(rin + 384 + 4 * lane); float k[4] = {bf2f(kw.x & 0xffffu), bf2f(kw.x >> 16), bf2f(kw.y & 0xffffu), bf2f(kw.y >> 16)};
        ss = k[0] * k[0] + k[1] * k[1] + k[2] * k[2] + k[3] * k[3];
        r = 1.0f / sqrtf(wave_sum(ss) * (1.f / 256.f) + EPS);
        u32x2 ok; ok.x = pk2(k[0] * r * a.g_dkv[4 * lane], k[1] * r * a.g_dkv[4 * lane + 1]); ok.y = pk2(k[2] * r * a.g_dkv[4 * lane + 2], k[3] * r * a.g_dkv[4 * lane + 3]);
        *(u32x2*)((bf16*)(a.ws + RAW_CKV) + (size_t)m * 256 + 4 * lane) = ok;
    }
}

DI int crow(int r, int hi) { return (r & 3) + 8 * (r >> 2) + 4 * hi; }
struct EpiRaw { bf16* O; int ldc; DI void operator()(int row, int col, float v) const { O[(size_t)row * ldc + col] = (bf16)f2bf(v); } };
struct EpiRes { float* X; const float* MOD; int l; int gsel  ; bool skip_ctx;
    DI void operator()(int row, int col, float v) const { const int b = row / SB, p = row - b * SB; const bool isctx = p < NCTX; if (skip_ctx && isctx) return;
        const float g = MOD[((size_t)l * 5 + (isctx ? 4 : b)) * 6144 + gsel * 1024 + col]; X[(size_t)row * D + col] += g * v; } };
template <class Epi>
DI void sgemm(Frame& F, const bf16* A, const bf16* Bt, int Mrows, int N, int K, const Epi& E) {
    refresh(F);
    const int lane = F.lane, r = lane & 31, hi = lane >> 5; const int ntn = N / 32, ntiles = (Mrows / 32) * ntn;
    for (int it = F.gw; it < ntiles; it += F.NGW) {
        const int mt = it / ntn, nt = it % ntn;
        const bf16* ap = A + (size_t)(mt * 32 + r) * K + 8 * hi; const bf16* bp = Bt + (size_t)(nt * 32 + r) * K + 8 * hi;
        f32x16 acc = {};
#pragma unroll 4
        for (int k0 = 0; k0 < K; k0 += 16) acc = __builtin_amdgcn_mfma_f32_32x32x16_bf16(*(const bf16x8*)(ap + k0), *(const bf16x8*)(bp + k0), acc, 0, 0, 0);
#pragma unroll
        for (int i = 0; i < 16; ++i) E(mt * 32 + crow(i, hi), nt * 32 + r, acc[i]);
    }
}
DI float swiglu_f(float g, float u) { return g / (1.f + __expf(-g)) * u; }
DI void sgemm_swiglu(const Args& a, Frame& F, const bf16* A, const bf16* BtBase, int Mrows, int Fh, int K, bf16* ACT, bool grouped, const MoeOff& mo) {
    refresh(F);
    const int lane = F.lane, r = lane & 31, hi = lane >> 5; const int ntn = Fh / 32, ntiles = (Mrows / 32) * ntn;
    for (int it = F.gw; it < ntiles; it += F.NGW) {
        const int mt = it / ntn, nt = it % ntn, f0 = nt * 32;
        const bf16* Bt = BtBase; if (grouped) Bt += (size_t)moe_expert_of_slot(mo, mt * 32) * (2 * Fh) * K;
        const int grow = (f0 / 128) * 256 + (f0 % 128);
        const bf16* ap = A + (size_t)(mt * 32 + r) * K + 8 * hi; const bf16* bg = Bt + (size_t)(grow + r) * K + 8 * hi; const bf16* bu = bg + (size_t)128 * K;
        f32x16 ag = {}, au = {};
#pragma unroll 2
        for (int k0 = 0; k0 < K; k0 += 16) { const bf16x8 av = *(const bf16x8*)(ap + k0);
            ag = __builtin_amdgcn_mfma_f32_32x32x16_bf16(av, *(const bf16x8*)(bg + k0), ag, 0, 0, 0);
            au = __builtin_amdgcn_mfma_f32_32x32x16_bf16(av, *(const bf16x8*)(bu + k0), au, 0, 0, 0); }
#pragma unroll
        for (int i = 0; i < 16; ++i) ACT[(size_t)(mt * 32 + crow(i, hi)) * Fh + f0 + r] = (bf16)f2bf(swiglu_f(ag[i], au[i]));
    }
}
DI void sgemm_moe_down(Frame& F, const bf16* A, const bf16* BtBase, int Mrows, int K, bf16* Y, const MoeOff& mo) {
    refresh(F);
    const int lane = F.lane, r = lane & 31, hi = lane >> 5; const int ntn = D / 32, ntiles = (Mrows / 32) * ntn;
    for (int it = F.gw; it < ntiles; it += F.NGW) {
        const int mt = it / ntn, nt = it % ntn;
        const bf16* Bt = BtBase + (size_t)moe_expert_of_slot(mo, mt * 32) * D * K;
        const bf16* ap = A + (size_t)(mt * 32 + r) * K + 8 * hi; const bf16* bp = Bt + (size_t)(nt * 32 + r) * K + 8 * hi;
        f32x16 acc = {};
#pragma unroll 4
        for (int k0 = 0; k0 < K; k0 += 16) acc = __builtin_amdgcn_mfma_f32_32x32x16_bf16(*(const bf16x8*)(ap + k0), *(const bf16x8*)(bp + k0), acc, 0, 0, 0);
#pragma unroll
        for (int i = 0; i < 16; ++i) Y[(size_t)(mt * 32 + crow(i, hi)) * D + nt * 32 + r] = (bf16)f2bf(acc[i]);
    }
}

template <int DK>
DI float dot_k(const unsigned* q, const bf16* kp) {
    float s = 0.f;
#pragma unroll
    for (int c = 0; c < DK / 8; ++c) { float kf[8]; unpack8(*(const u32x4*)(kp + 8 * c), kf);
#pragma unroll
        for (int i = 0; i < 4; ++i) { const unsigned w = q[4 * c + i]; s += bf2f(w & 0xffffu) * kf[2 * i]; s += bf2f(w >> 16) * kf[2 * i + 1]; } }
    return s;
}
DI void acc_v(float* o, float alpha, float pw, const bf16* vp) {
#pragma unroll
    for (int c = 0; c < 8; ++c) { float vf[8]; unpack8(*(const u32x4*)(vp + 8 * c), vf);
#pragma unroll
        for (int i = 0; i < 8; ++i) o[8 * c + i] = o[8 * c + i] * alpha + pw * vf[i]; }
}
template <int DK, int KIND>
DI void attn_naive(const Args& a, Frame& F, bool need_ctx) {
    refresh(F);
    const bf16* QB = (const bf16*)(a.ws + WS_QB); const bf16* KB = (const bf16*)(a.ws + WS_KB); const bf16* VB = (const bf16*)(a.ws + WS_VB); bf16* O = (bf16*)(a.ws + WS_O);
    constexpr int QP = NHEAD * DK, KP = KIND == 0 ? 256 : NHEAD * DK, VP = KIND == 0 ? 256 : 1024;
    const int nlat = NB * NHEAD * SEQ, nctx = need_ctx ? NB * NHEAD * NCTX : 0;
    const int gt = blockIdx.x * 512 + F.tid, NT = gridDim.x * 512;
    for (int it = gt; it < nlat + nctx; it += NT) {
        int b, h, p; bool isctx;
        if (it < nlat) { b = it / (NHEAD * SEQ); h = (it / SEQ) % NHEAD; p = NCTX + it % SEQ; isctx = false; }
        else { const int j = it - nlat; b = j / (NHEAD * NCTX); h = (j / NCTX) % NHEAD; p = j % NCTX; isctx = true; }
        const int m = b * SB + p; const int kvh = KIND == 0 ? h / 4 : h;
        unsigned q[DK / 2];
#pragma unroll
        for (int c = 0; c < DK / 8; ++c) { const u32x4 w = *(const u32x4*)(QB + (size_t)m * QP + h * DK + 8 * c); q[4 * c] = w.x; q[4 * c + 1] = w.y; q[4 * c + 2] = w.z; q[4 * c + 3] = w.w; }
        float o[64];
#pragma unroll
        for (int i = 0; i < 64; ++i) o[i] = 0.f;
        float mx = -INFINITY, lsum = 0.f;
        const bf16* kb0 = KB + (size_t)b * SB * KP + kvh * DK; const bf16* vb0 = VB + (size_t)b * SB * VP + kvh * 64;
        const int nk1 = (isctx || KIND == 1) ? NCTX : SB;
        for (int k = 0; k < nk1; ++k) {
            const float s = dot_k<DK>(q, kb0 + (size_t)k * KP); const float mn = fmaxf(mx, s), al = exp2f(mx - mn), pw = exp2f(s - mn);
            lsum = lsum * al + pw; mx = mn; acc_v(o, al, pw, vb0 + (size_t)k * VP);
        }
        if (KIND == 1 && !isctx) {
            const int t = p - NCTX, gr = t >> 6, gc = t & 63; const int r0 = min(max(gr - 4, 0), 56), c0 = min(max(gc - 8, 0), 48);
            const float* bias = a.rel_bias + h * 15 * 31;
            for (int kr = r0; kr < r0 + 8; ++kr) for (int kc = c0; kc < c0 + 16; ++kc) {
                const int k = NCTX + kr * 64 + kc;
                const float s = dot_k<DK>(q, kb0 + (size_t)k * KP) + bias[(kr - gr + 7) * 31 + (kc - gc + 15)] * LOG2E;
                const float mn = fmaxf(mx, s), al = exp2f(mx - mn), pw = exp2f(s - mn);
                lsum = lsum * al + pw; mx = mn; acc_v(o, al, pw, vb0 + (size_t)k * VP);
            }
        }
        const float inv = 1.f / lsum;
#pragma unroll
        for (int c = 0; c < 8; ++c) { float t8[8];
#pragma unroll
            for (int i = 0; i < 8; ++i) t8[i] = o[8 * c + i] * inv;
            *(u32x4*)(O + (size_t)m * 1024 + h * 64 + 8 * c) = pack8(t8); }
    }
}

constexpr int LDS_BYTES = 147456;
constexpr int MISC_OFF = 131072 + 320;
enum { PJ_NORM1 = 0, PJ_QKV = 1, PJ_MLAMID = 2, PJ_MLAUP = 3, PJ_PREP = 4, PJ_ATTN = 5, PJ_WO = 6, PJ_NORM2 = 7, PJ_GATHER = 8, PJ_GU = 9, PJ_DOWN = 10, PJ_COMBINE = 11 };
__host__ __device__ constexpr int pid_of(int l, int j) { return 1 + 16 * l + j; }
__host__ __device__ inline bool phase_exists(int l, int j) {
    const int kind = l % 3; const bool moe = (l & 1) != 0;
    switch (j) {
        case PJ_NORM1: return l == 0 || l == 1 || l == 3;
        case PJ_MLAMID: case PJ_MLAUP: return kind == 2;
        case PJ_GATHER: case PJ_COMBINE: return moe;
        case PJ_QKV: case PJ_PREP: case PJ_ATTN: case PJ_WO: case PJ_NORM2: case PJ_GU: case PJ_DOWN: return true;
        default: return false;
    }
}

__global__ void __launch_bounds__(512, 2) fwd_kernel(Args a) {
    extern __shared__ __attribute__((aligned(16))) unsigned char lds_raw[];
    Frame F;
    F.lds = (LAS unsigned char*)lds_raw;
    F.tid = threadIdx.x; F.lane = F.tid & 63; F.wave = __builtin_amdgcn_readfirstlane(F.tid >> 6);
    F.gw = blockIdx.x * 8 + F.wave; F.NGW = gridDim.x * 8;
    F.ws = a.ws; F.MOD = (float*)(a.ws + WS_MOD); F.X = (float*)(a.ws + WS_X); F.H = (bf16*)(a.ws + WS_H);
    volatile LAS unsigned* MISC = (volatile LAS unsigned*)(F.lds + MISC_OFF);
    if (F.tid < 32) MISC[F.tid] = 0u;
    __syncthreads();
    const int lo = a.lo, hi = a.hi;
    const bool one_launch = (hi - lo) > 1;
    XcdBarrier bar; bar.bar = (unsigned*)(a.ws + WS_CTL) + CW_BAR; bar.x = 0; bar.st = nullptr;
    if (one_launch) bar = xcd_barrier_post((unsigned*)(a.ws + WS_CTL) + CW_BAR, MISC + 8);
#define IN(k) (lo <= (k) && (k) < hi)
#define SEAM(k) do { if (one_launch && IN(k) && (k) + 1 < hi) xcd_barrier(bar); } while (0)

    if (IN(0)) { p0_prologue(a, F); } SEAM(0);

#pragma unroll 1
    for (int l = 0; l < 4; ++l) {
        const int kind = l % 3; const bool moe = (l & 1) != 0; const bool need_ctx = l < 3; const int moe_idx = l >> 1;
        const int P = 1 + 16 * l;
        if (l != 2) { if (IN(P + PJ_NORM1)) norm_rows<false>(a, F, l, 0, l == 0, false, 0); SEAM(P + PJ_NORM1); }
        if (IN(P + PJ_QKV)) {
            const int N = kind == 0 ? 1536 : (kind == 1 ? 3072 : 768);
            const bf16* Wt = (const bf16*)(a.ws + (l == 0 ? W_QKV0 : l == 1 ? W_QKV1 : l == 2 ? W_IN : W_QKV3));
            EpiRaw E{(bf16*)(a.ws + WS_RAW), N};
            sgemm(F, F.H, Wt, M, N, D, E);
        } SEAM(P + PJ_QKV);
        if (kind == 2) {
            if (IN(P + PJ_MLAMID)) mla_mid(a, F); SEAM(P + PJ_MLAMID);
            if (IN(P + PJ_MLAUP)) {
                { EpiRaw E{(bf16*)(a.ws + RAW_Q), 1536}; sgemm(F, (const bf16*)(a.ws + RAW_CQ), (const bf16*)(a.ws + W_UQ), M, 1536, QLORA, E); }
                { EpiRaw E{(bf16*)(a.ws + RAW_KV), 2048}; sgemm(F, (const bf16*)(a.ws + RAW_CKV), (const bf16*)(a.ws + W_UKV), M, 2048, KVLORA, E); }
            } SEAM(P + PJ_MLAUP);
        }
        if (IN(P + PJ_PREP)) prep_rows(a, F, l, kind); SEAM(P + PJ_PREP);
        if (IN(P + PJ_ATTN)) {
            if (kind == 0) attn_naive<64, 0>(a, F, need_ctx);
            else if (kind == 1) attn_naive<64, 1>(a, F, need_ctx);
            else attn_naive<96, 2>(a, F, need_ctx);
        } SEAM(P + PJ_ATTN);
        if (IN(P + PJ_WO)) { EpiRes E{F.X, F.MOD, l, 2, !need_ctx}; sgemm(F, (const bf16*)(a.ws + WS_O), (const bf16*)(a.ws + W_O + (size_t)l * 2 * MiB), M, D, D, E); } SEAM(P + PJ_WO);
        if (IN(P + PJ_NORM2)) { if (moe) norm_rows<true>(a, F, l, 1, false, !need_ctx, moe_idx); else norm_rows<false>(a, F, l, 1, false, !need_ctx, 0); } SEAM(P + PJ_NORM2);
        if (!moe) {
            const int di = l >> 1;
            if (IN(P + PJ_GU)) { MoeOff mo{}; sgemm_swiglu(a, F, F.H, (const bf16*)(a.ws + W_GU + (size_t)di * 11 * MiB), M, FF, D, (bf16*)(a.ws + WS_ACT), false, mo); } SEAM(P + PJ_GU);
            if (IN(P + PJ_DOWN)) { EpiRes E{F.X, F.MOD, l, 5, !need_ctx}; sgemm(F, (const bf16*)(a.ws + WS_ACT), (const bf16*)(a.ws + W_DN + (size_t)di * 11 * MiB / 2), M, D, FF, E); } SEAM(P + PJ_DOWN);
        } else {
            if (IN(P + PJ_GATHER)) moe_gather(a, F, moe_idx, !need_ctx); SEAM(P + PJ_GATHER);
            if (IN(P + PJ_GU)) { const MoeOff mo = moe_offsets(a, moe_idx); sgemm_swiglu(a, F, (const bf16*)(a.ws + WS_HP), (const bf16*)(a.ws + WE_GU(0) + (size_t)moe_idx * 168 * MiB), mo.o[8], FFE, D, (bf16*)(a.ws + WS_ACT), true, mo); } SEAM(P + PJ_GU);
            if (IN(P + PJ_DOWN)) { const MoeOff mo = moe_offsets(a, moe_idx); sgemm_moe_down(F, (const bf16*)(a.ws + WS_ACT), (const bf16*)(a.ws + WE_DN(0) + (size_t)moe_idx * 168 * MiB), mo.o[8], FFE, (bf16*)(a.ws + WS_HP), mo); } SEAM(P + PJ_DOWN);
            if (IN(P + PJ_COMBINE)) moe_combine(a, F, l, moe_idx); SEAM(P + PJ_COMBINE);
        }
    }
#undef IN
#undef SEAM
}

extern "C" void kernel_launch(void* const* d_in, const int* in_sizes, int n_in, void* d_out, int out_size, void* d_ws, size_t ws_size, hipStream_t stream) {
    static int grid = 0;
    if (grid == 0) {
        if (n_in != 51 || ws_size < WS_END || out_size != NB * SEQ * D) { fprintf(stderr, "kernel_launch: unexpected problem (n_in %d, ws %zu, out %d)\n", n_in, ws_size, out_size); grid = -1; return; }
        int dev = 0, cus = 0;
        if (hipGetDevice(&dev) != hipSuccess || hipDeviceGetAttribute(&cus, hipDeviceAttributeMultiprocessorCount, dev) != hipSuccess) { grid = -1; return; }
        if (hipFuncSetAttribute((const void*)fwd_kernel, hipFuncAttributeMaxDynamicSharedMemorySize, LDS_BYTES) != hipSuccess) { fprintf(stderr, "kernel_launch: hipFuncSetAttribute failed\n"); grid = -1; return; }
        int per_cu = 0;
        if (hipOccupancyMaxActiveBlocksPerMultiprocessor(&per_cu, (const void*)fwd_kernel, 512, LDS_BYTES) != hipSuccess || per_cu < 1) { fprintf(stderr, "kernel_launch: occupancy query says %d\n", per_cu); }
        (void)hipGetLastError();
        grid = cus;
    }
    if (grid < 0) return;
    (void)hipMemsetAsync((char*)d_ws + WS_CTL, 0, CTL_BYTES, stream);
    Args a{};
    const float* const* in = (const float* const*)d_in;
    a.x = in[0]; a.c = in[1]; a.ctx = in[2]; a.cctx = in[3];
    const int base[4] = {4, 14, 26, 40};
    for (int l = 0; l < 4; ++l) { a.w_mod[l] = in[base[l]]; a.b_mod[l] = in[base[l] + 1]; a.g_mix[l] = in[base[l] + 2]; a.g_ffn[l] = in[base[l] + 3]; a.w_router[l] = nullptr; }
    a.q_gain[0] = in[9]; a.k_gain[0] = in[10]; a.q_gain[1] = in[19]; a.k_gain[1] = in[20]; a.q_gain[2] = in[35]; a.k_gain[2] = in[36]; a.q_gain[3] = in[45]; a.k_gain[3] = in[46];
    a.w_router[1] = in[23]; a.w_router[3] = in[48]; a.rel_bias = in[21]; a.g_dq = in[31]; a.g_dkv = in[32];
    a.out = (float*)d_out; a.ws = (unsigned char*)d_ws;
    int nj = 0, item0 = 0;
    auto job = [&](int idx, size_t off, int K, int N, int Nd, int nb, int mode) { Job& j = a.jobs[nj++]; j.src = in[idx]; j.dst_off = off; j.K = K; j.N = N; j.Nd = Nd; j.nb = nb; j.mode = mode; j.item0 = item0; item0 += (nb * K / 64) * (N / 32); };
    job(8, W_QKV0, 1024, 1536, 1536, 1, 0); job(18, W_QKV1, 1024, 3072, 3072, 1, 0); job(30, W_IN, 1024, 672, 768, 1, 0); job(33, W_UQ, 384, 1536, 1536, 1, 0); job(34, W_UKV, 256, 2048, 2048, 1, 0); job(44, W_QKV3, 1024, 1536, 1536, 1, 0);
    job(11, W_O, 1024, 1024, 1024, 1, 0); job(22, W_O + 2 * MiB, 1024, 1024, 1024, 1, 0); job(37, W_O + 4 * MiB, 1024, 1024, 1024, 1, 0); job(47, W_O + 6 * MiB, 1024, 1024, 1024, 1, 0);
    job(12, W_GU, 1024, 2 * FF, 2 * FF, 1, 1); job(38, W_GU + 11 * MiB, 1024, 2 * FF, 2 * FF, 1, 1); job(13, W_DN, FF, 1024, 1024, 1, 0); job(39, W_DN + 11 * MiB / 2, FF, 1024, 1024, 1, 0);
    job(24, WE_GU(0), 1024, 2 * FFE, 2 * FFE, 8, 1); job(25, WE_DN(0), FFE, 1024, 1024, 8, 0); job(49, WE_GU(1), 1024, 2 * FFE, 2 * FFE, 8, 1); job(50, WE_DN(1), FFE, 1024, 1024, 8, 0);
    a.n_items = item0; a.pad = 0;
#if N_LAUNCH_MODE == 1
    a.lo = 0; a.hi = 1 + 16 * 4;
    hipLaunchKernelGGL(fwd_kernel, dim3(grid), dim3(512), LDS_BYTES, stream, a);
#else
    a.lo = 0; a.hi = 1;
    hipLaunchKernelGGL(fwd_kernel, dim3(grid), dim3(512), LDS_BYTES, stream, a);
    for (int l = 0; l < 4; ++l) for (int j = 0; j < 12; ++j) if (phase_exists(l, j)) { a.lo = pid_of(l, j); a.hi = a.lo + 1; hipLaunchKernelGGL(fwd_kernel, dim3(grid), dim3(512), LDS_BYTES, stream, a); }
#endif
}
```

```cpp
#include <hip/hip_runtime.h>
#include <cstdio>
#include <cstdint>

#ifndef N_LAUNCH_MODE
#define N_LAUNCH_MODE 1
#endif

constexpr int D = 1024, NB = 4, SEQ = 4096, NCTX = 256, SB = SEQ + NCTX  , M = NB * SB  ;
constexpr int NHEAD = 16, HD = 64;
constexpr int FF = 2816, FFE = 3584, NEXP = 8;
constexpr int QLORA = 384, KVLORA = 256, MLA_QK = 96;
constexpr int MAXSLOT = 36864;
constexpr float EPS = 1e-6f;
constexpr float LOG2E = 1.4426950408889634f;
constexpr float C2_64 = 0.125f * LOG2E;
constexpr float C2_96 = 0.10206207261596575f * LOG2E;

constexpr size_t MiB = 1u << 20;
constexpr size_t WS_CTL = 0, CTL_BYTES = 1 * MiB;
constexpr size_t WS_MOD = 1 * MiB;
constexpr size_t WS_ROPE = WS_MOD + 512 * 1024;
constexpr size_t WS_ROUTE = 2 * MiB;
constexpr size_t WS_X = 3 * MiB;
constexpr size_t WS_H = 71 * MiB;
constexpr size_t WS_HP = 105 * MiB;
constexpr size_t WS_ATT = 177 * MiB;
constexpr size_t WS_RAW = WS_ATT;
constexpr size_t WS_QB = WS_ATT + 166 * MiB;
constexpr size_t WS_KB = WS_QB + 51 * MiB;
constexpr size_t WS_VB = WS_KB + 51 * MiB;
constexpr size_t WS_O = WS_VB + 34 * MiB;
constexpr size_t WS_ACT = WS_ATT;
constexpr size_t WS_W = 513 * MiB;
constexpr size_t WS_WE = 571 * MiB;
constexpr size_t WS_END = WS_WE + 2 * 168 * MiB;
constexpr size_t RAW_IN = WS_RAW;
constexpr size_t RAW_CQ = RAW_IN + (size_t)M * 768 * 2;
constexpr size_t RAW_CKV = RAW_CQ + (size_t)M * 384 * 2;
constexpr size_t RAW_Q = RAW_CKV + (size_t)M * 256 * 2;
constexpr size_t RAW_KV = RAW_Q + (size_t)M * 1536 * 2;
static_assert(RAW_KV + (size_t)M * 2048 * 2 <= WS_QB, "raw region");
static_assert(WS_ACT + (size_t)MAXSLOT * FFE * 2 <= WS_W, "act overlay");
constexpr size_t W_QKV0 = WS_W, W_QKV1 = W_QKV0 + 3 * MiB, W_IN = W_QKV1 + 6 * MiB, W_UQ = W_IN + 3 * MiB / 2, W_UKV = W_UQ + 1179648, W_QKV3 = W_UKV + 1 * MiB;
constexpr size_t W_O = W_QKV3 + 3 * MiB;
constexpr size_t W_GU = W_O + 8 * MiB;
constexpr size_t W_DN = W_GU + 22 * MiB;
static_assert(W_DN + 11 * MiB <= WS_WE, "dense weights");
constexpr size_t WE_GU(int i) { return WS_WE + (size_t)i * 168 * MiB; }
constexpr size_t WE_DN(int i) { return WS_WE + (size_t)i * 168 * MiB + 112 * MiB; }
constexpr int CW_CNT = 64;
constexpr int CW_BAR = 4096;

#define LAS __attribute__((address_space(3)))
typedef unsigned short bf16;
typedef float f32x4 __attribute__((ext_vector_type(4)));
typedef float f32x16 __attribute__((ext_vector_type(16)));
typedef short bf16x8 __attribute__((ext_vector_type(8)));
typedef unsigned u32x4 __attribute__((ext_vector_type(4)));
typedef unsigned u32x2 __attribute__((ext_vector_type(2)));
#define DI __device__ __forceinline__
DI float bf2f(unsigned v) { return __uint_as_float(v << 16); }
DI unsigned f2bf(float f) { unsigned u = __float_as_uint(f); return (u + 0x7fffu + ((u >> 16) & 1u)) >> 16; }
DI unsigned pk2(float lo, float hi) { return f2bf(lo) | (f2bf(hi) << 16); }
DI float wave_sum(float v) {
#pragma unroll
    for (int o = 1; o < 64; o <<= 1) v += __shfl_xor(v, o);
    return v;
}
DI void unpack8(const u32x4 w, float* f) {
    f[0] = bf2f(w.x & 0xffffu); f[1] = bf2f(w.x >> 16); f[2] = bf2f(w.y & 0xffffu); f[3] = bf2f(w.y >> 16);
    f[4] = bf2f(w.z & 0xffffu); f[5] = bf2f(w.z >> 16); f[6] = bf2f(w.w & 0xffffu); f[7] = bf2f(w.w >> 16);
}
DI u32x4 pack8(const float* f) { u32x4 w; w.x = pk2(f[0], f[1]); w.y = pk2(f[2], f[3]); w.z = pk2(f[4], f[5]); w.w = pk2(f[6], f[7]); return w; }

#define XB_TMO      128
#define XB_XCNT(j)  (256  + 64 * (j))
#define XB_XSUB(j)  (1280 + 64 * (j))
#define XB_XGEN(j)  (2304 + 64 * (j))
#define XB_TOP      3328
#define XB_TOPGEN   3392
#define XCD_BAR_WORDS 3456
#define XB_SPIN_CAP (1u << 18)
DI unsigned xb_ld(unsigned* p)              { return __hip_atomic_load(p, __ATOMIC_RELAXED, __HIP_MEMORY_SCOPE_AGENT); }
DI unsigned xb_add(unsigned* p, unsigned v) { return __hip_atomic_fetch_add(p, v, __ATOMIC_RELAXED, __HIP_MEMORY_SCOPE_AGENT); }
DI unsigned xb_xcc_id() { return (unsigned)__builtin_amdgcn_s_getreg((3 << 11) | 20) & 0xFu; }
#define XB_SPIN(cond, bar) do { unsigned _sp = 0; while (cond) { __builtin_amdgcn_s_sleep(1); \
    if ((++_sp & 255u) == 0u) { if (xb_ld(&(bar)[XB_TMO])) break; if (_sp > XB_SPIN_CAP) { atomicAdd(&(bar)[XB_TMO], 1u); break; } } } } while (0)
struct XcdBarrier { unsigned* bar; unsigned x; volatile LAS unsigned* st; };
DI XcdBarrier xcd_barrier_post(unsigned* bar, volatile LAS unsigned* st) {
    XcdBarrier b; b.bar = bar; b.x = xb_xcc_id(); b.st = st;
    if (threadIdx.x == 0) (void)xb_add(&bar[XB_XCNT(b.x)], 1u);
    return b;
}
DI void xcd_barrier_complete(unsigned* bar, unsigned x, unsigned& nloc, unsigned& nx) {
    const unsigned G = gridDim.x * gridDim.y * gridDim.z;
    unsigned sum, cnt, mine, sp = 0u;
    for (;;) {
        sum = 0u; cnt = 0u; mine = 0u;
#pragma unroll
        for (unsigned j = 0; j < 16; ++j) { const unsigned c = xb_ld(&bar[XB_XCNT(j)]); sum += c; cnt += (c > 0u) ? 1u : 0u; mine = (j == x) ? c : mine; }
        if (sum == G) break;
        __builtin_amdgcn_s_sleep(1);
        if ((++sp & 255u) == 0u) { if (xb_ld(&bar[XB_TMO])) break; if (sp > XB_SPIN_CAP) { atomicAdd(&bar[XB_TMO], 1u); break; } }
    }
    nloc = mine > 0u ? mine : 1u; nx = cnt > 0u ? cnt : 1u;
}
DI void xcd_barrier(const XcdBarrier& b) {
    asm volatile("s_waitcnt vmcnt(0)" ::: "memory");
    __syncthreads();
    if (threadIdx.x == 0) {
        unsigned* bar = b.bar;
        __builtin_amdgcn_s_waitcnt(0);
        unsigned nloc = b.st[0], nx = b.st[1];
        if (nloc == 0u) { xcd_barrier_complete(bar, b.x, nloc, nx); b.st[0] = nloc; b.st[1] = nx; }
        const unsigned old = xb_add(&bar[XB_XSUB(b.x)], 1u);
        const unsigned gen = old / nloc;
        if (old + 1u == (gen + 1u) * nloc) {
            __builtin_amdgcn_fence(__ATOMIC_RELEASE, "agent");
            asm volatile("s_waitcnt vmcnt(0)" ::: "memory");
            const unsigned og = xb_add(&bar[XB_TOP], 1u);
            const unsigned tg = og / nx;
            if (og + 1u == (tg + 1u) * nx) xb_add(&bar[XB_TOPGEN], 1u);
            else XB_SPIN(xb_ld(&bar[XB_TOPGEN]) == tg, bar);
            __builtin_amdgcn_fence(__ATOMIC_ACQUIRE, "agent");
            xb_add(&bar[XB_XGEN(b.x)], 1u);
            asm volatile("s_waitcnt vmcnt(0)" ::: "memory");
        } else {
            XB_SPIN(xb_ld(&bar[XB_XGEN(b.x)]) == gen, bar);
            __builtin_amdgcn_fence(__ATOMIC_ACQUIRE, "agent");
            asm volatile("s_waitcnt vmcnt(0)" ::: "memory");
        }
    }
    __syncthreads();
}

constexpr int NJOBS = 18;
struct Job { const float* src; unsigned long long dst_off; int K, N, Nd, nb, mode, item0; };
struct Args {
    const float* x; const float* c; const float* ctx; const float* cctx;
    const float* w_mod[4]; const float* b_mod[4]; const float* g_mix[4]; const float* g_ffn[4];
    const float* q_gain[4]; const float* k_gain[4]; const float* w_router[4];
    const float* rel_bias; const float* g_dq; const float* g_dkv;
    float* out; unsigned char* ws;
    Job jobs[NJOBS];
    int n_items; int lo; int hi; int pad;
};

struct Frame {
    LAS unsigned char* lds;
    int tid, lane, wave, gw, NGW;
    unsigned char* ws;
    float* MOD; float* X; bf16* H;
};
DI void refresh(Frame& F) { int t = threadIdx.x; asm volatile("" : "+v"(t)); F.tid = t; F.lane = t & 63; F.wave = __builtin_amdgcn_readfirstlane(t >> 6); F.gw = blockIdx.x * 8 + F.wave; }
DI int row_mod_idx(int m) { const int b = m / SB, p = m - b * SB; return p < NCTX ? 4 : b; }

DI void conv_item(const Args& a, Frame& F, LAS float* scr, int item) {
    int j = 0;
#pragma unroll 1
    for (int t = 1; t < NJOBS; ++t) if (item >= a.jobs[t].item0) j = t;
    const Job jb = a.jobs[j];
    const int it = item - jb.item0, nblk = jb.N / 32, kb = it / nblk, nbk = it % nblk;
    const int k0g = 64 * kb, n0 = 32 * nbk, e = k0g / jb.K, k0 = k0g - e * jb.K;
    const float* W = jb.src + (size_t)k0g * jb.N + n0;
    const int lane = F.lane;
#pragma unroll 8
    for (int i = 0; i < 32; ++i) { const int kk = 2 * i + (lane >> 5); scr[kk * 33 + (lane & 31)] = W[(size_t)kk * jb.N + (lane & 31)]; }
    asm volatile("s_waitcnt lgkmcnt(0)" ::: "memory");
    int drow = n0;
    if (jb.mode == 1) { const int Fh = jb.N / 2; if (n0 < Fh) drow = (n0 / 128) * 256 + (n0 % 128); else { const int n1 = n0 - Fh; drow = (n1 / 128) * 256 + 128 + (n1 % 128); } }
    bf16* dst = (bf16*)(a.ws + jb.dst_off) + ((size_t)e * jb.Nd + drow) * jb.K + k0;
    const int c = lane & 7;
#pragma unroll
    for (int jj = 0; jj < 4; ++jj) { const int n = (lane >> 3) + 8 * jj; const LAS float* s = scr + (8 * c) * 33 + n;
        u32x4 o; o.x = pk2(s[0 * 33], s[1 * 33]); o.y = pk2(s[2 * 33], s[3 * 33]); o.z = pk2(s[4 * 33], s[5 * 33]); o.w = pk2(s[6 * 33], s[7 * 33]);
        *(u32x4*)(dst + (size_t)n * jb.K + 8 * c) = o; }
    asm volatile("s_waitcnt lgkmcnt(0)" ::: "memory");
}
DI float silu_f(float v) { return v / (1.f + __expf(-v)); }
DI void p0_prologue(const Args& a, Frame& F) {
    refresh(F);
    LAS float* red = (LAS float*)F.lds;
    for (int it = blockIdx.x; it < 4 * 96; it += gridDim.x) {
        const int l = it / 96, j0 = (it % 96) * 64;
        const float* wm = a.w_mod[l] + (size_t)(128 * F.wave) * 6144 + j0 + F.lane;
        float acc[5] = {0.f, 0.f, 0.f, 0.f, 0.f};
#pragma unroll 4
        for (int k = 0; k < 128; ++k) {
            const float w = wm[(size_t)k * 6144]; const int kk = 128 * F.wave + k;
#pragma unroll
            for (int s = 0; s < 4; ++s) acc[s] += silu_f(a.c[s * 1024 + kk]) * w;
            acc[4] += silu_f(a.cctx[kk]) * w;
        }
#pragma unroll
        for (int s = 0; s < 5; ++s) red[(F.wave * 5 + s) * 64 + F.lane] = acc[s];
        __syncthreads();
        if (F.tid < 320) { const int s = F.tid >> 6, ln = F.tid & 63; float t = a.b_mod[l][j0 + ln];
#pragma unroll
            for (int w = 0; w < 8; ++w) t += red[(w * 5 + s) * 64 + ln];
            F.MOD[((size_t)l * 5 + s) * 6144 + j0 + ln] = t; }
        __syncthreads();
    }
    if (blockIdx.x == 0) {
        float* R64 = (float*)(a.ws + WS_ROPE); float* R32 = R64 + 64 * 16 * 2;
        for (int t = F.tid; t < 64 * 16; t += 512) { const int pos = t >> 4, i = t & 15; const float f = expf(-9.210340371976184f * (float)i / 16.f), ang = (float)pos * f; R64[2 * t] = cosf(ang); R64[2 * t + 1] = sinf(ang); }
        for (int t = F.tid; t < 64 * 8; t += 512) { const int pos = t >> 3, i = t & 7; const float f = expf(-9.210340371976184f * (float)i / 8.f), ang = (float)pos * f; R32[2 * t] = cosf(ang); R32[2 * t + 1] = sinf(ang); }
    }
    { u32x4* z = (u32x4*)(a.ws + W_IN + (size_t)672 * 1024 * 2); const int n16 = 96 * 1024 * 2 / 16;
      for (int t = blockIdx.x * 512 + F.tid; t < n16; t += gridDim.x * 512) z[t] = (u32x4){0u, 0u, 0u, 0u}; }
    __syncthreads();
    LAS float* scr = (LAS float*)(F.lds + F.wave * 16384);
    for (int it = F.gw; it < a.n_items; it += F.NGW) conv_item(a, F, scr, it);
}

template <bool ROUTE>
DI void norm_rows(const Args& a, Frame& F, int l, int which  , bool first, bool skip_ctx, int moe_idx) {
    refresh(F);
    const float* gvec = which == 0 ? a.g_mix[l] : a.g_ffn[l];
    f32x4 g[4];
#pragma unroll
    for (int j = 0; j < 4; ++j) g[j] = *(const f32x4*)(gvec + 4 * F.lane + 256 * j);
    for (int m = F.gw; m < M; m += F.NGW) {
        const int b = m / SB, p = m - b * SB; const bool isctx = p < NCTX;
        if (skip_ctx && isctx) continue;
        const float* src = first ? (isctx ? a.ctx + ((size_t)b * NCTX + p) * D : a.x + ((size_t)b * SEQ + (p - NCTX)) * D) : F.X + (size_t)m * D;
        f32x4 v[4]; float ss = 0.f;
#pragma unroll
        for (int j = 0; j < 4; ++j) { v[j] = *(const f32x4*)(src + 4 * F.lane + 256 * j); ss += (v[j].x * v[j].x + v[j].y * v[j].y) + (v[j].z * v[j].z + v[j].w * v[j].w); }
        if (first) {
#pragma unroll
            for (int j = 0; j < 4; ++j) *(f32x4*)(F.X + (size_t)m * D + 4 * F.lane + 256 * j) = v[j];
        }
        const float rstd = 1.0f / sqrtf(wave_sum(ss) * (1.f / D) + EPS);
        const float* md = F.MOD + ((size_t)l * 5 + (isctx ? 4 : b)) * 6144 + (which ? 3072 : 0);
        f32x4 hv[4];
#pragma unroll
        for (int j = 0; j < 4; ++j) { const f32x4 sh = *(const f32x4*)(md + 4 * F.lane + 256 * j), sc = *(const f32x4*)(md + 1024 + 4 * F.lane + 256 * j);
            hv[j] = (v[j] * rstd) * g[j] * (1.f + sc) + sh;
            u32x2 o; o.x = pk2(hv[j].x, hv[j].y); o.y = pk2(hv[j].z, hv[j].w);
            *(u32x2*)(F.H + (size_t)m * D + 4 * F.lane + 256 * j) = o; }
        if (ROUTE) {
            float lg[8] = {0.f, 0.f, 0.f, 0.f, 0.f, 0.f, 0.f, 0.f}; const float* wr = a.w_router[l];
#pragma unroll
            for (int j = 0; j < 4; ++j)
#pragma unroll
                for (int i = 0; i < 4; ++i) { const int k = 4 * F.lane + 256 * j + i; const f32x4 w0 = *(const f32x4*)(wr + (size_t)k * 8), w1 = *(const f32x4*)(wr + (size_t)k * 8 + 4); const float hx = hv[j][i];
                    lg[0] += hx * w0.x; lg[1] += hx * w0.y; lg[2] += hx * w0.z; lg[3] += hx * w0.w; lg[4] += hx * w1.x; lg[5] += hx * w1.y; lg[6] += hx * w1.z; lg[7] += hx * w1.w; }
#pragma unroll
            for (int e = 0; e < 8; ++e) lg[e] = wave_sum(lg[e]);
            int e0 = 0; float v0 = lg[0];
#pragma unroll
            for (int e = 1; e < 8; ++e) if (lg[e] > v0) { v0 = lg[e]; e0 = e; }
            int e1 = -1; float v1 = -INFINITY;
#pragma unroll
            for (int e = 0; e < 8; ++e) if (e != e0 && lg[e] > v1) { v1 = lg[e]; e1 = e; }
            const float ex = __expf(v1 - v0), w0 = 1.f / (1.f + ex), w1 = ex / (1.f + ex);
            if (F.lane == 0) {
                unsigned* cnt = (unsigned*)(a.ws + WS_CTL) + CW_CNT + 64 * moe_idx;
                const unsigned p0 = atomicAdd(cnt + e0, 1u), p1 = atomicAdd(cnt + e1, 1u);
                int* r = (int*)(a.ws + WS_ROUTE) + (size_t)m * 8;
                r[0] = e0; r[1] = e1; r[2] = (int)p0; r[3] = (int)p1; r[4] = __float_as_int(w0); r[5] = __float_as_int(w1);
            }
        }
    }
}

struct MoeOff { int o[9]; };
DI MoeOff moe_offsets(const Args& a, int moe_idx) {
    const unsigned* cnt = (const unsigned*)(a.ws + WS_CTL) + CW_CNT + 64 * moe_idx;
    MoeOff r; r.o[0] = 0;
#pragma unroll
    for (int e = 0; e < 8; ++e) { const int c = (int)__builtin_amdgcn_readfirstlane((int)__hip_atomic_load(cnt + e, __ATOMIC_RELAXED, __HIP_MEMORY_SCOPE_AGENT)); r.o[e + 1] = r.o[e] + ((c + 255) & ~255); }
    return r;
}
DI int moe_off_of(const MoeOff& mo, int e) { int r = 0;
#pragma unroll
    for (int i = 1; i < 8; ++i) if (e >= i) r = mo.o[i];
    return r; }
DI int moe_expert_of_slot(const MoeOff& mo, int slot) { int e = 0;
#pragma unroll
    for (int i = 1; i < 8; ++i) if (slot >= mo.o[i]) e = i;
    return e; }

DI void moe_gather(const Args& a, Frame& F, int moe_idx, bool skip_ctx) {
    refresh(F);
    const MoeOff mo = moe_offsets(a, moe_idx);
    bf16* HP = (bf16*)(a.ws + WS_HP);
    for (int it = F.gw; it < 2 * M; it += F.NGW) {
        const int m = it >> 1, k = it & 1; const int p = m % SB; if (skip_ctx && p < NCTX) continue;
        const int* r = (const int*)(a.ws + WS_ROUTE) + (size_t)m * 8;
        const int e = r[k], pos = r[2 + k]; const int slot = moe_off_of(mo, e) + pos;
        const u32x4* s = (const u32x4*)(F.H + (size_t)m * D); u32x4* d = (u32x4*)(HP + (size_t)slot * D);
        d[F.lane] = s[F.lane]; d[F.lane + 64] = s[F.lane + 64];
    }
}
DI void moe_combine(const Args& a, Frame& F, int l, int moe_idx) {
    refresh(F);
    const MoeOff mo = moe_offsets(a, moe_idx);
    const bf16* Y = (const bf16*)(a.ws + WS_HP);
    const bool last = (l == 3);
    f32x4 g[4];
#pragma unroll
    for (int j = 0; j < 4; ++j) g[j] = last ? (f32x4){0.f, 0.f, 0.f, 0.f} : *(const f32x4*)(a.g_mix[l + 1] + 4 * F.lane + 256 * j);
    for (int m = F.gw; m < M; m += F.NGW) {
        const int b = m / SB, p = m - b * SB; const bool isctx = p < NCTX;
        if (last && isctx) continue;
        const int* r = (const int*)(a.ws + WS_ROUTE) + (size_t)m * 8;
        const int s0 = moe_off_of(mo, r[0]) + r[2], s1 = moe_off_of(mo, r[1]) + r[3]; const float w0 = __int_as_float(r[4]), w1 = __int_as_float(r[5]);
        const float* md = F.MOD + ((size_t)l * 5 + (isctx ? 4 : b)) * 6144 + 5 * 1024;
        f32x4 v[4]; float ss = 0.f;
#pragma unroll
        for (int j = 0; j < 4; ++j) { const int col = 4 * F.lane + 256 * j;
            const u32x2 y0 = *(const u32x2*)(Y + (size_t)s0 * D + col), y1 = *(const u32x2*)(Y + (size_t)s1 * D + col);
            const f32x4 g2 = *(const f32x4*)(md + col); const f32x4 xv = *(const f32x4*)(F.X + (size_t)m * D + col);
            f32x4 f; f.x = w0 * bf2f(y0.x & 0xffffu) + w1 * bf2f(y1.x & 0xffffu); f.y = w0 * bf2f(y0.x >> 16) + w1 * bf2f(y1.x >> 16);
            f.z = w0 * bf2f(y0.y & 0xffffu) + w1 * bf2f(y1.y & 0xffffu); f.w = w0 * bf2f(y0.y >> 16) + w1 * bf2f(y1.y >> 16);
            v[j] = xv + g2 * f; ss += (v[j].x * v[j].x + v[j].y * v[j].y) + (v[j].z * v[j].z + v[j].w * v[j].w); }
        if (last) {
            float* o = a.out + ((size_t)b * SEQ + (p - NCTX)) * D;
#pragma unroll
            for (int j = 0; j < 4; ++j) *(f32x4*)(o + 4 * F.lane + 256 * j) = v[j];
        } else {
#pragma unroll
            for (int j = 0; j < 4; ++j) *(f32x4*)(F.X + (size_t)m * D + 4 * F.lane + 256 * j) = v[j];
            const float rstd = 1.0f / sqrtf(wave_sum(ss) * (1.f / D) + EPS);
            const float* md2 = F.MOD + ((size_t)(l + 1) * 5 + (isctx ? 4 : b)) * 6144;
#pragma unroll
            for (int j = 0; j < 4; ++j) { const f32x4 sh = *(const f32x4*)(md2 + 4 * F.lane + 256 * j), sc = *(const f32x4*)(md2 + 1024 + 4 * F.lane + 256 * j);
                const f32x4 hv = (v[j] * rstd) * g[j] * (1.f + sc) + sh; u32x2 o; o.x = pk2(hv.x, hv.y); o.y = pk2(hv.z, hv.w);
                *(u32x2*)(F.H + (size_t)m * D + 4 * F.lane + 256 * j) = o; }
        }
    }
}

DI void load16(const bf16* p, float* v) { const u32x4 a = *(const u32x4*)p, b = *(const u32x4*)(p + 8); unpack8(a, v); unpack8(b, v + 8); }
DI void store16(bf16* p, const float* v) { *(u32x4*)p = pack8(v); *(u32x4*)(p + 8) = pack8(v + 8); }
DI void rms64_gain(float* v, const float* gain, int part) {
    float ss = 0.f;
#pragma unroll
    for (int i = 0; i < 16; ++i) ss += v[i] * v[i];
    ss += __shfl_xor(ss, 1); ss += __shfl_xor(ss, 2);
    const float r = 1.0f / sqrtf(ss * (1.f / 64.f) + EPS);
#pragma unroll
    for (int i = 0; i < 16; ++i) v[i] = v[i] * r * gain[part * 16 + i];
}
DI void rope64(float* v, const float* R64, int part, int gr, int gc) {
    const int pos = part < 2 ? gr : gc; const float* cs = R64 + pos * 32;
#pragma unroll
    for (int i = 0; i < 16; ++i) { const float other = __shfl_xor(v[i], 1); const float c = cs[2 * i], s = cs[2 * i + 1];
        v[i] = (part & 1) ? (other * s + v[i] * c) : (v[i] * c - other * s); }
}
DI void rms32_rope(float* v, const float* gain  , int part, bool do_rope, const float* R32, int gr, int gc) {
    float ss = 0.f;
#pragma unroll
    for (int i = 0; i < 16; ++i) ss += v[i] * v[i];
    ss += __shfl_xor(ss, 1);
    const float r = 1.0f / sqrtf(ss * (1.f / 32.f) + EPS);
#pragma unroll
    for (int i = 0; i < 16; ++i) v[i] = v[i] * r * gain[part * 16 + i];
    if (do_rope) { const int pos = part == 0 ? gr : gc; const float* cs = R32 + pos * 16;
#pragma unroll
        for (int i = 0; i < 8; ++i) { const float c = cs[2 * i], s = cs[2 * i + 1]; const float x1 = v[i], x2 = v[i + 8]; v[i] = x1 * c - x2 * s; v[i + 8] = x1 * s + x2 * c; } }
}
DI void prep_rows(const Args& a, Frame& F, int l, int kind) {
    refresh(F);
    const float* R64 = (const float*)(a.ws + WS_ROPE); const float* R32 = R64 + 64 * 16 * 2;
    const float* qg = a.q_gain[l]; const float* kg = a.k_gain[l];
    bf16* QB = (bf16*)(a.ws + WS_QB); bf16* KB = (bf16*)(a.ws + WS_KB); bf16* VB = (bf16*)(a.ws + WS_VB);
    const int lane = F.lane, part = lane & 3;
    for (int m = F.gw; m < M; m += F.NGW) {
        const int p = m % SB; const bool isctx = p < NCTX; const int t = isctx ? 0 : p - NCTX; const int gr = t >> 6, gc = t & 63;
        float v[16];
        if (kind == 0) {
            const bf16* raw = (const bf16*)(a.ws + WS_RAW) + (size_t)m * 1536;
            load16(raw + lane * 16, v); rms64_gain(v, qg, part); if (!isctx) rope64(v, R64, part, gr, gc);
#pragma unroll
            for (int i = 0; i < 16; ++i) v[i] *= C2_64;
            store16(QB + (size_t)m * 1024 + lane * 16, v);
            const int l16 = lane & 15;
            load16(raw + 1024 + l16 * 16, v); rms64_gain(v, kg, part); if (!isctx) rope64(v, R64, part, gr, gc);
            if (lane < 16) store16(KB + (size_t)m * 256 + l16 * 16, v);
            if (lane >= 16 && lane < 32) { const u32x4* s = (const u32x4*)(raw + 1280 + l16 * 16); u32x4* d = (u32x4*)(VB + (size_t)m * 256 + l16 * 16); d[0] = s[0]; d[1] = s[1]; }
        } else if (kind == 1) {
            const bf16* raw = (const bf16*)(a.ws + WS_RAW) + (size_t)m * 3072;
            load16(raw + lane * 16, v); rms64_gain(v, qg, part);
#pragma unroll
            for (int i = 0; i < 16; ++i) v[i] *= C2_64;
            store16(QB + (size_t)m * 1024 + lane * 16, v);
            load16(raw + 1024 + lane * 16, v); rms64_gain(v, kg, part); store16(KB + (size_t)m * 1024 + lane * 16, v);
            { const u32x4* s = (const u32x4*)(raw + 2048 + lane * 16); u32x4* d = (u32x4*)(VB + (size_t)m * 1024 + lane * 16); d[0] = s[0]; d[1] = s[1]; }
        } else {
            const bf16* qraw = (const bf16*)(a.ws + RAW_Q) + (size_t)m * 1536; const bf16* kvraw = (const bf16*)(a.ws + RAW_KV) + (size_t)m * 2048; const bf16* rin = (const bf16*)(a.ws + RAW_IN) + (size_t)m * 768;
            const int h = lane >> 2;
            load16(qraw + h * 96 + part * 16, v); rms64_gain(v, qg, part);
#pragma unroll
            for (int i = 0; i < 16; ++i) v[i] *= C2_96;
            store16(QB + (size_t)m * 1536 + h * 96 + part * 16, v);
            { const int h2 = (lane >> 1) & 15, p2 = lane & 1;
              load16(qraw + h2 * 96 + 64 + p2 * 16, v); rms32_rope(v, qg + 64, p2, !isctx, R32, gr, gc);
#pragma unroll
              for (int i = 0; i < 16; ++i) v[i] *= C2_96;
              if (lane < 32) store16(QB + (size_t)m * 1536 + h2 * 96 + 64 + p2 * 16, v); }
            load16(kvraw + h * 128 + part * 16, v); rms64_gain(v, kg, part); store16(KB + (size_t)m * 1536 + h * 96 + part * 16, v);
            { const u32x4* s = (const u32x4*)(kvraw + h * 128 + 64 + part * 16); u32x4* d = (u32x4*)(VB + (size_t)m * 1024 + h * 64 + part * 16); d[0] = s[0]; d[1] = s[1]; }
            { const int h2 = (lane >> 1) & 15, p2 = lane & 1;
              load16(rin + 640 + p2 * 16, v); rms32_rope(v, kg + 64, p2, !isctx, R32, gr, gc);
              if (lane < 32) store16(KB + (size_t)m * 1536 + h2 * 96 + 64 + p2 * 16, v); }
        }
    }
}
DI void mla_mid(const Args& a, Frame& F) {
    refresh(F);
    const int lane = F.lane;
    for (int m = F.gw; m < M; m += F.NGW) {
        const bf16* rin = (const bf16*)(a.ws + RAW_IN) + (size_t)m * 768;
        const unsigned* q3 = (const unsigned*)(rin + 6 * lane); float q[6]; float ss = 0.f;
#pragma unroll
        for (int i = 0; i < 3; ++i) { const unsigned w = q3[i]; q[2 * i] = bf2f(w & 0xffffu); q[2 * i + 1] = bf2f(w >> 16); }
#pragma unroll
        for (int i = 0; i < 6; ++i) ss += q[i] * q[i];
        float r = 1.0f / sqrtf(wave_sum(ss) * (1.f / 384.f) + EPS);
        unsigned* oq = (unsigned*)((bf16*)(a.ws + RAW_CQ) + (size_t)m * 384 + 6 * lane);
#pragma unroll
        for (int i = 0; i < 3; ++i) oq[i] = pk2(q[2 * i] * r * a.g_dq[6 * lane + 2 * i], q[2 * i + 1] * r * a.g_dq[6 * lane + 2 * i + 1]);
        const u32x2 kw = *(const u32x2*)(rin + 384 + 4 * lane); float k[4] = {bf2f(kw.x & 0xffffu), bf2f(kw.x >> 16), bf2f(kw.y & 0xffffu), bf2f(kw.y >> 16)};
        ss = k[0] * k[0] + k[1] * k[1] + k[2] * k[2] + k[3] * k[3];
        r = 1.0f / sqrtf(wave_sum(ss) * (1.f / 256.f) + EPS);
        u32x2 ok; ok.x = pk2(k[0] * r * a.g_dkv[4 * lane], k[1] * r * a.g_dkv[4 * lane + 1]); ok.y = pk2(k[2] * r * a.g_dkv[4 * lane + 2], k[3] * r * a.g_dkv[4 * lane + 3]);
        *(u32x2*)((bf16*)(a.ws + RAW_CKV) + (size_t)m * 256 + 4 * lane) = ok;
    }
}

DI int crow(int r, int hi) { return (r & 3) + 8 * (r >> 2) + 4 * hi; }
struct EpiRaw { bf16* O; int ldc; DI void operator()(int row, int col, float v) const { O[(size_t)row * ldc + col] = (bf16)f2bf(v); } };
struct EpiRes { float* X; const float* MOD; int l; int gsel  ; bool skip_ctx;
    DI void operator()(int row, int col, float v) const { const int b = row / SB, p = row - b * SB; const bool isctx = p < NCTX; if (skip_ctx && isctx) return;
        const float g = MOD[((size_t)l * 5 + (isctx ? 4 : b)) * 6144 + gsel * 1024 + col]; X[(size_t)row * D + col] += g * v; } };
template <class Epi>
DI void sgemm(Frame& F, const bf16* A, const bf16* Bt, int Mrows, int N, int K, const Epi& E) {
    refresh(F);
    const int lane = F.lane, r = lane & 31, hi = lane >> 5; const int ntn = N / 32, ntiles = (Mrows / 32) * ntn;
    for (int it = F.gw; it < ntiles; it += F.NGW) {
        const int mt = it / ntn, nt = it % ntn;
        const bf16* ap = A + (size_t)(mt * 32 + r) * K + 8 * hi; const bf16* bp = Bt + (size_t)(nt * 32 + r) * K + 8 * hi;
        f32x16 acc = {};
#pragma unroll 4
        for (int k0 = 0; k0 < K; k0 += 16) acc = __builtin_amdgcn_mfma_f32_32x32x16_bf16(*(const bf16x8*)(ap + k0), *(const bf16x8*)(bp + k0), acc, 0, 0, 0);
#pragma unroll
        for (int i = 0; i < 16; ++i) E(mt * 32 + crow(i, hi), nt * 32 + r, acc[i]);
    }
}
DI float swiglu_f(float g, float u) { return g / (1.f + __expf(-g)) * u; }
DI void sgemm_swiglu(const Args& a, Frame& F, const bf16* A, const bf16* BtBase, int Mrows, int Fh, int K, bf16* ACT, bool grouped, const MoeOff& mo) {
    refresh(F);
    const int lane = F.lane, r = lane & 31, hi = lane >> 5; const int ntn = Fh / 32, ntiles = (Mrows / 32) * ntn;
    for (int it = F.gw; it < ntiles; it += F.NGW) {
        const int mt = it / ntn, nt = it % ntn, f0 = nt * 32;
        const bf16* Bt = BtBase; if (grouped) Bt += (size_t)moe_expert_of_slot(mo, mt * 32) * (2 * Fh) * K;
        const int grow = (f0 / 128) * 256 + (f0 % 128);
        const bf16* ap = A + (size_t)(mt * 32 + r) * K + 8 * hi; const bf16* bg = Bt + (size_t)(grow + r) * K + 8 * hi; const bf16* bu = bg + (size_t)128 * K;
        f32x16 ag = {}, au = {};
#pragma unroll 2
        for (int k0 = 0; k0 < K; k0 += 16) { const bf16x8 av = *(const bf16x8*)(ap + k0);
            ag = __builtin_amdgcn_mfma_f32_32x32x16_bf16(av, *(const bf16x8*)(bg + k0), ag, 0, 0, 0);
            au = __builtin_amdgcn_mfma_f32_32x32x16_bf16(av, *(const bf16x8*)(bu + k0), au, 0, 0, 0); }
#pragma unroll
        for (int i = 0; i < 16; ++i) ACT[(size_t)(mt * 32 + crow(i, hi)) * Fh + f0 + r] = (bf16)f2bf(swiglu_f(ag[i], au[i]));
    }
}
DI void sgemm_moe_down(Frame& F, const bf16* A, const bf16* BtBase, int Mrows, int K, bf16* Y, const MoeOff& mo) {
    refresh(F);
    const int lane = F.lane, r = lane & 31, hi = lane >> 5; const int ntn = D / 32, ntiles = (Mrows / 32) * ntn;
    for (int it = F.gw; it < ntiles; it += F.NGW) {
        const int mt = it / ntn, nt = it % ntn;
        const bf16* Bt = BtBase + (size_t)moe_expert_of_slot(mo, mt * 32) * D * K;
        const bf16* ap = A + (size_t)(mt * 32 + r) * K + 8 * hi; const bf16* bp = Bt + (size_t)(nt * 32 + r) * K + 8 * hi;
        f32x16 acc = {};
#pragma unroll 4
        for (int k0 = 0; k0 < K; k0 += 16) acc = __builtin_amdgcn_mfma_f32_32x32x16_bf16(*(const bf16x8*)(ap + k0), *(const bf16x8*)(bp + k0), acc, 0, 0, 0);
#pragma unroll
        for (int i = 0; i < 16; ++i) Y[(size_t)(mt * 32 + crow(i, hi)) * D + nt * 32 + r] = (bf16)f2bf(acc[i]);
    }
}

template <int DK>
DI float dot_k(const unsigned* q, const bf16* kp) {
    float s = 0.f;
#pragma unroll
    for (int c = 0; c < DK / 8; ++c) { float kf[8]; unpack8(*(const u32x4*)(kp + 8 * c), kf);
#pragma unroll
        for (int i = 0; i < 4; ++i) { const unsigned w = q[4 * c + i]; s += bf2f(w & 0xffffu) * kf[2 * i]; s += bf2f(w >> 16) * kf[2 * i + 1]; } }
    return s;
}
DI void acc_v(float* o, float alpha, float pw, const bf16* vp) {
#pragma unroll
    for (int c = 0; c < 8; ++c) { float vf[8]; unpack8(*(const u32x4*)(vp + 8 * c), vf);
#pragma unroll
        for (int i = 0; i < 8; ++i) o[8 * c + i] = o[8 * c + i] * alpha + pw * vf[i]; }
}
template <int DK, int KIND>
DI void attn_naive(const Args& a, Frame& F, bool need_ctx) {
    refresh(F);
    const bf16* QB = (const bf16*)(a.ws + WS_QB); const bf16* KB = (const bf16*)(a.ws + WS_KB); const bf16* VB = (const bf16*)(a.ws + WS_VB); bf16* O = (bf16*)(a.ws + WS_O);
    constexpr int QP = NHEAD * DK, KP = KIND == 0 ? 256 : NHEAD * DK, VP = KIND == 0 ? 256 : 1024;
    const int nlat = NB * NHEAD * SEQ, nctx = need_ctx ? NB * NHEAD * NCTX : 0;
    const int gt = blockIdx.x * 512 + F.tid, NT = gridDim.x * 512;
    for (int it = gt; it < nlat + nctx; it += NT) {
        int b, h, p; bool isctx;
        if (it < nlat) { b = it / (NHEAD * SEQ); h = (it / SEQ) % NHEAD; p = NCTX + it % SEQ; isctx = false; }
        else { const int j = it - nlat; b = j / (NHEAD * NCTX); h = (j / NCTX) % NHEAD; p = j % NCTX; isctx = true; }
        const int m = b * SB + p; const int kvh = KIND == 0 ? h / 4 : h;
        unsigned q[DK / 2];
#pragma unroll
        for (int c = 0; c < DK / 8; ++c) { const u32x4 w = *(const u32x4*)(QB + (size_t)m * QP + h * DK + 8 * c); q[4 * c] = w.x; q[4 * c + 1] = w.y; q[4 * c + 2] = w.z; q[4 * c + 3] = w.w; }
        float o[64];
#pragma unroll
        for (int i = 0; i < 64; ++i) o[i] = 0.f;
        float mx = -INFINITY, lsum = 0.f;
        const bf16* kb0 = KB + (size_t)b * SB * KP + kvh * DK; const bf16* vb0 = VB + (size_t)b * SB * VP + kvh * 64;
        const int nk1 = (isctx || KIND == 1) ? NCTX : SB;
        for (int k = 0; k < nk1; ++k) {
            const float s = dot_k<DK>(q, kb0 + (size_t)k * KP); const float mn = fmaxf(mx, s), al = exp2f(mx - mn), pw = exp2f(s - mn);
            lsum = lsum * al + pw; mx = mn; acc_v(o, al, pw, vb0 + (size_t)k * VP);
        }
        if (KIND == 1 && !isctx) {
            const int t = p - NCTX, gr = t >> 6, gc = t & 63; const int r0 = min(max(gr - 4, 0), 56), c0 = min(max(gc - 8, 0), 48);
            const float* bias = a.rel_bias + h * 15 * 31;
            for (int kr = r0; kr < r0 + 8; ++kr) for (int kc = c0; kc < c0 + 16; ++kc) {
                const int k = NCTX + kr * 64 + kc;
                const float s = dot_k<DK>(q, kb0 + (size_t)k * KP) + bias[(kr - gr + 7) * 31 + (kc - gc + 15)] * LOG2E;
                const float mn = fmaxf(mx, s), al = exp2f(mx - mn), pw = exp2f(s - mn);
                lsum = lsum * al + pw; mx = mn; acc_v(o, al, pw, vb0 + (size_t)k * VP);
            }
        }
        const float inv = 1.f / lsum;
#pragma unroll
        for (int c = 0; c < 8; ++c) { float t8[8];
#pragma unroll
            for (int i = 0; i < 8; ++i) t8[i] = o[8 * c + i] * inv;
            *(u32x4*)(O + (size_t)m * 1024 + h * 64 + 8 * c) = pack8(t8); }
    }
}

constexpr int LDS_BYTES = 147456;
constexpr int MISC_OFF = 131072 + 320;
enum { PJ_NORM1 = 0, PJ_QKV = 1, PJ_MLAMID = 2, PJ_MLAUP = 3, PJ_PREP = 4, PJ_ATTN = 5, PJ_WO = 6, PJ_NORM2 = 7, PJ_GATHER = 8, PJ_GU = 9, PJ_DOWN = 10, PJ_COMBINE = 11 };
__host__ __device__ constexpr int pid_of(int l, int j) { return 1 + 16 * l + j; }
__host__ __device__ inline bool phase_exists(int l, int j) {
    const int kind = l % 3; const bool moe = (l & 1) != 0;
    switch (j) {
        case PJ_NORM1: return l == 0 || l == 1 || l == 3;
        case PJ_MLAMID: case PJ_MLAUP: return kind == 2;
        case PJ_GATHER: case PJ_COMBINE: return moe;
        case PJ_QKV: case PJ_PREP: case PJ_ATTN: case PJ_WO: case PJ_NORM2: case PJ_GU: case PJ_DOWN: return true;
        default: return false;
    }
}

__global__ void __launch_bounds__(512, 2) fwd_kernel(Args a) {
    extern __shared__ __attribute__((aligned(16))) unsigned char lds_raw[];
    Frame F;
    F.lds = (LAS unsigned char*)lds_raw;
    F.tid = threadIdx.x; F.lane = F.tid & 63; F.wave = __builtin_amdgcn_readfirstlane(F.tid >> 6);
    F.gw = blockIdx.x * 8 + F.wave; F.NGW = gridDim.x * 8;
    F.ws = a.ws; F.MOD = (float*)(a.ws + WS_MOD); F.X = (float*)(a.ws + WS_X); F.H = (bf16*)(a.ws + WS_H);
    volatile LAS unsigned* MISC = (volatile LAS unsigned*)(F.lds + MISC_OFF);
    if (F.tid < 32) MISC[F.tid] = 0u;
    __syncthreads();
    const int lo = a.lo, hi = a.hi;
    const bool one_launch = (hi - lo) > 1;
    XcdBarrier bar; bar.bar = (unsigned*)(a.ws + WS_CTL) + CW_BAR; bar.x = 0; bar.st = nullptr;
    if (one_launch) bar = xcd_barrier_post((unsigned*)(a.ws + WS_CTL) + CW_BAR, MISC + 8);
#define IN(k) (lo <= (k) && (k) < hi)
#define SEAM(k) do { if (one_launch && IN(k) && (k) + 1 < hi) xcd_barrier(bar); } while (0)

    if (IN(0)) { p0_prologue(a, F); } SEAM(0);

#pragma unroll 1
    for (int l = 0; l < 4; ++l) {
        const int kind = l % 3; const bool moe = (l & 1) != 0; const bool need_ctx = l < 3; const int moe_idx = l >> 1;
        const int P = 1 + 16 * l;
        if (l != 2) { if (IN(P + PJ_NORM1)) norm_rows<false>(a, F, l, 0, l == 0, false, 0); SEAM(P + PJ_NORM1); }
        if (IN(P + PJ_QKV)) {
            const int N = kind == 0 ? 1536 : (kind == 1 ? 3072 : 768);
            const bf16* Wt = (const bf16*)(a.ws + (l == 0 ? W_QKV0 : l == 1 ? W_QKV1 : l == 2 ? W_IN : W_QKV3));
            EpiRaw E{(bf16*)(a.ws + WS_RAW), N};
            sgemm(F, F.H, Wt, M, N, D, E);
        } SEAM(P + PJ_QKV);
        if (kind == 2) {
            if (IN(P + PJ_MLAMID)) mla_mid(a, F); SEAM(P + PJ_MLAMID);
            if (IN(P + PJ_MLAUP)) {
                { EpiRaw E{(bf16*)(a.ws + RAW_Q), 1536}; sgemm(F, (const bf16*)(a.ws + RAW_CQ), (const bf16*)(a.ws + W_UQ), M, 1536, QLORA, E); }
                { EpiRaw E{(bf16*)(a.ws + RAW_KV), 2048}; sgemm(F, (const bf16*)(a.ws + RAW_CKV), (const bf16*)(a.ws + W_UKV), M, 2048, KVLORA, E); }
            } SEAM(P + PJ_MLAUP);
        }
        if (IN(P + PJ_PREP)) prep_rows(a, F, l, kind); SEAM(P + PJ_PREP);
        if (IN(P + PJ_ATTN)) {
            if (kind == 0) attn_naive<64, 0>(a, F, need_ctx);
            else if (kind == 1) attn_naive<64, 1>(a, F, need_ctx);
            else attn_naive<96, 2>(a, F, need_ctx);
        } SEAM(P + PJ_ATTN);
        if (IN(P + PJ_WO)) { EpiRes E{F.X, F.MOD, l, 2, !need_ctx}; sgemm(F, (const bf16*)(a.ws + WS_O), (const bf16*)(a.ws + W_O + (size_t)l * 2 * MiB), M, D, D, E); } SEAM(P + PJ_WO);
        if (IN(P + PJ_NORM2)) { if (moe) norm_rows<true>(a, F, l, 1, false, !need_ctx, moe_idx); else norm_rows<false>(a, F, l, 1, false, !need_ctx, 0); } SEAM(P + PJ_NORM2);
        if (!moe) {
            const int di = l >> 1;
            if (IN(P + PJ_GU)) { MoeOff mo{}; sgemm_swiglu(a, F, F.H, (const bf16*)(a.ws + W_GU + (size_t)di * 11 * MiB), M, FF, D, (bf16*)(a.ws + WS_ACT), false, mo); } SEAM(P + PJ_GU);
            if (IN(P + PJ_DOWN)) { EpiRes E{F.X, F.MOD, l, 5, !need_ctx}; sgemm(F, (const bf16*)(a.ws + WS_ACT), (const bf16*)(a.ws + W_DN + (size_t)di * 11 * MiB / 2), M, D, FF, E); } SEAM(P + PJ_DOWN);
        } else {
            if (IN(P + PJ_GATHER)) moe_gather(a, F, moe_idx, !need_ctx); SEAM(P + PJ_GATHER);
            if (IN(P + PJ_GU)) { const MoeOff mo = moe_offsets(a, moe_idx); sgemm_swiglu(a, F, (const bf16*)(a.ws + WS_HP), (const bf16*)(a.ws + WE_GU(0) + (size_t)moe_idx * 168 * MiB), mo.o[8], FFE, D, (bf16*)(a.ws + WS_ACT), true, mo); } SEAM(P + PJ_GU);
            if (IN(P + PJ_DOWN)) { const MoeOff mo = moe_offsets(a, moe_idx); sgemm_moe_down(F, (const bf16*)(a.ws + WS_ACT), (const bf16*)(a.ws + WE_DN(0) + (size_t)moe_idx * 168 * MiB), mo.o[8], FFE, (bf16*)(a.ws + WS_HP), mo); } SEAM(P + PJ_DOWN);
            if (IN(P + PJ_COMBINE)) moe_combine(a, F, l, moe_idx); SEAM(P + PJ_COMBINE);
        }
    }
#undef IN
#undef SEAM
}

extern "C" void kernel_launch(void* const* d_in, const int* in_sizes, int n_in, void* d_out, int out_size, void* d_ws, size_t ws_size, hipStream_t stream) {
    static int grid = 0;
    if (grid == 0) {
        if (n_in != 51 || ws_size < WS_END || out_size != NB * SEQ * D) { fprintf(stderr, "kernel_launch: unexpected problem (n_in %d, ws %zu, out %d)\n", n_in, ws_size, out_size); grid = -1; return; }
        int dev = 0, cus = 0;
        if (hipGetDevice(&dev) != hipSuccess || hipDeviceGetAttribute(&cus, hipDeviceAttributeMultiprocessorCount, dev) != hipSuccess) { grid = -1; return; }
        if (hipFuncSetAttribute((const void*)fwd_kernel, hipFuncAttributeMaxDynamicSharedMemorySize, LDS_BYTES) != hipSuccess) { fprintf(stderr, "kernel_launch: hipFuncSetAttribute failed\n"); grid = -1; return; }
        int per_cu = 0;
        if (hipOccupancyMaxActiveBlocksPerMultiprocessor(&per_cu, (const void*)fwd_kernel, 512, LDS_BYTES) != hipSuccess || per_cu < 1) { fprintf(stderr, "kernel_launch: occupancy query says %d\n", per_cu); }
        (void)hipGetLastError();
        grid = cus;
    }
    if (grid < 0) return;
    (void)hipMemsetAsync((char*)d_ws + WS_CTL, 0, CTL_BYTES, stream);
    Args a{};
    const float* const* in = (const float* const*)d_in;
    a.x = in[0]; a.c = in[1]; a.ctx = in[2]; a.cctx = in[3];
    const int base[4] = {4, 14, 26, 40};
    for (int l = 0; l < 4; ++l) { a.w_mod[l] = in[base[l]]; a.b_mod[l] = in[base[l] + 1]; a.g_mix[l] = in[base[l] + 2]; a.g_ffn[l] = in[base[l] + 3]; a.w_router[l] = nullptr; }
    a.q_gain[0] = in[9]; a.k_gain[0] = in[10]; a.q_gain[1] = in[19]; a.k_gain[1] = in[20]; a.q_gain[2] = in[35]; a.k_gain[2] = in[36]; a.q_gain[3] = in[45]; a.k_gain[3] = in[46];
    a.w_router[1] = in[23]; a.w_router[3] = in[48]; a.rel_bias = in[21]; a.g_dq = in[31]; a.g_dkv = in[32];
    a.out = (float*)d_out; a.ws = (unsigned char*)d_ws;
    int nj = 0, item0 = 0;
    auto job = [&](int idx, size_t off, int K, int N, int Nd, int nb, int mode) { Job& j = a.jobs[nj++]; j.src = in[idx]; j.dst_off = off; j.K = K; j.N = N; j.Nd = Nd; j.nb = nb; j.mode = mode; j.item0 = item0; item0 += (nb * K / 64) * (N / 32); };
    job(8, W_QKV0, 1024, 1536, 1536, 1, 0); job(18, W_QKV1, 1024, 3072, 3072, 1, 0); job(30, W_IN, 1024, 672, 768, 1, 0); job(33, W_UQ, 384, 1536, 1536, 1, 0); job(34, W_UKV, 256, 2048, 2048, 1, 0); job(44, W_QKV3, 1024, 1536, 1536, 1, 0);
    job(11, W_O, 1024, 1024, 1024, 1, 0); job(22, W_O + 2 * MiB, 1024, 1024, 1024, 1, 0); job(37, W_O + 4 * MiB, 1024, 1024, 1024, 1, 0); job(47, W_O + 6 * MiB, 1024, 1024, 1024, 1, 0);
    job(12, W_GU, 1024, 2 * FF, 2 * FF, 1, 1); job(38, W_GU + 11 * MiB, 1024, 2 * FF, 2 * FF, 1, 1); job(13, W_DN, FF, 1024, 1024, 1, 0); job(39, W_DN + 11 * MiB / 2, FF, 1024, 1024, 1, 0);
    job(24, WE_GU(0), 1024, 2 * FFE, 2 * FFE, 8, 1); job(25, WE_DN(0), FFE, 1024, 1024, 8, 0); job(49, WE_GU(1), 1024, 2 * FFE, 2 * FFE, 8, 1); job(50, WE_DN(1), FFE, 1024, 1024, 8, 0);
    a.n_items = item0; a.pad = 0;
#if N_LAUNCH_MODE == 1
    a.lo = 0; a.hi = 1 + 16 * 4;
    hipLaunchKernelGGL(fwd_kernel, dim3(grid), dim3(512), LDS_BYTES, stream, a);
#else
    a.lo = 0; a.hi = 1;
    hipLaunchKernelGGL(fwd_kernel, dim3(grid), dim3(512), LDS_BYTES, stream, a);
    for (int l = 0; l < 4; ++l) for (int j = 0; j < 12; ++j) if (phase_exists(l, j)) { a.lo = pid_of(l, j); a.hi = a.lo + 1; hipLaunchKernelGGL(fwd_kernel, dim3(grid), dim3(512), LDS_BYTES, stream, a); }
#endif
}
```

```cpp
#include <hip/hip_runtime.h>
#include <cstdio>
#include <cstdint>

#ifndef FAST_ATTN
#define FAST_ATTN 1
#endif
#ifndef N_LAUNCH_MODE
#define N_LAUNCH_MODE 1
#endif

constexpr int D = 1024, NB = 4, SEQ = 4096, NCTX = 256, SB = SEQ + NCTX  , M = NB * SB  ;
constexpr int NHEAD = 16, HD = 64;
constexpr int FF = 2816, FFE = 3584, NEXP = 8;
constexpr int QLORA = 384, KVLORA = 256, MLA_QK = 96;
constexpr int MAXSLOT = 36864;
constexpr float EPS = 1e-6f;
constexpr float LOG2E = 1.4426950408889634f;
constexpr float C2_64 = 0.125f * LOG2E;
constexpr float C2_96 = 0.10206207261596575f * LOG2E;

constexpr size_t MiB = 1u << 20;
constexpr size_t WS_CTL = 0, CTL_BYTES = 1 * MiB;
constexpr size_t WS_MOD = 1 * MiB;
constexpr size_t WS_ROPE = WS_MOD + 512 * 1024;
constexpr size_t WS_ROUTE = 2 * MiB;
constexpr size_t WS_X = 3 * MiB;
constexpr size_t WS_H = 71 * MiB;
constexpr size_t WS_HP = 105 * MiB;
constexpr size_t WS_ATT = 177 * MiB;
constexpr size_t WS_RAW = WS_ATT;
constexpr size_t WS_QB = WS_ATT + 166 * MiB;
constexpr size_t WS_KB = WS_QB + 51 * MiB;
constexpr size_t WS_VB = WS_KB + 51 * MiB;
constexpr size_t WS_O = WS_VB + 34 * MiB;
constexpr size_t WS_ACT = WS_ATT;
constexpr size_t WS_W = 513 * MiB;
constexpr size_t WS_WE = 571 * MiB;
constexpr size_t WS_END = WS_WE + 2 * 168 * MiB;
constexpr size_t RAW_IN = WS_RAW;
constexpr size_t RAW_CQ = RAW_IN + (size_t)M * 768 * 2;
constexpr size_t RAW_CKV = RAW_CQ + (size_t)M * 384 * 2;
constexpr size_t RAW_Q = RAW_CKV + (size_t)M * 256 * 2;
constexpr size_t RAW_KV = RAW_Q + (size_t)M * 1536 * 2;
static_assert(RAW_KV + (size_t)M * 2048 * 2 <= WS_QB, "raw region");
static_assert(WS_ACT + (size_t)MAXSLOT * FFE * 2 <= WS_W, "act overlay");
constexpr size_t W_QKV0 = WS_W, W_QKV1 = W_QKV0 + 3 * MiB, W_IN = W_QKV1 + 6 * MiB, W_UQ = W_IN + 3 * MiB / 2, W_UKV = W_UQ + 1179648, W_QKV3 = W_UKV + 1 * MiB;
constexpr size_t W_O = W_QKV3 + 3 * MiB;
constexpr size_t W_GU = W_O + 8 * MiB;
constexpr size_t W_DN = W_GU + 22 * MiB;
static_assert(W_DN + 11 * MiB <= WS_WE, "dense weights");
constexpr size_t WE_GU(int i) { return WS_WE + (size_t)i * 168 * MiB; }
constexpr size_t WE_DN(int i) { return WS_WE + (size_t)i * 168 * MiB + 112 * MiB; }
constexpr int CW_CNT = 64;
constexpr int CW_BAR = 4096;

#define LAS __attribute__((address_space(3)))
typedef unsigned short bf16;
typedef float f32x4 __attribute__((ext_vector_type(4)));
typedef float f32x16 __attribute__((ext_vector_type(16)));
typedef short bf16x8 __attribute__((ext_vector_type(8)));
typedef unsigned u32x4 __attribute__((ext_vector_type(4)));
typedef unsigned u32x2 __attribute__((ext_vector_type(2)));
#define DI __device__ __forceinline__
DI float bf2f(unsigned v) { return __uint_as_float(v << 16); }
DI unsigned f2bf(float f) { unsigned u = __float_as_uint(f); return (u + 0x7fffu + ((u >> 16) & 1u)) >> 16; }
DI unsigned pk2(float lo, float hi) { return f2bf(lo) | (f2bf(hi) << 16); }
DI float wave_sum(float v) {
#pragma unroll
    for (int o = 1; o < 64; o <<= 1) v += __shfl_xor(v, o);
    return v;
}
DI void unpack8(const u32x4 w, float* f) {
    f[0] = bf2f(w.x & 0xffffu); f[1] = bf2f(w.x >> 16); f[2] = bf2f(w.y & 0xffffu); f[3] = bf2f(w.y >> 16);
    f[4] = bf2f(w.z & 0xffffu); f[5] = bf2f(w.z >> 16); f[6] = bf2f(w.w & 0xffffu); f[7] = bf2f(w.w >> 16);
}
DI u32x4 pack8(const float* f) { u32x4 w; w.x = pk2(f[0], f[1]); w.y = pk2(f[2], f[3]); w.z = pk2(f[4], f[5]); w.w = pk2(f[6], f[7]); return w; }

#define XB_TMO      128
#define XB_XCNT(j)  (256  + 64 * (j))
#define XB_XSUB(j)  (1280 + 64 * (j))
#define XB_XGEN(j)  (2304 + 64 * (j))
#define XB_TOP      3328
#define XB_TOPGEN   3392
#define XCD_BAR_WORDS 3456
#define XB_SPIN_CAP (1u << 18)
DI unsigned xb_ld(unsigned* p)              { return __hip_atomic_load(p, __ATOMIC_RELAXED, __HIP_MEMORY_SCOPE_AGENT); }
DI unsigned xb_add(unsigned* p, unsigned v) { return __hip_atomic_fetch_add(p, v, __ATOMIC_RELAXED, __HIP_MEMORY_SCOPE_AGENT); }
DI unsigned xb_xcc_id() { return (unsigned)__builtin_amdgcn_s_getreg((3 << 11) | 20) & 0xFu; }
#define XB_SPIN(cond, bar) do { unsigned _sp = 0; while (cond) { __builtin_amdgcn_s_sleep(1); \
    if ((++_sp & 255u) == 0u) { if (xb_ld(&(bar)[XB_TMO])) break; if (_sp > XB_SPIN_CAP) { atomicAdd(&(bar)[XB_TMO], 1u); break; } } } } while (0)
struct XcdBarrier { unsigned* bar; unsigned x; volatile LAS unsigned* st; };
DI XcdBarrier xcd_barrier_post(unsigned* bar, volatile LAS unsigned* st) {
    XcdBarrier b; b.bar = bar; b.x = xb_xcc_id(); b.st = st;
    if (threadIdx.x == 0) (void)xb_add(&bar[XB_XCNT(b.x)], 1u);
    return b;
}
DI void xcd_barrier_complete(unsigned* bar, unsigned x, unsigned& nloc, unsigned& nx) {
    const unsigned G = gridDim.x * gridDim.y * gridDim.z;
    unsigned sum, cnt, mine, sp = 0u;
    for (;;) {
        sum = 0u; cnt = 0u; mine = 0u;
#pragma unroll
        for (unsigned j = 0; j < 16; ++j) { const unsigned c = xb_ld(&bar[XB_XCNT(j)]); sum += c; cnt += (c > 0u) ? 1u : 0u; mine = (j == x) ? c : mine; }
        if (sum == G) break;
        __builtin_amdgcn_s_sleep(1);
        if ((++sp & 255u) == 0u) { if (xb_ld(&bar[XB_TMO])) break; if (sp > XB_SPIN_CAP) { atomicAdd(&bar[XB_TMO], 1u); break; } }
    }
    nloc = mine > 0u ? mine : 1u; nx = cnt > 0u ? cnt : 1u;
}
DI void xcd_barrier(const XcdBarrier& b) {
    asm volatile("s_waitcnt vmcnt(0)" ::: "memory");
    __syncthreads();
    if (threadIdx.x == 0) {
        unsigned* bar = b.bar;
        __builtin_amdgcn_s_waitcnt(0);
        unsigned nloc = b.st[0], nx = b.st[1];
        if (nloc == 0u) { xcd_barrier_complete(bar, b.x, nloc, nx); b.st[0] = nloc; b.st[1] = nx; }
        const unsigned old = xb_add(&bar[XB_XSUB(b.x)], 1u);
        const unsigned gen = old / nloc;
        if (old + 1u == (gen + 1u) * nloc) {
            __builtin_amdgcn_fence(__ATOMIC_RELEASE, "agent");
            asm volatile("s_waitcnt vmcnt(0)" ::: "memory");
            const unsigned og = xb_add(&bar[XB_TOP], 1u);
            const unsigned tg = og / nx;
            if (og + 1u == (tg + 1u) * nx) xb_add(&bar[XB_TOPGEN], 1u);
            else XB_SPIN(xb_ld(&bar[XB_TOPGEN]) == tg, bar);
            __builtin_amdgcn_fence(__ATOMIC_ACQUIRE, "agent");
            xb_add(&bar[XB_XGEN(b.x)], 1u);
            asm volatile("s_waitcnt vmcnt(0)" ::: "memory");
        } else {
            XB_SPIN(xb_ld(&bar[XB_XGEN(b.x)]) == gen, bar);
            __builtin_amdgcn_fence(__ATOMIC_ACQUIRE, "agent");
            asm volatile("s_waitcnt vmcnt(0)" ::: "memory");
        }
    }
    __syncthreads();
}

namespace pg8 {
#define PG8_LAS __attribute__((address_space(3)))
typedef unsigned short bf16_t;
typedef short bf16x8 __attribute__((ext_vector_type(8)));
typedef float f32x4 __attribute__((ext_vector_type(4)));
typedef unsigned u32x4 __attribute__((ext_vector_type(4)));
constexpr int BM = 256, BK = 64, HALF = 128, HTB = HALF * BK * 2  , STAGE_BYTES = 8 * HTB, NXCD = 8, WGM = 8;

__host__ __device__ __forceinline__ int lds_byte(int r, int c) { const int st = (r >> 4) * 2 + (c >> 5), rr = r & 15, cc = c & 31, ob = rr * 64 + cc * 2; return st * 1024 + (ob ^ (((ob >> 9) & 1) << 5)); }
__host__ __device__ __forceinline__ void stage_rc(int b, int& R, int& C) { const int st = b / 1024, sb = b % 1024, swz = sb ^ (((sb >> 9) & 1) << 5); R = (st >> 1) * 16 + swz / 64; C = (st & 1) * 32 + (swz % 64) / 2; }
__host__ __device__ __forceinline__ int perm32(int rho) { const int n = rho >> 4, i = rho & 15; return 8 * (i >> 2) + 4 * n + (i & 3); }

struct Unit { int pm, pn, e; };
struct Gemm { const bf16_t* A; const bf16_t* Bt; int M, N, K; size_t estride; };
struct StaticOrder {
    int nM, nN, nwg, G, c;
    __host__ __device__ void init(int M, int N, int G_, int c_) { nM = M / BM; nN = N / BM; nwg = nM * nN; G = G_; c = c_; }
    __host__ __device__ bool next(int i, Unit& u) const {
        const long L = (long)i * G + c; if (L >= nwg) return false;
        int wgid = (int)L; { const int q = nwg / NXCD, r = nwg % NXCD, xcd = wgid % NXCD, off = wgid / NXCD; wgid = (xcd < r ? xcd * (q + 1) : r * (q + 1) + (xcd - r) * q) + off; }
        const int nig = WGM * nN, gid = wgid / nig, fm = gid * WGM, gsz = (nM - fm) < WGM ? (nM - fm) : WGM;
        u.pm = fm + ((wgid % nig) % gsz); u.pn = (wgid % nig) / gsz; u.e = 0; return true;
    }
    __device__ __forceinline__ void a_ready(const Unit&) const {}
    __device__ __forceinline__ void done(const Unit&) const {}
};

__device__ __forceinline__ unsigned cvt_pk_bf16(float lo, float hi) { unsigned r; asm volatile("v_cvt_pk_bf16_f32 %0, %1, %2" : "=v"(r) : "v"(lo), "v"(hi)); return r; }
struct EpiRaw2 {
    static constexpr bool PERM = true, AFTER_DRAIN = false;
    bf16_t* O; int ldc;
    __device__ __forceinline__ void operator()(const f32x4 (&acc)[2][2][4][2], const Unit& u, int wr, int wc, int fr, int fq) const {
        const int row0 = u.pm * BM + wr * 64 + fr, col0 = u.pn * BM + wc * 32 + 8 * fq;
#pragma unroll
        for (int ai = 0; ai < 2; ++ai)
#pragma unroll
            for (int m = 0; m < 4; ++m) { bf16_t* rowp = O + (size_t)(row0 + ai * HALF + m * 16) * ldc + col0;
#pragma unroll
                for (int bj = 0; bj < 2; ++bj) { const f32x4 v0 = acc[ai][bj][m][0], v1 = acc[ai][bj][m][1];
                    u32x4 w; w.x = cvt_pk_bf16(v0[0], v0[1]); w.y = cvt_pk_bf16(v0[2], v0[3]); w.z = cvt_pk_bf16(v1[0], v1[1]); w.w = cvt_pk_bf16(v1[2], v1[3]);
                    *(u32x4*)(rowp + bj * HALF) = w; } }
    }
};
struct EpiResG {
    static constexpr bool PERM = false, AFTER_DRAIN = false;
    float* X; const float* MOD; int l, gsel;
    __device__ __forceinline__ void operator()(const f32x4 (&acc)[2][2][4][2], const Unit& u, int wr, int wc, int fr, int fq) const {
        const int b = u.pm / 17, s = (u.pm - b * 17 == 0) ? 4 : b;
        const float* gate = MOD + ((size_t)l * 5 + s) * 6144 + gsel * 1024;
        const int col0 = u.pn * BM + wc * 32 + 4 * fq;
        f32x4 gv[2][2];
#pragma unroll
        for (int bj = 0; bj < 2; ++bj)
#pragma unroll
            for (int n = 0; n < 2; ++n) gv[bj][n] = *(const f32x4*)(gate + col0 + bj * HALF + n * 16);
#pragma unroll
        for (int ai = 0; ai < 2; ++ai)
#pragma unroll
            for (int m = 0; m < 4; ++m) { float* rowp = X + (size_t)(u.pm * BM + ai * HALF + wr * 64 + m * 16 + fr) * 1024 + col0;
                f32x4 xv[2][2];
#pragma unroll
                for (int bj = 0; bj < 2; ++bj)
#pragma unroll
                    for (int n = 0; n < 2; ++n) xv[bj][n] = *(const f32x4*)(rowp + bj * HALF + n * 16);
#pragma unroll
                for (int bj = 0; bj < 2; ++bj)
#pragma unroll
                    for (int n = 0; n < 2; ++n) *(f32x4*)(rowp + bj * HALF + n * 16) = xv[bj][n] + gv[bj][n] * acc[ai][bj][m][n];
                asm volatile("" ::: "memory"); }
    }
};
__device__ __forceinline__ float swiglu1(float g, float u) { return g * __builtin_amdgcn_rcpf(1.f + __expf(-g)) * u; }
struct EpiSwiglu {
    static constexpr bool PERM = true, AFTER_DRAIN = false;
    bf16_t* ACT; int Fh;
    __device__ __forceinline__ void operator()(const f32x4 (&acc)[2][2][4][2], const Unit& u, int wr, int wc, int fr, int fq) const {
        const int row0 = u.pm * BM + wr * 64 + fr, f0 = u.pn * HALF + wc * 32 + 8 * fq;
#pragma unroll
        for (int ai = 0; ai < 2; ++ai)
#pragma unroll
            for (int m = 0; m < 4; ++m) { const f32x4 g0 = acc[ai][0][m][0], g1 = acc[ai][0][m][1], u0 = acc[ai][1][m][0], u1 = acc[ai][1][m][1];
                u32x4 w; w.x = cvt_pk_bf16(swiglu1(g0[0], u0[0]), swiglu1(g0[1], u0[1])); w.y = cvt_pk_bf16(swiglu1(g0[2], u0[2]), swiglu1(g0[3], u0[3]));
                w.z = cvt_pk_bf16(swiglu1(g1[0], u1[0]), swiglu1(g1[1], u1[1])); w.w = cvt_pk_bf16(swiglu1(g1[2], u1[2]), swiglu1(g1[3], u1[3]));
                *(u32x4*)(ACT + (size_t)(row0 + ai * HALF + m * 16) * Fh + f0) = w; }
    }
};
struct LatOrder {
    StaticOrder s;
    __device__ void init(int N, int G, int c) { s.init(16384, N, G, c); }
    __device__ __forceinline__ bool next(int i, Unit& u) const { if (!s.next(i, u)) return false; u.pm = u.pm + u.pm / 16 + 1; return true; }
    __device__ __forceinline__ void a_ready(const Unit&) const {}
    __device__ __forceinline__ void done(const Unit&) const {}
};
struct RowOrder {
    StaticOrder s; bool lat;
    __device__ void init(bool lat_, int N, int G, int c) { lat = lat_; s.init(lat_ ? 16384 : 17408, N, G, c); }
    __device__ __forceinline__ bool next(int i, Unit& u) const { if (!s.next(i, u)) return false; if (lat) u.pm = u.pm + u.pm / 16 + 1; return true; }
    __device__ __forceinline__ void a_ready(const Unit&) const {}
    __device__ __forceinline__ void done(const Unit&) const {}
};
struct MoeOrder {
    StaticOrder s; int o1, o2, o3, o4, o5, o6, o7;
    __device__ __forceinline__ bool next(int i, Unit& u) const { if (!s.next(i, u)) return false; const int sl = u.pm * BM;
        u.e = (sl >= o1) + (sl >= o2) + (sl >= o3) + (sl >= o4) + (sl >= o5) + (sl >= o6) + (sl >= o7); return true; }
    __device__ __forceinline__ void a_ready(const Unit&) const {}
    __device__ __forceinline__ void done(const Unit&) const {}
};
template <class Epi, class Sched, bool ALIGN_EPI = false, bool SP2 = false>
__device__ __forceinline__ void gemm_phase(PG8_LAS unsigned char* lds, const Gemm g, const Sched& S, const Epi& E) {
    int tid_ = threadIdx.x; asm volatile("" : "+v"(tid_)); const int tid = tid_, wid = __builtin_amdgcn_readfirstlane(tid >> 6), lane = tid & 63, wr = wid >> 2, wc = wid & 3, fr = lane & 15, fq = lane >> 4;
    const int K = g.K, nt = K / BK;
    unsigned voffA[2], voffB[2];
#pragma unroll
    for (int i = 0; i < 2; ++i) { int R, C; stage_rc(tid * 16 + i * 8192, R, C); const int Rb = Epi::PERM ? ((R & ~31) + perm32(R & 31)) : R;
        voffA[i] = (unsigned)(R * K + C) * 2u; voffB[i] = (unsigned)(Rb * K + C) * 2u; }
    const size_t kstep = (size_t)(BK * 2);
    const size_t hstep = (size_t)HALF * K * 2;
    const size_t tstep = 2 * hstep;
    const unsigned ldsw = (unsigned)wid * 1024u;
    const int aoff = lds_byte(wr * 64 + fr, fq * 8), boff = lds_byte(wc * 32 + fr, fq * 8);
#define PG8_SA(b, h) (((b) * 2 + (h)) * HTB)
#define PG8_SB(b, h) ((4 + (b) * 2 + (h)) * HTB)
#define PG8_STAGE(bufoff, gbase, voff) do { _Pragma("unroll") for (int _i = 0; _i < 2; ++_i) \
        __builtin_amdgcn_global_load_lds((const unsigned*)((const char*)(gbase) + (voff)[_i]), (PG8_LAS unsigned*)(lds + (bufoff) + ldsw + _i * 8192), 16, 0, 0); } while (0)
#define PG8_LDA(dst, b, h) do { _Pragma("unroll") for (int m = 0; m < 4; ++m) _Pragma("unroll") for (int k = 0; k < 2; ++k) dst[m][k] = *(const PG8_LAS bf16x8*)(lds + PG8_SA(b, h) + aoff + m * 2048 + k * 1024); } while (0)
#define PG8_LDB(dst, b, h) do { _Pragma("unroll") for (int n = 0; n < 2; ++n) _Pragma("unroll") for (int k = 0; k < 2; ++k) dst[n][k] = *(const PG8_LAS bf16x8*)(lds + PG8_SB(b, h) + boff + n * 2048 + k * 1024); } while (0)
#define PG8_MMA(ai, bj, At, Bt) do { __builtin_amdgcn_s_setprio(1); _Pragma("unroll") for (int m = 0; m < 4; ++m) _Pragma("unroll") for (int n = 0; n < 2; ++n) _Pragma("unroll") for (int k = 0; k < 2; ++k) \
        acc[ai][bj][m][n] = __builtin_amdgcn_mfma_f32_16x16x32_bf16(Bt[n][k], At[m][k], acc[ai][bj][m][n], 0, 0, 0); __builtin_amdgcn_s_setprio(0); } while (0)
#define PG8_WAIT_V(n) asm volatile("s_waitcnt vmcnt(" #n ")" ::: "memory")
#define PG8_WAIT_L(n) asm volatile("s_waitcnt lgkmcnt(" #n ")" ::: "memory")
#define PG8_BAR __builtin_amdgcn_s_barrier()
#define PG8_SCHED __builtin_amdgcn_sched_barrier(0)
    Unit cur, nxt; int ui = 0;
    if (!S.next(0, cur)) return;
    f32x4 acc[2][2][4][2];
#pragma unroll
    for (int a = 0; a < 2; ++a)
#pragma unroll
        for (int b = 0; b < 2; ++b)
#pragma unroll
            for (int m = 0; m < 4; ++m)
#pragma unroll
                for (int n = 0; n < 2; ++n) acc[a][b][m][n] = (f32x4){0.f, 0.f, 0.f, 0.f};
    bf16x8 At[4][2], B0[2][2], B1[2][2];
    const char* cA = (const char*)g.A + (size_t)cur.pm * tstep; const char* cB = (const char*)g.Bt + (size_t)cur.e * g.estride + (size_t)cur.pn * tstep;
    S.a_ready(cur);
    if constexpr (SP2) {
        PG8_STAGE(PG8_SB(0, 0), cB, voffB); PG8_STAGE(PG8_SB(0, 1), cB + hstep, voffB); PG8_STAGE(PG8_SA(0, 0), cA, voffA); PG8_STAGE(PG8_SA(0, 1), cA + hstep, voffA);
        if (wr == 1) PG8_BAR;
        PG8_WAIT_V(2); PG8_BAR;
        PG8_STAGE(PG8_SB(1, 0), cB + kstep, voffB); PG8_STAGE(PG8_SA(1, 0), cA + kstep, voffA); PG8_STAGE(PG8_SB(1, 1), cB + hstep + kstep, voffB);
        PG8_WAIT_V(6); PG8_BAR;
    } else {
        PG8_STAGE(PG8_SB(0, 0), cB, voffB); PG8_STAGE(PG8_SA(0, 0), cA, voffA); PG8_STAGE(PG8_SB(0, 1), cB + hstep, voffB); PG8_STAGE(PG8_SA(0, 1), cA + hstep, voffA);
        if (wr == 1) PG8_BAR;
        PG8_WAIT_V(4); PG8_BAR;
        PG8_STAGE(PG8_SB(1, 0), cB + kstep, voffB); PG8_STAGE(PG8_SA(1, 0), cA + kstep, voffA); PG8_STAGE(PG8_SB(1, 1), cB + hstep + kstep, voffB);
        PG8_WAIT_V(6); PG8_BAR;
    }
    for (;;) {
        const bool has_next = S.next(ui + 1, nxt);
        const char* nA = has_next ? (const char*)g.A + (size_t)nxt.pm * tstep : cA; const char* nB = has_next ? (const char*)g.Bt + (size_t)nxt.e * g.estride + (size_t)nxt.pn * tstep : cB;
        for (int t = 0; t < nt; t += 2) {
            const bool last = (t == nt - 2);
            const char* a1 = cA + (size_t)(t + 1) * kstep;
            const char* a2 = last ? nA : cA + (size_t)(t + 2) * kstep; const char* b2 = last ? nB : cB + (size_t)(t + 2) * kstep;
            const char* a3 = a2 + kstep; const char* b3 = b2 + kstep;
            if (last && has_next) S.a_ready(nxt);
            if constexpr (SP2) {
            PG8_LDB(B0, 0, 0); PG8_LDB(B1, 0, 1); PG8_SCHED; PG8_LDA(At, 0, 0); PG8_STAGE(PG8_SA(1, 1), a1 + hstep, voffA);
            PG8_WAIT_V(8); PG8_WAIT_L(0); PG8_BAR; PG8_MMA(0, 0, At, B0); PG8_MMA(0, 1, At, B1); PG8_BAR; PG8_SCHED;
            PG8_LDA(At, 0, 1); PG8_STAGE(PG8_SB(0, 0), b2, voffB); PG8_STAGE(PG8_SB(0, 1), b2 + hstep, voffB); PG8_STAGE(PG8_SA(0, 0), a2, voffA);
            PG8_WAIT_V(8); PG8_WAIT_L(0); PG8_BAR; PG8_MMA(1, 0, At, B0); PG8_MMA(1, 1, At, B1); PG8_BAR; PG8_SCHED;
            PG8_LDB(B0, 1, 0); PG8_LDB(B1, 1, 1); PG8_SCHED; PG8_LDA(At, 1, 0); PG8_STAGE(PG8_SA(0, 1), a2 + hstep, voffA);
            PG8_WAIT_V(8); PG8_WAIT_L(0); PG8_BAR; PG8_MMA(0, 0, At, B0); PG8_MMA(0, 1, At, B1); PG8_BAR; PG8_SCHED;
            PG8_LDA(At, 1, 1); PG8_STAGE(PG8_SB(1, 0), b3, voffB); PG8_STAGE(PG8_SB(1, 1), b3 + hstep, voffB); PG8_STAGE(PG8_SA(1, 0), a3, voffA);
            PG8_WAIT_V(8); PG8_WAIT_L(0); PG8_BAR; PG8_MMA(1, 0, At, B0); PG8_MMA(1, 1, At, B1); PG8_BAR; PG8_SCHED;
            } else {
            PG8_LDB(B0, 0, 0); PG8_SCHED; PG8_LDA(At, 0, 0); PG8_STAGE(PG8_SA(1, 1), a1 + hstep, voffA);
            PG8_WAIT_L(8); PG8_BAR; PG8_WAIT_L(0); PG8_MMA(0, 0, At, B0); PG8_BAR; PG8_SCHED;
            PG8_LDB(B1, 0, 1); PG8_STAGE(PG8_SB(0, 0), b2, voffB);
            PG8_BAR; PG8_WAIT_L(0); PG8_MMA(0, 1, At, B1); PG8_BAR;
            PG8_LDA(At, 0, 1); PG8_STAGE(PG8_SA(0, 0), a2, voffA);
            PG8_BAR; PG8_WAIT_L(0); PG8_MMA(1, 0, At, B0); PG8_BAR; PG8_SCHED;
            PG8_STAGE(PG8_SB(0, 1), b2 + hstep, voffB);
            PG8_WAIT_V(6); PG8_BAR; PG8_MMA(1, 1, At, B1); PG8_BAR;
            PG8_LDB(B0, 1, 0); PG8_SCHED; PG8_LDA(At, 1, 0); PG8_STAGE(PG8_SA(0, 1), a2 + hstep, voffA);
            PG8_WAIT_L(8); PG8_BAR; PG8_WAIT_L(0); PG8_MMA(0, 0, At, B0); PG8_BAR; PG8_SCHED;
            PG8_LDB(B1, 1, 1); PG8_STAGE(PG8_SB(1, 0), b3, voffB);
            PG8_BAR; PG8_WAIT_L(0); PG8_MMA(0, 1, At, B1); PG8_BAR;
            PG8_LDA(At, 1, 1); PG8_STAGE(PG8_SA(1, 0), a3, voffA);
            PG8_BAR; PG8_WAIT_L(0); PG8_MMA(1, 0, At, B0); PG8_BAR; PG8_SCHED;
            PG8_STAGE(PG8_SB(1, 1), b3 + hstep, voffB);
            PG8_WAIT_V(6); PG8_BAR; PG8_MMA(1, 1, At, B1); PG8_BAR;
            }
        }
        if constexpr (ALIGN_EPI) { if (wr == 0) PG8_BAR; }
        if constexpr (!Epi::AFTER_DRAIN) { E(acc, cur, wr, wc, fr, fq); S.done(cur); }
        if (!has_next) break;
#pragma unroll
        for (int a = 0; a < 2; ++a)
#pragma unroll
            for (int b = 0; b < 2; ++b)
#pragma unroll
                for (int m = 0; m < 4; ++m)
#pragma unroll
                    for (int n = 0; n < 2; ++n) acc[a][b][m][n] = (f32x4){0.f, 0.f, 0.f, 0.f};
        cur = nxt; cA = nA; cB = nB; ++ui;
        if constexpr (ALIGN_EPI) { if (wr == 1) PG8_BAR; }
    }
    PG8_WAIT_V(0);
    if constexpr (!ALIGN_EPI) { if (wr == 0) PG8_BAR; }
    PG8_BAR;
    if constexpr (Epi::AFTER_DRAIN) { E.fused(acc, cur, wr, wc, fr, fq, lds, wid, lane); S.done(cur); }
#undef PG8_SA
#undef PG8_SB
#undef PG8_STAGE
#undef PG8_LDA
#undef PG8_LDB
#undef PG8_MMA
#undef PG8_WAIT_V
#undef PG8_WAIT_L
#undef PG8_BAR
#undef PG8_SCHED
}
}

constexpr int NJOBS = 18;
struct Job { const float* src; unsigned long long dst_off; int K, N, Nd, nb, mode, item0; };
struct Args {
    const float* x; const float* c; const float* ctx; const float* cctx;
    const float* w_mod[4]; const float* b_mod[4]; const float* g_mix[4]; const float* g_ffn[4];
    const float* q_gain[4]; const float* k_gain[4]; const float* w_router[4];
    const float* rel_bias; const float* g_dq; const float* g_dkv;
    float* out; unsigned char* ws;
    Job jobs[NJOBS];
    int n_items; int lo; int hi; int pad;
};

struct Frame {
    LAS unsigned char* lds;
    int tid, lane, wave, gw, NGW;
    unsigned char* ws;
    float* MOD; float* X; bf16* H;
};
DI void refresh(Frame& F) { int t = threadIdx.x; asm volatile("" : "+v"(t)); F.tid = t; F.lane = t & 63; F.wave = __builtin_amdgcn_readfirstlane(t >> 6); F.gw = blockIdx.x * 8 + F.wave; }
DI int row_mod_idx(int m) { const int b = m / SB, p = m - b * SB; return p < NCTX ? 4 : b; }

DI void conv_item(const Args& a, Frame& F, LAS float* scr, int item) {
    int j = 0;
#pragma unroll 1
    for (int t = 1; t < NJOBS; ++t) if (item >= a.jobs[t].item0) j = t;
    const Job jb = a.jobs[j];
    const int it = item - jb.item0, nblk = jb.N / 32, kb = it / nblk, nbk = it % nblk;
    const int k0g = 64 * kb, n0 = 32 * nbk, e = k0g / jb.K, k0 = k0g - e * jb.K;
    const float* W = jb.src + (size_t)k0g * jb.N + n0;
    const int lane = F.lane;
#pragma unroll 8
    for (int i = 0; i < 32; ++i) { const int kk = 2 * i + (lane >> 5); scr[kk * 33 + (lane & 31)] = W[(size_t)kk * jb.N + (lane & 31)]; }
    asm volatile("s_waitcnt lgkmcnt(0)" ::: "memory");
    int drow = n0;
    if (jb.mode == 1) { const int Fh = jb.N / 2; if (n0 < Fh) drow = (n0 / 128) * 256 + (n0 % 128); else { const int n1 = n0 - Fh; drow = (n1 / 128) * 256 + 128 + (n1 % 128); } }
    bf16* dst = (bf16*)(a.ws + jb.dst_off) + ((size_t)e * jb.Nd + drow) * jb.K + k0;
    const int c = lane & 7;
#pragma unroll
    for (int jj = 0; jj < 4; ++jj) { const int n = (lane >> 3) + 8 * jj; const LAS float* s = scr + (8 * c) * 33 + n;
        u32x4 o; o.x = pk2(s[0 * 33], s[1 * 33]); o.y = pk2(s[2 * 33], s[3 * 33]); o.z = pk2(s[4 * 33], s[5 * 33]); o.w = pk2(s[6 * 33], s[7 * 33]);
        *(u32x4*)(dst + (size_t)n * jb.K + 8 * c) = o; }
    asm volatile("s_waitcnt lgkmcnt(0)" ::: "memory");
}
DI float silu_f(float v) { return v / (1.f + __expf(-v)); }
DI void p0_prologue(const Args& a, Frame& F) {
    refresh(F);
    LAS float* red = (LAS float*)F.lds;
    for (int it = blockIdx.x; it < 4 * 96; it += gridDim.x) {
        const int l = it / 96, j0 = (it % 96) * 64;
        const float* wm = a.w_mod[l] + (size_t)(128 * F.wave) * 6144 + j0 + F.lane;
        float acc[5] = {0.f, 0.f, 0.f, 0.f, 0.f};
#pragma unroll 4
        for (int k = 0; k < 128; ++k) {
            const float w = wm[(size_t)k * 6144]; const int kk = 128 * F.wave + k;
#pragma unroll
            for (int s = 0; s < 4; ++s) acc[s] += silu_f(a.c[s * 1024 + kk]) * w;
            acc[4] += silu_f(a.cctx[kk]) * w;
        }
#pragma unroll
        for (int s = 0; s < 5; ++s) red[(F.wave * 5 + s) * 64 + F.lane] = acc[s];
        __syncthreads();
        if (F.tid < 320) { const int s = F.tid >> 6, ln = F.tid & 63; float t = a.b_mod[l][j0 + ln];
#pragma unroll
            for (int w = 0; w < 8; ++w) t += red[(w * 5 + s) * 64 + ln];
            F.MOD[((size_t)l * 5 + s) * 6144 + j0 + ln] = t; }
        __syncthreads();
    }
    if (blockIdx.x == 0) {
        float* R64 = (float*)(a.ws + WS_ROPE); float* R32 = R64 + 64 * 16 * 2;
        for (int t = F.tid; t < 64 * 16; t += 512) { const int pos = t >> 4, i = t & 15; const float f = expf(-9.210340371976184f * (float)i / 16.f), ang = (float)pos * f; R64[2 * t] = cosf(ang); R64[2 * t + 1] = sinf(ang); }
        for (int t = F.tid; t < 64 * 8; t += 512) { const int pos = t >> 3, i = t & 7; const float f = expf(-9.210340371976184f * (float)i / 8.f), ang = (float)pos * f; R32[2 * t] = cosf(ang); R32[2 * t + 1] = sinf(ang); }
    }
    { u32x4* z = (u32x4*)(a.ws + W_IN + (size_t)672 * 1024 * 2); const int n16 = 96 * 1024 * 2 / 16;
      for (int t = blockIdx.x * 512 + F.tid; t < n16; t += gridDim.x * 512) z[t] = (u32x4){0u, 0u, 0u, 0u}; }
    __syncthreads();
    LAS float* scr = (LAS float*)(F.lds + F.wave * 16384);
    for (int it = F.gw; it < a.n_items; it += F.NGW) conv_item(a, F, scr, it);
}

template <bool ROUTE>
DI void norm_rows(const Args& a, Frame& F, int l, int which  , bool first, bool skip_ctx, int moe_idx) {
    refresh(F);
    const float* gvec = which == 0 ? a.g_mix[l] : a.g_ffn[l];
    f32x4 g[4];
#pragma unroll
    for (int j = 0; j < 4; ++j) g[j] = *(const f32x4*)(gvec + 4 * F.lane + 256 * j);
    for (int m = F.gw; m < M; m += F.NGW) {
        const int b = m / SB, p = m - b * SB; const bool isctx = p < NCTX;
        if (skip_ctx && isctx) continue;
        const float* src = first ? (isctx ? a.ctx + ((size_t)b * NCTX + p) * D : a.x + ((size_t)b * SEQ + (p - NCTX)) * D) : F.X + (size_t)m * D;
        f32x4 v[4]; float ss = 0.f;
#pragma unroll
        for (int j = 0; j < 4; ++j) { v[j] = *(const f32x4*)(src + 4 * F.lane + 256 * j); ss += (v[j].x * v[j].x + v[j].y * v[j].y) + (v[j].z * v[j].z + v[j].w * v[j].w); }
        if (first) {
#pragma unroll
            for (int j = 0; j < 4; ++j) *(f32x4*)(F.X + (size_t)m * D + 4 * F.lane + 256 * j) = v[j];
        }
        const float rstd = 1.0f / sqrtf(wave_sum(ss) * (1.f / D) + EPS);
        const float* md = F.MOD + ((size_t)l * 5 + (isctx ? 4 : b)) * 6144 + (which ? 3072 : 0);
        f32x4 hv[4];
#pragma unroll
        for (int j = 0; j < 4; ++j) { const f32x4 sh = *(const f32x4*)(md + 4 * F.lane + 256 * j), sc = *(const f32x4*)(md + 1024 + 4 * F.lane + 256 * j);
            hv[j] = (v[j] * rstd) * g[j] * (1.f + sc) + sh;
            u32x2 o; o.x = pk2(hv[j].x, hv[j].y); o.y = pk2(hv[j].z, hv[j].w);
            *(u32x2*)(F.H + (size_t)m * D + 4 * F.lane + 256 * j) = o; }
        if (ROUTE) {
            float lg[8] = {0.f, 0.f, 0.f, 0.f, 0.f, 0.f, 0.f, 0.f}; const float* wr = a.w_router[l];
#pragma unroll
            for (int j = 0; j < 4; ++j)
#pragma unroll
                for (int i = 0; i < 4; ++i) { const int k = 4 * F.lane + 256 * j + i; const f32x4 w0 = *(const f32x4*)(wr + (size_t)k * 8), w1 = *(const f32x4*)(wr + (size_t)k * 8 + 4); const float hx = hv[j][i];
                    lg[0] += hx * w0.x; lg[1] += hx * w0.y; lg[2] += hx * w0.z; lg[3] += hx * w0.w; lg[4] += hx * w1.x; lg[5] += hx * w1.y; lg[6] += hx * w1.z; lg[7] += hx * w1.w; }
#pragma unroll
            for (int e = 0; e < 8; ++e) lg[e] = wave_sum(lg[e]);
            int e0 = 0; float v0 = lg[0];
#pragma unroll
            for (int e = 1; e < 8; ++e) if (lg[e] > v0) { v0 = lg[e]; e0 = e; }
            int e1 = -1; float v1 = -INFINITY;
#pragma unroll
            for (int e = 0; e < 8; ++e) if (e != e0 && lg[e] > v1) { v1 = lg[e]; e1 = e; }
            const float ex = __expf(v1 - v0), w0 = 1.f / (1.f + ex), w1 = ex / (1.f + ex);
            if (F.lane == 0) {
                unsigned* cnt = (unsigned*)(a.ws + WS_CTL) + CW_CNT + 64 * moe_idx;
                const unsigned p0 = atomicAdd(cnt + e0, 1u), p1 = atomicAdd(cnt + e1, 1u);
                int* r = (int*)(a.ws + WS_ROUTE) + (size_t)m * 8;
                r[0] = e0; r[1] = e1; r[2] = (int)p0; r[3] = (int)p1; r[4] = __float_as_int(w0); r[5] = __float_as_int(w1);
            }
        }
    }
}

struct MoeOff { int o[9]; };
DI MoeOff moe_offsets(const Args& a, int moe_idx) {
    const unsigned* cnt = (const unsigned*)(a.ws + WS_CTL) + CW_CNT + 64 * moe_idx;
    MoeOff r; r.o[0] = 0;
#pragma unroll
    for (int e = 0; e < 8; ++e) { const int c = (int)__builtin_amdgcn_readfirstlane((int)__hip_atomic_load(cnt + e, __ATOMIC_RELAXED, __HIP_MEMORY_SCOPE_AGENT)); r.o[e + 1] = r.o[e] + ((c + 255) & ~255); }
    return r;
}
DI int moe_off_of(const MoeOff& mo, int e) { int r = 0;
#pragma unroll
    for (int i = 1; i < 8; ++i) if (e >= i) r = mo.o[i];
    return r; }
DI int moe_expert_of_slot(const MoeOff& mo, int slot) { int e = 0;
#pragma unroll
    for (int i = 1; i < 8; ++i) if (slot >= mo.o[i]) e = i;
    return e; }

DI void moe_gather(const Args& a, Frame& F, int moe_idx, bool skip_ctx) {
    refresh(F);
    const MoeOff mo = moe_offsets(a, moe_idx);
    bf16* HP = (bf16*)(a.ws + WS_HP);
    for (int it = F.gw; it < 2 * M; it += F.NGW) {
        const int m = it >> 1, k = it & 1; const int p = m % SB; if (skip_ctx && p < NCTX) continue;
        const int* r = (const int*)(a.ws + WS_ROUTE) + (size_t)m * 8;
        const int e = r[k], pos = r[2 + k]; const int slot = moe_off_of(mo, e) + pos;
        const u32x4* s = (const u32x4*)(F.H + (size_t)m * D); u32x4* d = (u32x4*)(HP + (size_t)slot * D);
        d[F.lane] = s[F.lane]; d[F.lane + 64] = s[F.lane + 64];
    }
}
DI void moe_combine(const Args& a, Frame& F, int l, int moe_idx) {
    refresh(F);
    const MoeOff mo = moe_offsets(a, moe_idx);
    const bf16* Y = (const bf16*)(a.ws + WS_HP);
    const bool last = (l == 3);
    f32x4 g[4];
#pragma unroll
    for (int j = 0; j < 4; ++j) g[j] = last ? (f32x4){0.f, 0.f, 0.f, 0.f} : *(const f32x4*)(a.g_mix[l + 1] + 4 * F.lane + 256 * j);
    for (int m = F.gw; m < M; m += F.NGW) {
        const int b = m / SB, p = m - b * SB; const bool isctx = p < NCTX;
        if (last && isctx) continue;
        const int* r = (const int*)(a.ws + WS_ROUTE) + (size_t)m * 8;
        const int s0 = moe_off_of(mo, r[0]) + r[2], s1 = moe_off_of(mo, r[1]) + r[3]; const float w0 = __int_as_float(r[4]), w1 = __int_as_float(r[5]);
        const float* md = F.MOD + ((size_t)l * 5 + (isctx ? 4 : b)) * 6144 + 5 * 1024;
        f32x4 v[4]; float ss = 0.f;
#pragma unroll
        for (int j = 0; j < 4; ++j) { const int col = 4 * F.lane + 256 * j;
            const u32x2 y0 = *(const u32x2*)(Y + (size_t)s0 * D + col), y1 = *(const u32x2*)(Y + (size_t)s1 * D + col);
            const f32x4 g2 = *(const f32x4*)(md + col); const f32x4 xv = *(const f32x4*)(F.X + (size_t)m * D + col);
            f32x4 f; f.x = w0 * bf2f(y0.x & 0xffffu) + w1 * bf2f(y1.x & 0xffffu); f.y = w0 * bf2f(y0.x >> 16) + w1 * bf2f(y1.x >> 16);
            f.z = w0 * bf2f(y0.y & 0xffffu) + w1 * bf2f(y1.y & 0xffffu); f.w = w0 * bf2f(y0.y >> 16) + w1 * bf2f(y1.y >> 16);
            v[j] = xv + g2 * f; ss += (v[j].x * v[j].x + v[j].y * v[j].y) + (v[j].z * v[j].z + v[j].w * v[j].w); }
        if (last) {
            float* o = a.out + ((size_t)b * SEQ + (p - NCTX)) * D;
#pragma unroll
            for (int j = 0; j < 4; ++j) *(f32x4*)(o + 4 * F.lane + 256 * j) = v[j];
        } else {
#pragma unroll
            for (int j = 0; j < 4; ++j) *(f32x4*)(F.X + (size_t)m * D + 4 * F.lane + 256 * j) = v[j];
            const float rstd = 1.0f / sqrtf(wave_sum(ss) * (1.f / D) + EPS);
            const float* md2 = F.MOD + ((size_t)(l + 1) * 5 + (isctx ? 4 : b)) * 6144;
#pragma unroll
            for (int j = 0; j < 4; ++j) { const f32x4 sh = *(const f32x4*)(md2 + 4 * F.lane + 256 * j), sc = *(const f32x4*)(md2 + 1024 + 4 * F.lane + 256 * j);
                const f32x4 hv = (v[j] * rstd) * g[j] * (1.f + sc) + sh; u32x2 o; o.x = pk2(hv.x, hv.y); o.y = pk2(hv.z, hv.w);
                *(u32x2*)(F.H + (size_t)m * D + 4 * F.lane + 256 * j) = o; }
        }
    }
}

DI void load16(const bf16* p, float* v) { const u32x4 a = *(const u32x4*)p, b = *(const u32x4*)(p + 8); unpack8(a, v); unpack8(b, v + 8); }
DI void store16(bf16* p, const float* v) { *(u32x4*)p = pack8(v); *(u32x4*)(p + 8) = pack8(v + 8); }
DI void rms64_gain(float* v, const float* gain, int part) {
    float ss = 0.f;
#pragma unroll
    for (int i = 0; i < 16; ++i) ss += v[i] * v[i];
    ss += __shfl_xor(ss, 1); ss += __shfl_xor(ss, 2);
    const float r = 1.0f / sqrtf(ss * (1.f / 64.f) + EPS);
#pragma unroll
    for (int i = 0; i < 16; ++i) v[i] = v[i] * r * gain[part * 16 + i];
}
DI void rope64(float* v, const float* R64, int part, int gr, int gc) {
    const int pos = part < 2 ? gr : gc; const float* cs = R64 + pos * 32;
#pragma unroll
    for (int i = 0; i < 16; ++i) { const float other = __shfl_xor(v[i], 1); const float c = cs[2 * i], s = cs[2 * i + 1];
        v[i] = (part & 1) ? (other * s + v[i] * c) : (v[i] * c - other * s); }
}
DI void rms32_rope(float* v, const float* gain  , int part, bool do_rope, const float* R32, int gr, int gc) {
    float ss = 0.f;
#pragma unroll
    for (int i = 0; i < 16; ++i) ss += v[i] * v[i];
    ss += __shfl_xor(ss, 1);
    const float r = 1.0f / sqrtf(ss * (1.f / 32.f) + EPS);
#pragma unroll
    for (int i = 0; i < 16; ++i) v[i] = v[i] * r * gain[part * 16 + i];
    if (do_rope) { const int pos = part == 0 ? gr : gc; const float* cs = R32 + pos * 16;
#pragma unroll
        for (int i = 0; i < 8; ++i) { const float c = cs[2 * i], s = cs[2 * i + 1]; const float x1 = v[i], x2 = v[i + 8]; v[i] = x1 * c - x2 * s; v[i + 8] = x1 * s + x2 * c; } }
}
DI void prep_rows(const Args& a, Frame& F, int l, int kind) {
    refresh(F);
    const float* R64 = (const float*)(a.ws + WS_ROPE); const float* R32 = R64 + 64 * 16 * 2;
    const float* qg = a.q_gain[l]; const float* kg = a.k_gain[l];
    bf16* QB = (bf16*)(a.ws + WS_QB); bf16* KB = (bf16*)(a.ws + WS_KB); bf16* VB = (bf16*)(a.ws + WS_VB);
    const int lane = F.lane, part = lane & 3;
    for (int m = F.gw; m < M; m += F.NGW) {
        const int p = m % SB; const bool isctx = p < NCTX; const int t = isctx ? 0 : p - NCTX; const int gr = t >> 6, gc = t & 63;
        float v[16];
        if (kind == 0) {
            const bf16* raw = (const bf16*)(a.ws + WS_RAW) + (size_t)m * 1536;
            load16(raw + lane * 16, v); rms64_gain(v, qg, part); if (!isctx) rope64(v, R64, part, gr, gc);
#pragma unroll
            for (int i = 0; i < 16; ++i) v[i] *= C2_64;
            store16(QB + (size_t)m * 1024 + lane * 16, v);
            const int l16 = lane & 15;
            load16(raw + 1024 + l16 * 16, v); rms64_gain(v, kg, part); if (!isctx) rope64(v, R64, part, gr, gc);
            if (lane < 16) store16(KB + (size_t)m * 256 + l16 * 16, v);
            if (lane >= 16 && lane < 32) { const u32x4* s = (const u32x4*)(raw + 1280 + l16 * 16); u32x4* d = (u32x4*)(VB + (size_t)m * 256 + l16 * 16); d[0] = s[0]; d[1] = s[1]; }
        } else if (kind == 1) {
            const bf16* raw = (const bf16*)(a.ws + WS_RAW) + (size_t)m * 3072;
            load16(raw + lane * 16, v); rms64_gain(v, qg, part);
#pragma unroll
            for (int i = 0; i < 16; ++i) v[i] *= C2_64;
            store16(QB + (size_t)m * 1024 + lane * 16, v);
            load16(raw + 1024 + lane * 16, v); rms64_gain(v, kg, part); store16(KB + (size_t)m * 1024 + lane * 16, v);
            { const u32x4* s = (const u32x4*)(raw + 2048 + lane * 16); u32x4* d = (u32x4*)(VB + (size_t)m * 1024 + lane * 16); d[0] = s[0]; d[1] = s[1]; }
        } else {
            const bf16* qraw = (const bf16*)(a.ws + RAW_Q) + (size_t)m * 1536; const bf16* kvraw = (const bf16*)(a.ws + RAW_KV) + (size_t)m * 2048; const bf16* rin = (const bf16*)(a.ws + RAW_IN) + (size_t)m * 768;
            const int h = lane >> 2;
            load16(qraw + h * 96 + part * 16, v); rms64_gain(v, qg, part);
#pragma unroll
            for (int i = 0; i < 16; ++i) v[i] *= C2_96;
            store16(QB + (size_t)m * 1536 + h * 96 + part * 16, v);
            { const int h2 = (lane >> 1) & 15, p2 = lane & 1;
              load16(qraw + h2 * 96 + 64 + p2 * 16, v); rms32_rope(v, qg + 64, p2, !isctx, R32, gr, gc);
#pragma unroll
              for (int i = 0; i < 16; ++i) v[i] *= C2_96;
              if (lane < 32) store16(QB + (size_t)m * 1536 + h2 * 96 + 64 + p2 * 16, v); }
            load16(kvraw + h * 128 + part * 16, v); rms64_gain(v, kg, part); store16(KB + (size_t)m * 1536 + h * 96 + part * 16, v);
            { const u32x4* s = (const u32x4*)(kvraw + h * 128 + 64 + part * 16); u32x4* d = (u32x4*)(VB + (size_t)m * 1024 + h * 64 + part * 16); d[0] = s[0]; d[1] = s[1]; }
            { const int h2 = (lane >> 1) & 15, p2 = lane & 1;
              load16(rin + 640 + p2 * 16, v); rms32_rope(v, kg + 64, p2, !isctx, R32, gr, gc);
              if (lane < 32) store16(KB + (size_t)m * 1536 + h2 * 96 + 64 + p2 * 16, v); }
        }
    }
}
DI void mla_mid(const Args& a, Frame& F) {
    refresh(F);
    const int lane = F.lane;
    for (int m = F.gw; m < M; m += F.NGW) {
        const bf16* rin = (const bf16*)(a.ws + RAW_IN) + (size_t)m * 768;
        const unsigned* q3 = (const unsigned*)(rin + 6 * lane); float q[6]; float ss = 0.f;
#pragma unroll
        for (int i = 0; i < 3; ++i) { const unsigned w = q3[i]; q[2 * i] = bf2f(w & 0xffffu); q[2 * i + 1] = bf2f(w >> 16); }
#pragma unroll
        for (int i = 0; i < 6; ++i) ss += q[i] * q[i];
        float r = 1.0f / sqrtf(wave_sum(ss) * (1.f / 384.f) + EPS);
        unsigned* oq = (unsigned*)((bf16*)(a.ws + RAW_CQ) + (size_t)m * 384 + 6 * lane);
#pragma unroll
        for (int i = 0; i < 3; ++i) oq[i] = pk2(q[2 * i] * r * a.g_dq[6 * lane + 2 * i], q[2 * i + 1] * r * a.g_dq[6 * lane + 2 * i + 1]);
        const u32x2 kw = *(const u32x2*)(rin + 384 + 4 * lane); float k[4] = {bf2f(kw.x & 0xffffu), bf2f(kw.x >> 16), bf2f(kw.y & 0xffffu), bf2f(kw.y >> 16)};
        ss = k[0] * k[0] + k[1] * k[1] + k[2] * k[2] + k[3] * k[3];
        r = 1.0f / sqrtf(wave_sum(ss) * (1.f / 256.f) + EPS);
        u32x2 ok; ok.x = pk2(k[0] * r * a.g_dkv[4 * lane], k[1] * r * a.g_dkv[4 * lane + 1]); ok.y = pk2(k[2] * r * a.g_dkv[4 * lane + 2], k[3] * r * a.g_dkv[4 * lane + 3]);
        *(u32x2*)((bf16*)(a.ws + RAW_CKV) + (size_t)m * 256 + 4 * lane) = ok;
    }
}

DI int crow(int r, int hi) { return (r & 3) + 8 * (r >> 2) + 4 * hi; }
struct EpiRaw { bf16* O; int ldc; DI void operator()(int row, int col, float v) const { O[(size_t)row * ldc + col] = (bf16)f2bf(v); } };
struct EpiRes { float* X; const float* MOD; int l; int gsel  ; bool skip_ctx;
    DI void operator()(int row, int col, float v) const { const int b = row / SB, p = row - b * SB; const bool isctx = p < NCTX; if (skip_ctx && isctx) return;
        const float g = MOD[((size_t)l * 5 + (isctx ? 4 : b)) * 6144 + gsel * 1024 + col]; X[(size_t)row * D + col] += g * v; } };
template <class Epi>
DI void sgemm(Frame& F, const bf16* A, const bf16* Bt, int Mrows, int N, int K, const Epi& E) {
    refresh(F);
    const int lane = F.lane, r = lane & 31, hi = lane >> 5; const int ntn = N / 32, ntiles = (Mrows / 32) * ntn;
    for (int it = F.gw; it < ntiles; it += F.NGW) {
        const int mt = it / ntn, nt = it % ntn;
        const bf16* ap = A + (size_t)(mt * 32 + r) * K + 8 * hi; const bf16* bp = Bt + (size_t)(nt * 32 + r) * K + 8 * hi;
        f32x16 acc = {};
#pragma unroll 4
        for (int k0 = 0; k0 < K; k0 += 16) acc = __builtin_amdgcn_mfma_f32_32x32x16_bf16(*(const bf16x8*)(ap + k0), *(const bf16x8*)(bp + k0), acc, 0, 0, 0);
#pragma unroll
        for (int i = 0; i < 16; ++i) E(mt * 32 + crow(i, hi), nt * 32 + r, acc[i]);
    }
}
DI float swiglu_f(float g, float u) { return g / (1.f + __expf(-g)) * u; }
DI void sgemm_swiglu(const Args& a, Frame& F, const bf16* A, const bf16* BtBase, int Mrows, int Fh, int K, bf16* ACT, bool grouped, const MoeOff& mo) {
    refresh(F);
    const int lane = F.lane, r = lane & 31, hi = lane >> 5; const int ntn = Fh / 32, ntiles = (Mrows / 32) * ntn;
    for (int it = F.gw; it < ntiles; it += F.NGW) {
        const int mt = it / ntn, nt = it % ntn, f0 = nt * 32;
        const bf16* Bt = BtBase; if (grouped) Bt += (size_t)moe_expert_of_slot(mo, mt * 32) * (2 * Fh) * K;
        const int grow = (f0 / 128) * 256 + (f0 % 128);
        const bf16* ap = A + (size_t)(mt * 32 + r) * K + 8 * hi; const bf16* bg = Bt + (size_t)(grow + r) * K + 8 * hi; const bf16* bu = bg + (size_t)128 * K;
        f32x16 ag = {}, au = {};
#pragma unroll 2
        for (int k0 = 0; k0 < K; k0 += 16) { const bf16x8 av = *(const bf16x8*)(ap + k0);
            ag = __builtin_amdgcn_mfma_f32_32x32x16_bf16(av, *(const bf16x8*)(bg + k0), ag, 0, 0, 0);
            au = __builtin_amdgcn_mfma_f32_32x32x16_bf16(av, *(const bf16x8*)(bu + k0), au, 0, 0, 0); }
#pragma unroll
        for (int i = 0; i < 16; ++i) ACT[(size_t)(mt * 32 + crow(i, hi)) * Fh + f0 + r] = (bf16)f2bf(swiglu_f(ag[i], au[i]));
    }
}
DI void sgemm_moe_down(Frame& F, const bf16* A, const bf16* BtBase, int Mrows, int K, bf16* Y, const MoeOff& mo) {
    refresh(F);
    const int lane = F.lane, r = lane & 31, hi = lane >> 5; const int ntn = D / 32, ntiles = (Mrows / 32) * ntn;
    for (int it = F.gw; it < ntiles; it += F.NGW) {
        const int mt = it / ntn, nt = it % ntn;
        const bf16* Bt = BtBase + (size_t)moe_expert_of_slot(mo, mt * 32) * D * K;
        const bf16* ap = A + (size_t)(mt * 32 + r) * K + 8 * hi; const bf16* bp = Bt + (size_t)(nt * 32 + r) * K + 8 * hi;
        f32x16 acc = {};
#pragma unroll 4
        for (int k0 = 0; k0 < K; k0 += 16) acc = __builtin_amdgcn_mfma_f32_32x32x16_bf16(*(const bf16x8*)(ap + k0), *(const bf16x8*)(bp + k0), acc, 0, 0, 0);
#pragma unroll
        for (int i = 0; i < 16; ++i) Y[(size_t)(mt * 32 + crow(i, hi)) * D + nt * 32 + r] = (bf16)f2bf(acc[i]);
    }
}

template <int DK>
DI float dot_k(const unsigned* q, const bf16* kp) {
    float s = 0.f;
#pragma unroll
    for (int c = 0; c < DK / 8; ++c) { float kf[8]; unpack8(*(const u32x4*)(kp + 8 * c), kf);
#pragma unroll
        for (int i = 0; i < 4; ++i) { const unsigned w = q[4 * c + i]; s += bf2f(w & 0xffffu) * kf[2 * i]; s += bf2f(w >> 16) * kf[2 * i + 1]; } }
    return s;
}
DI void acc_v(float* o, float alpha, float pw, const bf16* vp) {
#pragma unroll
    for (int c = 0; c < 8; ++c) { float vf[8]; unpack8(*(const u32x4*)(vp + 8 * c), vf);
#pragma unroll
        for (int i = 0; i < 8; ++i) o[8 * c + i] = o[8 * c + i] * alpha + pw * vf[i]; }
}
template <int DK, int KIND>
DI void attn_naive(const Args& a, Frame& F, bool need_ctx) {
    refresh(F);
    const bf16* QB = (const bf16*)(a.ws + WS_QB); const bf16* KB = (const bf16*)(a.ws + WS_KB); const bf16* VB = (const bf16*)(a.ws + WS_VB); bf16* O = (bf16*)(a.ws + WS_O);
    constexpr int QP = NHEAD * DK, KP = KIND == 0 ? 256 : NHEAD * DK, VP = KIND == 0 ? 256 : 1024;
    const int nlat = NB * NHEAD * SEQ, nctx = need_ctx ? NB * NHEAD * NCTX : 0;
    const int gt = blockIdx.x * 512 + F.tid, NT = gridDim.x * 512;
    for (int it = gt; it < nlat + nctx; it += NT) {
        int b, h, p; bool isctx;
        if (it < nlat) { b = it / (NHEAD * SEQ); h = (it / SEQ) % NHEAD; p = NCTX + it % SEQ; isctx = false; }
        else { const int j = it - nlat; b = j / (NHEAD * NCTX); h = (j / NCTX) % NHEAD; p = j % NCTX; isctx = true; }
        const int m = b * SB + p; const int kvh = KIND == 0 ? h / 4 : h;
        unsigned q[DK / 2];
#pragma unroll
        for (int c = 0; c < DK / 8; ++c) { const u32x4 w = *(const u32x4*)(QB + (size_t)m * QP + h * DK + 8 * c); q[4 * c] = w.x; q[4 * c + 1] = w.y; q[4 * c + 2] = w.z; q[4 * c + 3] = w.w; }
        float o[64];
#pragma unroll
        for (int i = 0; i < 64; ++i) o[i] = 0.f;
        float mx = -INFINITY, lsum = 0.f;
        const bf16* kb0 = KB + (size_t)b * SB * KP + kvh * DK; const bf16* vb0 = VB + (size_t)b * SB * VP + kvh * 64;
        const int nk1 = (isctx || KIND == 1) ? NCTX : SB;
        for (int k = 0; k < nk1; ++k) {
            const float s = dot_k<DK>(q, kb0 + (size_t)k * KP); const float mn = fmaxf(mx, s), al = exp2f(mx - mn), pw = exp2f(s - mn);
            lsum = lsum * al + pw; mx = mn; acc_v(o, al, pw, vb0 + (size_t)k * VP);
        }
        if (KIND == 1 && !isctx) {
            const int t = p - NCTX, gr = t >> 6, gc = t & 63; const int r0 = min(max(gr - 4, 0), 56), c0 = min(max(gc - 8, 0), 48);
            const float* bias = a.rel_bias + h * 15 * 31;
            for (int kr = r0; kr < r0 + 8; ++kr) for (int kc = c0; kc < c0 + 16; ++kc) {
                const int k = NCTX + kr * 64 + kc;
                const float s = dot_k<DK>(q, kb0 + (size_t)k * KP) + bias[(kr - gr + 7) * 31 + (kc - gc + 15)] * LOG2E;
                const float mn = fmaxf(mx, s), al = exp2f(mx - mn), pw = exp2f(s - mn);
                lsum = lsum * al + pw; mx = mn; acc_v(o, al, pw, vb0 + (size_t)k * VP);
            }
        }
        const float inv = 1.f / lsum;
#pragma unroll
        for (int c = 0; c < 8; ++c) { float t8[8];
#pragma unroll
            for (int i = 0; i < 8; ++i) t8[i] = o[8 * c + i] * inv;
            *(u32x4*)(O + (size_t)m * 1024 + h * 64 + 8 * c) = pack8(t8); }
    }
}


namespace fa {
typedef __attribute__((address_space(3))) const char* lds_cptr;
typedef short v4i16_t __attribute__((ext_vector_type(4)));
typedef short s16x4 __attribute__((ext_vector_type(4)));
DI s16x4 vtr(lds_cptr p) { return __builtin_bit_cast(s16x4, __builtin_amdgcn_ds_read_tr16_b64_v4i16((__attribute__((address_space(3))) v4i16_t*)p)); }
DI unsigned cvtpk(float lo, float hi) { typedef float f2 __attribute__((ext_vector_type(2))); typedef __bf16 b2 __attribute__((ext_vector_type(2))); f2 v = {lo, hi}; b2 b = __builtin_convertvector(v, b2); return __builtin_bit_cast(unsigned, b); }
DI int clampi(int v, int lo, int hi) { return v < lo ? lo : (v > hi ? hi : v); }
#define FA_MFMA(a, b, c) __builtin_amdgcn_mfma_f32_32x32x16_bf16((a), (b), (c), 0, 0, 0)

template <int DK, int KIND>
DI void attn_fast(const Args& a, Frame& F, bool need_ctx) {
    refresh(F);
    constexpr int QP = NHEAD * DK, KP = KIND == 0 ? 256 : NHEAD * DK, VP = KIND == 0 ? 256 : 1024;
    constexpr int KSLOT = 64 * DK * 2, VSLOT = 8192, ND = DK / 16;
    constexpr int L_K = 0, L_V = 3 * KSLOT, L_WS = L_V + 3 * VSLOT, L_BIAS = L_WS + 2048;
    const bf16* QB = (const bf16*)(a.ws + WS_QB); const bf16* KB = (const bf16*)(a.ws + WS_KB); const bf16* VB = (const bf16*)(a.ws + WS_VB); bf16* O = (bf16*)(a.ws + WS_O);
    const int tid = F.tid, lane = F.lane, wid = F.wave, r32 = lane & 31, hi = lane >> 5;
    LAS unsigned char* lds = F.lds;
    LAS float* wsf = (LAS float*)(lds + L_WS) + wid * 64;
    LAS float* biasL = (LAS float*)(lds + L_BIAS);
    const int G = gridDim.x, bx = blockIdx.x; const int vcu = (G % 8 == 0) ? (bx % 8) * (G / 8) + bx / 8 : bx;
    const int nunits = 1024 + (need_ctx ? 64 : 0);
    const lds_cptr kfp = (lds_cptr)lds + L_K + hi * 1024 + r32 * 16;
    const lds_cptr vfp = (lds_cptr)lds + L_V + ((lane >> 4) & 1) * 32 + (lane & 3) * 8 + (4 * hi + ((lane & 15) >> 2)) * 64;
#pragma unroll 1
    for (int u = vcu; u < nunits; u += G) {
        int b, h, qrow0, nt, kr_lo = 0, gr0 = 0; bool isctx;
        if (u < 1024) { const int bh = u >> 4, qb = u & 15; b = bh >> 4; h = bh & 15; qrow0 = b * SB + NCTX + 256 * qb; isctx = false;
            if (KIND == 1) { gr0 = 4 * qb; kr_lo = clampi(gr0 - 4, 0, 56); const int kr_hi = clampi(gr0 - 1, 0, 56) + 7; nt = 4 + kr_hi - kr_lo + 1; } else nt = SB / 64; }
        else { const int j = u - 1024; b = j >> 4; h = j & 15; qrow0 = b * SB; nt = 4; isctx = true; }
        const int kvh = KIND == 0 ? (h >> 2) : h;
        const bf16* Kh = KB + (size_t)b * SB * KP + kvh * DK; const bf16* Vh = VB + (size_t)b * SB * VP + kvh * 64;
        if (KIND == 1 && !isctx) { for (int i = tid; i < 465; i += 512) biasL[i] = a.rel_bias[h * 465 + i] * LOG2E; }
        bf16x8 qr[ND];
        { const bf16* qp = QB + (size_t)(qrow0 + 32 * wid + r32) * QP + h * DK + 8 * hi;
#pragma unroll
          for (int d0 = 0; d0 < ND; ++d0) qr[d0] = *(const bf16x8*)(qp + 16 * d0); }
#define FA_ISSUE(t, slot) do { const int kr_ = 64 * (t) + ((t) >= 4 ? 64 * kr_lo : 0); \
            __builtin_amdgcn_global_load_lds((const unsigned*)(Kh + (size_t)(kr_ + lane) * KP + wid * 8), (LAS unsigned*)(lds + L_K + (slot) * KSLOT + wid * 1024), 16, 0, 0); \
            if (DK == 96) __builtin_amdgcn_global_load_lds((const unsigned*)(Kh + (size_t)(kr_ + lane) * KP + (8 + (wid & 3)) * 8), (LAS unsigned*)(lds + L_K + (slot) * KSLOT + (8 + (wid & 3)) * 1024), 16, 0, 0); \
            __builtin_amdgcn_global_load_lds((const unsigned*)(Vh + (size_t)(kr_ + 16 * (wid & 3) + (lane >> 2)) * VP + (wid >> 2) * 32 + (lane & 3) * 8), (LAS unsigned*)(lds + L_V + (slot) * VSLOT + wid * 1024), 16, 0, 0); } while (0)
        FA_ISSUE(0, 0); FA_ISSUE(1, 1);
        float m_run = -INFINITY, l_run = 0.f; f32x16 o0 = {}, o1 = {};
        int sl_cur = 0, sl_nn = 2;
#pragma unroll 1
        for (int t = 0; t < nt; ++t) {
            if (t + 1 < nt) { if (DK == 96) asm volatile("s_waitcnt vmcnt(3) lgkmcnt(0)" ::: "memory"); else asm volatile("s_waitcnt vmcnt(2) lgkmcnt(0)" ::: "memory"); }
            else asm volatile("s_waitcnt vmcnt(0) lgkmcnt(0)" ::: "memory");
            __builtin_amdgcn_s_barrier(); asm volatile("" ::: "memory");
            if (t + 2 < nt) FA_ISSUE(t + 2, sl_nn);
            bool active = true; int kr = 0, gr = 0;
            if (KIND == 1 && !isctx && t >= 4) { kr = kr_lo + t - 4; gr = gr0 + (wid >> 1); const int r0 = clampi(gr - 4, 0, 56); active = (kr >= r0) && (kr < r0 + 8); }
            if (active) {
                const lds_cptr kp = kfp + sl_cur * KSLOT; const lds_cptr vp = vfp + sl_cur * VSLOT;
                f32x16 s0 = {}, s1 = {};
#pragma unroll
                for (int d0 = 0; d0 < ND; ++d0) { const bf16x8 k0 = *(const __attribute__((address_space(3))) bf16x8*)(kp + d0 * 2048), k1 = *(const __attribute__((address_space(3))) bf16x8*)(kp + d0 * 2048 + 512);
                    s0 = FA_MFMA(k0, qr[d0], s0); s1 = FA_MFMA(k1, qr[d0], s1); }
                if (KIND == 1 && !isctx && t >= 4) {
                    const int gc = (wid & 1) * 32 + r32, c0 = clampi(gc - 8, 0, 48); const LAS float* bl = biasL + (kr - gr + 7) * 31 + 15 - gc;
#pragma unroll
                    for (int r = 0; r < 16; ++r) { const int kc = crow(r, hi);
                        s0[r] = (kc >= c0 && kc < c0 + 16) ? s0[r] + bl[kc] : -INFINITY;
                        s1[r] = (kc + 32 >= c0 && kc + 32 < c0 + 16) ? s1[r] + bl[kc + 32] : -INFINITY; }
                }
                float rm = fmaxf(s0[0], s1[0]);
#pragma unroll
                for (int r = 1; r < 16; ++r) rm = fmaxf(rm, fmaxf(s0[r], s1[r]));
                { auto rr = __builtin_amdgcn_permlane32_swap(__float_as_uint(rm), __float_as_uint(rm), false, false); rm = fmaxf(__uint_as_float(rr[0]), __uint_as_float(rr[1])); }
                const float mn = fmaxf(m_run, rm);
                if (__any(mn > m_run)) {
                    const float al = __builtin_amdgcn_exp2f(m_run - mn); l_run *= al;
                    if (hi == 0) wsf[r32] = al;
#pragma unroll
                    for (int r = 0; r < 16; ++r) { const float f = wsf[crow(r, hi)]; o0[r] *= f; o1[r] *= f; }
                }
                m_run = mn;
                float ps = 0.f;
#pragma unroll
                for (int r = 0; r < 16; ++r) { s0[r] = __builtin_amdgcn_exp2f(s0[r] - mn); s1[r] = __builtin_amdgcn_exp2f(s1[r] - mn); ps += s0[r] + s1[r]; }
                l_run += ps;
                u32x4 pw[4];
#pragma unroll
                for (int i = 0; i < 4; ++i) { pw[0][i] = cvtpk(s0[2 * i], s0[2 * i + 1]); pw[1][i] = cvtpk(s0[8 + 2 * i], s0[8 + 2 * i + 1]); pw[2][i] = cvtpk(s1[2 * i], s1[2 * i + 1]); pw[3][i] = cvtpk(s1[8 + 2 * i], s1[8 + 2 * i + 1]); }
#pragma unroll
                for (int ks = 0; ks < 4; ++ks) {
                    const s16x4 a0 = vtr(vp + ks * 1024), a1 = vtr(vp + ks * 1024 + 512), b0 = vtr(vp + 4096 + ks * 1024), b1 = vtr(vp + 4096 + ks * 1024 + 512);
                    const bf16x8 v0 = {a0[0], a0[1], a0[2], a0[3], a1[0], a1[1], a1[2], a1[3]}, v1 = {b0[0], b0[1], b0[2], b0[3], b1[0], b1[1], b1[2], b1[3]};
                    const bf16x8 pa = __builtin_bit_cast(bf16x8, pw[ks]);
                    o0 = FA_MFMA(pa, v0, o0); o1 = FA_MFMA(pa, v1, o1);
                }
            }
            sl_cur = sl_cur == 2 ? 0 : sl_cur + 1; sl_nn = sl_nn == 2 ? 0 : sl_nn + 1;
        }
        { auto rr = __builtin_amdgcn_permlane32_swap(__float_as_uint(l_run), __float_as_uint(l_run), false, false); l_run = __uint_as_float(rr[0]) + __uint_as_float(rr[1]); }
        if (hi == 0) wsf[32 + r32] = 1.0f / l_run;
        bf16* Ow = O + (size_t)(qrow0 + 32 * wid) * 1024 + h * 64 + r32;
#pragma unroll
        for (int r = 0; r < 16; ++r) { const int q = crow(r, hi); const float il = wsf[32 + q];
            Ow[(size_t)q * 1024] = (bf16)f2bf(o0[r] * il); Ow[(size_t)q * 1024 + 32] = (bf16)f2bf(o1[r] * il); }
        asm volatile("s_waitcnt lgkmcnt(0)" ::: "memory");
        __builtin_amdgcn_s_barrier(); asm volatile("" ::: "memory");
#undef FA_ISSUE
    }
}
#undef FA_MFMA
}

constexpr int LDS_BYTES = 147456;
constexpr int MISC_OFF = 131072 + 320;
enum { PJ_NORM1 = 0, PJ_QKV = 1, PJ_MLAMID = 2, PJ_MLAUP = 3, PJ_PREP = 4, PJ_ATTN = 5, PJ_WO = 6, PJ_NORM2 = 7, PJ_GATHER = 8, PJ_GU = 9, PJ_DOWN = 10, PJ_COMBINE = 11 };
__host__ __device__ constexpr int pid_of(int l, int j) { return 1 + 16 * l + j; }
__host__ __device__ inline bool phase_exists(int l, int j) {
    const int kind = l % 3; const bool moe = (l & 1) != 0;
    switch (j) {
        case PJ_NORM1: return l == 0 || l == 1 || l == 3;
        case PJ_MLAMID: case PJ_MLAUP: return kind == 2;
        case PJ_GATHER: case PJ_COMBINE: return moe;
        case PJ_QKV: case PJ_PREP: case PJ_ATTN: case PJ_WO: case PJ_NORM2: case PJ_GU: case PJ_DOWN: return true;
        default: return false;
    }
}

__global__ void __launch_bounds__(512, 2) fwd_kernel(Args a) {
    extern __shared__ __attribute__((aligned(16))) unsigned char lds_raw[];
    Frame F;
    F.lds = (LAS unsigned char*)lds_raw;
    F.tid = threadIdx.x; F.lane = F.tid & 63; F.wave = __builtin_amdgcn_readfirstlane(F.tid >> 6);
    F.gw = blockIdx.x * 8 + F.wave; F.NGW = gridDim.x * 8;
    F.ws = a.ws; F.MOD = (float*)(a.ws + WS_MOD); F.X = (float*)(a.ws + WS_X); F.H = (bf16*)(a.ws + WS_H);
    volatile LAS unsigned* MISC = (volatile LAS unsigned*)(F.lds + MISC_OFF);
    if (F.tid < 32) MISC[F.tid] = 0u;
    __syncthreads();
    const int lo = a.lo, hi = a.hi;
    const bool one_launch = (hi - lo) > 1;
    XcdBarrier bar; bar.bar = (unsigned*)(a.ws + WS_CTL) + CW_BAR; bar.x = 0; bar.st = nullptr;
    if (one_launch) bar = xcd_barrier_post((unsigned*)(a.ws + WS_CTL) + CW_BAR, MISC + 8);
#define IN(k) (lo <= (k) && (k) < hi)
#define SEAM(k) do { if (one_launch && IN(k) && (k) + 1 < hi) xcd_barrier(bar); } while (0)

    if (IN(0)) { p0_prologue(a, F); } SEAM(0);

#pragma unroll 1
    for (int l = 0; l < 4; ++l) {
        const int kind = l % 3; const bool moe = (l & 1) != 0; const bool need_ctx = l < 3; const int moe_idx = l >> 1;
        const int P = 1 + 16 * l;
        if (l != 2) { if (IN(P + PJ_NORM1)) norm_rows<false>(a, F, l, 0, l == 0, false, 0); SEAM(P + PJ_NORM1); }
        if (IN(P + PJ_QKV)) {
            const int N = kind == 0 ? 1536 : (kind == 1 ? 3072 : 768);
            const bf16* Wt = (const bf16*)(a.ws + (l == 0 ? W_QKV0 : l == 1 ? W_QKV1 : l == 2 ? W_IN : W_QKV3));
            pg8::Gemm g{F.H, Wt, M, N, D, 0}; pg8::StaticOrder S; S.init(M, N, (int)gridDim.x, (int)blockIdx.x); pg8::EpiRaw2 E{(bf16*)(a.ws + WS_RAW), N};
            pg8::gemm_phase<pg8::EpiRaw2, pg8::StaticOrder, true, true>(F.lds, g, S, E);
        } SEAM(P + PJ_QKV);
        if (kind == 2) {
            if (IN(P + PJ_MLAMID)) mla_mid(a, F); SEAM(P + PJ_MLAMID);
            if (IN(P + PJ_MLAUP)) {
                { pg8::Gemm g{(const bf16*)(a.ws + RAW_CQ), (const bf16*)(a.ws + W_UQ), M, 1536, QLORA, 0}; pg8::StaticOrder S; S.init(M, 1536, (int)gridDim.x, (int)blockIdx.x); pg8::EpiRaw2 E{(bf16*)(a.ws + RAW_Q), 1536};
                  pg8::gemm_phase<pg8::EpiRaw2, pg8::StaticOrder, true, true>(F.lds, g, S, E); }
                { pg8::Gemm g{(const bf16*)(a.ws + RAW_CKV), (const bf16*)(a.ws + W_UKV), M, 2048, KVLORA, 0}; pg8::StaticOrder S; S.init(M, 2048, (int)gridDim.x, (int)blockIdx.x); pg8::EpiRaw2 E{(bf16*)(a.ws + RAW_KV), 2048};
                  pg8::gemm_phase<pg8::EpiRaw2, pg8::StaticOrder, true, true>(F.lds, g, S, E); }
            } SEAM(P + PJ_MLAUP);
        }
        if (IN(P + PJ_PREP)) prep_rows(a, F, l, kind); SEAM(P + PJ_PREP);
        if (IN(P + PJ_ATTN)) {
#if FAST_ATTN
            if (kind == 0) fa::attn_fast<64, 0>(a, F, need_ctx);
            else if (kind == 1) fa::attn_fast<64, 1>(a, F, need_ctx);
            else fa::attn_fast<96, 2>(a, F, need_ctx);
#else
            if (kind == 0) attn_naive<64, 0>(a, F, need_ctx);
            else if (kind == 1) attn_naive<64, 1>(a, F, need_ctx);
            else attn_naive<96, 2>(a, F, need_ctx);
#endif
        } SEAM(P + PJ_ATTN);
        if (IN(P + PJ_WO)) {
            pg8::Gemm g{(const bf16*)(a.ws + WS_O), (const bf16*)(a.ws + W_O + (size_t)l * 2 * MiB), M, D, D, 0}; pg8::RowOrder S; S.init(!need_ctx, D, (int)gridDim.x, (int)blockIdx.x); pg8::EpiResG E{F.X, F.MOD, l, 2};
            pg8::gemm_phase<pg8::EpiResG, pg8::RowOrder, true, true>(F.lds, g, S, E);
        } SEAM(P + PJ_WO);
        if (IN(P + PJ_NORM2)) { if (moe) norm_rows<true>(a, F, l, 1, false, !need_ctx, moe_idx); else norm_rows<false>(a, F, l, 1, false, !need_ctx, 0); } SEAM(P + PJ_NORM2);
        if (!moe) {
            const int di = l >> 1;
            if (IN(P + PJ_GU)) {
                pg8::Gemm g{F.H, (const bf16*)(a.ws + W_GU + (size_t)di * 11 * MiB), M, 2 * FF, D, 0}; pg8::StaticOrder S; S.init(M, 2 * FF, (int)gridDim.x, (int)blockIdx.x); pg8::EpiSwiglu E{(bf16*)(a.ws + WS_ACT), FF};
                pg8::gemm_phase<pg8::EpiSwiglu, pg8::StaticOrder, true, true>(F.lds, g, S, E);
            } SEAM(P + PJ_GU);
            if (IN(P + PJ_DOWN)) {
                pg8::Gemm g{(const bf16*)(a.ws + WS_ACT), (const bf16*)(a.ws + W_DN + (size_t)di * 11 * MiB / 2), M, D, FF, 0}; pg8::RowOrder S; S.init(!need_ctx, D, (int)gridDim.x, (int)blockIdx.x); pg8::EpiResG E{F.X, F.MOD, l, 5};
                pg8::gemm_phase<pg8::EpiResG, pg8::RowOrder, true, true>(F.lds, g, S, E);
            } SEAM(P + PJ_DOWN);
        } else {
            if (IN(P + PJ_GATHER)) moe_gather(a, F, moe_idx, !need_ctx); SEAM(P + PJ_GATHER);
            if (IN(P + PJ_GU)) {
                const MoeOff mo = moe_offsets(a, moe_idx);
                pg8::Gemm g{(const bf16*)(a.ws + WS_HP), (const bf16*)(a.ws + WE_GU(0) + (size_t)moe_idx * 168 * MiB), mo.o[8], 2 * FFE, D, (size_t)2 * FFE * D * 2};
                pg8::MoeOrder S; S.s.init(mo.o[8], 2 * FFE, (int)gridDim.x, (int)blockIdx.x); S.o1 = mo.o[1]; S.o2 = mo.o[2]; S.o3 = mo.o[3]; S.o4 = mo.o[4]; S.o5 = mo.o[5]; S.o6 = mo.o[6]; S.o7 = mo.o[7];
                pg8::EpiSwiglu E{(bf16*)(a.ws + WS_ACT), FFE};
                pg8::gemm_phase<pg8::EpiSwiglu, pg8::MoeOrder, true, true>(F.lds, g, S, E);
            } SEAM(P + PJ_GU);
            if (IN(P + PJ_DOWN)) {
                const MoeOff mo = moe_offsets(a, moe_idx);
                pg8::Gemm g{(const bf16*)(a.ws + WS_ACT), (const bf16*)(a.ws + WE_DN(0) + (size_t)moe_idx * 168 * MiB), mo.o[8], D, FFE, (size_t)D * FFE * 2};
                pg8::MoeOrder S; S.s.init(mo.o[8], D, (int)gridDim.x, (int)blockIdx.x); S.o1 = mo.o[1]; S.o2 = mo.o[2]; S.o3 = mo.o[3]; S.o4 = mo.o[4]; S.o5 = mo.o[5]; S.o6 = mo.o[6]; S.o7 = mo.o[7];
                pg8::EpiRaw2 E{(bf16*)(a.ws + WS_HP), D};
                pg8::gemm_phase<pg8::EpiRaw2, pg8::MoeOrder, true, true>(F.lds, g, S, E);
            } SEAM(P + PJ_DOWN);
            if (IN(P + PJ_COMBINE)) moe_combine(a, F, l, moe_idx); SEAM(P + PJ_COMBINE);
        }
    }
#undef IN
#undef SEAM
}

extern "C" void kernel_launch(void* const* d_in, const int* in_sizes, int n_in, void* d_out, int out_size, void* d_ws, size_t ws_size, hipStream_t stream) {
    static int grid = 0;
    if (grid == 0) {
        if (n_in != 51 || ws_size < WS_END || out_size != NB * SEQ * D) { fprintf(stderr, "kernel_launch: unexpected problem (n_in %d, ws %zu, out %d)\n", n_in, ws_size, out_size); grid = -1; return; }
        int dev = 0, cus = 0;
        if (hipGetDevice(&dev) != hipSuccess || hipDeviceGetAttribute(&cus, hipDeviceAttributeMultiprocessorCount, dev) != hipSuccess) { grid = -1; return; }
        if (hipFuncSetAttribute((const void*)fwd_kernel, hipFuncAttributeMaxDynamicSharedMemorySize, LDS_BYTES) != hipSuccess) { fprintf(stderr, "kernel_launch: hipFuncSetAttribute failed\n"); grid = -1; return; }
        int per_cu = 0;
        if (hipOccupancyMaxActiveBlocksPerMultiprocessor(&per_cu, (const void*)fwd_kernel, 512, LDS_BYTES) != hipSuccess || per_cu < 1) { fprintf(stderr, "kernel_launch: occupancy query says %d\n", per_cu); }
        (void)hipGetLastError();
        grid = cus;
    }
    if (grid < 0) return;
    (void)hipMemsetAsync((char*)d_ws + WS_CTL, 0, CTL_BYTES, stream);
    Args a{};
    const float* const* in = (const float* const*)d_in;
    a.x = in[0]; a.c = in[1]; a.ctx = in[2]; a.cctx = in[3];
    const int base[4] = {4, 14, 26, 40};
    for (int l = 0; l < 4; ++l) { a.w_mod[l] = in[base[l]]; a.b_mod[l] = in[base[l] + 1]; a.g_mix[l] = in[base[l] + 2]; a.g_ffn[l] = in[base[l] + 3]; a.w_router[l] = nullptr; }
    a.q_gain[0] = in[9]; a.k_gain[0] = in[10]; a.q_gain[1] = in[19]; a.k_gain[1] = in[20]; a.q_gain[2] = in[35]; a.k_gain[2] = in[36]; a.q_gain[3] = in[45]; a.k_gain[3] = in[46];
    a.w_router[1] = in[23]; a.w_router[3] = in[48]; a.rel_bias = in[21]; a.g_dq = in[31]; a.g_dkv = in[32];
    a.out = (float*)d_out; a.ws = (unsigned char*)d_ws;
    int nj = 0, item0 = 0;
    auto job = [&](int idx, size_t off, int K, int N, int Nd, int nb, int mode) { Job& j = a.jobs[nj++]; j.src = in[idx]; j.dst_off = off; j.K = K; j.N = N; j.Nd = Nd; j.nb = nb; j.mode = mode; j.item0 = item0; item0 += (nb * K / 64) * (N / 32); };
    job(8, W_QKV0, 1024, 1536, 1536, 1, 0); job(18, W_QKV1, 1024, 3072, 3072, 1, 0); job(30, W_IN, 1024, 672, 768, 1, 0); job(33, W_UQ, 384, 1536, 1536, 1, 0); job(34, W_UKV, 256, 2048, 2048, 1, 0); job(44, W_QKV3, 1024, 1536, 1536, 1, 0);
    job(11, W_O, 1024, 1024, 1024, 1, 0); job(22, W_O + 2 * MiB, 1024, 1024, 1024, 1, 0); job(37, W_O + 4 * MiB, 1024, 1024, 1024, 1, 0); job(47, W_O + 6 * MiB, 1024, 1024, 1024, 1, 0);
    job(12, W_GU, 1024, 2 * FF, 2 * FF, 1, 1); job(38, W_GU + 11 * MiB, 1024, 2 * FF, 2 * FF, 1, 1); job(13, W_DN, FF, 1024, 1024, 1, 0); job(39, W_DN + 11 * MiB / 2, FF, 1024, 1024, 1, 0);
    job(24, WE_GU(0), 1024, 2 * FFE, 2 * FFE, 8, 1); job(25, WE_DN(0), FFE, 1024, 1024, 8, 0); job(49, WE_GU(1), 1024, 2 * FFE, 2 * FFE, 8, 1); job(50, WE_DN(1), FFE, 1024, 1024, 8, 0);
    a.n_items = item0; a.pad = 0;
#if N_LAUNCH_MODE == 1
    a.lo = 0; a.hi = 1 + 16 * 4;
    hipLaunchKernelGGL(fwd_kernel, dim3(grid), dim3(512), LDS_BYTES, stream, a);
#else
    a.lo = 0; a.hi = 1;
    hipLaunchKernelGGL(fwd_kernel, dim3(grid), dim3(512), LDS_BYTES, stream, a);
    for (int l = 0; l < 4; ++l) for (int j = 0; j < 12; ++j) if (phase_exists(l, j)) { a.lo = pid_of(l, j); a.hi = a.lo + 1; hipLaunchKernelGGL(fwd_kernel, dim3(grid), dim3(512), LDS_BYTES, stream, a); }
#endif
}
```

```cpp
#include <hip/hip_runtime.h>
#include <cstdio>
#include <cstdint>

#ifndef PROBE_TMASK
#define PROBE_TMASK 0
#endif
#define TSEL(l, j) ((((PROBE_TMASK) >> (j)) & 1) && (((PROBE_TMASK) >> (16 + (l))) & 1))
#ifndef N_LAUNCH_MODE
#define N_LAUNCH_MODE 1
#endif

constexpr int D = 1024, NB = 4, SEQ = 4096, NCTX = 256, SB = SEQ + NCTX  , M = NB * SB  ;
constexpr int NHEAD = 16, HD = 64;
constexpr int FF = 2816, FFE = 3584, NEXP = 8;
constexpr int QLORA = 384, KVLORA = 256, MLA_QK = 96;
constexpr int MAXSLOT = 36864;
constexpr float EPS = 1e-6f;
constexpr float LOG2E = 1.4426950408889634f;
constexpr float C2_64 = 0.125f * LOG2E;
constexpr float C2_96 = 0.10206207261596575f * LOG2E;

constexpr size_t MiB = 1u << 20;
constexpr size_t WS_CTL = 0, CTL_BYTES = 64 * 1024;
constexpr size_t WS_MOD = 1 * MiB;
constexpr size_t WS_ROPE = WS_MOD + 512 * 1024;
constexpr size_t WS_BOUND = WS_ROPE + 16 * 1024;
constexpr size_t WS_ROUTE = 2 * MiB;
constexpr size_t WS_BC = WS_ROUTE + 768 * 1024;
constexpr size_t WS_X = 3 * MiB;
constexpr size_t WS_H = 71 * MiB;
constexpr size_t WS_HP = 105 * MiB;
constexpr size_t WS_ATT = 177 * MiB;
constexpr size_t WS_RAW = WS_ATT;
constexpr size_t WS_QB = WS_ATT + 166 * MiB;
constexpr size_t WS_KB = WS_QB + 51 * MiB;
constexpr size_t WS_VB = WS_KB + 51 * MiB;
constexpr size_t WS_O = WS_VB + 34 * MiB;
constexpr size_t WS_ACT = WS_ATT;
constexpr size_t WS_SLAB2 = WS_ATT + 252 * MiB;
constexpr size_t WS_SLAB = WS_QB;
constexpr size_t WS_W = 513 * MiB;
constexpr size_t WS_WE = 571 * MiB;
constexpr size_t WS_END = WS_WE + 2 * 168 * MiB;
constexpr size_t RAW_IN = WS_RAW;
constexpr size_t RAW_CQ = RAW_IN + (size_t)M * 768 * 2;
constexpr size_t RAW_CKV = RAW_CQ + (size_t)M * 384 * 2;
constexpr size_t RAW_Q = RAW_CKV + (size_t)M * 256 * 2;
constexpr size_t RAW_KV = RAW_Q + (size_t)M * 1536 * 2;
static_assert(RAW_KV + (size_t)M * 2048 * 2 <= WS_QB, "raw region");
static_assert(WS_ACT + (size_t)MAXSLOT * FFE * 2 <= WS_W, "act overlay");
constexpr size_t W_QKV0 = WS_W, W_QKV1 = W_QKV0 + 3 * MiB, W_IN = W_QKV1 + 6 * MiB, W_UQ = W_IN + 3 * MiB / 2, W_UKV = W_UQ + 1179648, W_QKV3 = W_UKV + 1 * MiB;
constexpr size_t W_O = W_QKV3 + 3 * MiB;
constexpr size_t W_GU = W_O + 8 * MiB;
constexpr size_t W_DN = W_GU + 22 * MiB;
static_assert(W_DN + 11 * MiB <= WS_WE, "dense weights");
constexpr size_t WE_GU(int i) { return WS_WE + (size_t)i * 168 * MiB; }
constexpr size_t WE_DN(int i) { return WS_WE + (size_t)i * 168 * MiB + 112 * MiB; }
constexpr int CW_CNT = 64;
constexpr int CW_BAR = 4096;

#define LAS __attribute__((address_space(3)))
typedef unsigned short bf16;
typedef float f32x4 __attribute__((ext_vector_type(4)));
typedef float f32x16 __attribute__((ext_vector_type(16)));
typedef short bf16x8 __attribute__((ext_vector_type(8)));
typedef unsigned u32x4 __attribute__((ext_vector_type(4)));
typedef unsigned u32x2 __attribute__((ext_vector_type(2)));
#define DI __device__ __forceinline__
DI float bf2f(unsigned v) { return __uint_as_float(v << 16); }
DI unsigned f2bf(float f) { unsigned u = __float_as_uint(f); return (u + 0x7fffu + ((u >> 16) & 1u)) >> 16; }
DI unsigned pk2(float lo, float hi) { return f2bf(lo) | (f2bf(hi) << 16); }
template <int X> DI float swz_xor(float v) { static_assert(X >= 1 && X < 32, "swz_xor"); return __int_as_float(__builtin_amdgcn_ds_swizzle(__float_as_int(v), (X << 10) | 0x1F)); }
DI float wave_sum(float v) {
    v += swz_xor<1>(v); v += swz_xor<2>(v); v += swz_xor<4>(v); v += swz_xor<8>(v); v += swz_xor<16>(v);
    auto rr = __builtin_amdgcn_permlane32_swap(__float_as_uint(v), __float_as_uint(v), false, false);
    return __uint_as_float(rr[0]) + __uint_as_float(rr[1]);
}
DI float wave_max(float v) {
    v = fmaxf(v, swz_xor<1>(v)); v = fmaxf(v, swz_xor<2>(v)); v = fmaxf(v, swz_xor<4>(v)); v = fmaxf(v, swz_xor<8>(v)); v = fmaxf(v, swz_xor<16>(v));
    auto rr = __builtin_amdgcn_permlane32_swap(__float_as_uint(v), __float_as_uint(v), false, false);
    return fmaxf(__uint_as_float(rr[0]), __uint_as_float(rr[1]));
}
DI void unpack8(const u32x4 w, float* f) {
    f[0] = bf2f(w.x & 0xffffu); f[1] = bf2f(w.x >> 16); f[2] = bf2f(w.y & 0xffffu); f[3] = bf2f(w.y >> 16);
    f[4] = bf2f(w.z & 0xffffu); f[5] = bf2f(w.z >> 16); f[6] = bf2f(w.w & 0xffffu); f[7] = bf2f(w.w >> 16);
}
DI f32x4 ldx4(const bf16* p) { const u32x2 w = *(const u32x2*)p; return (f32x4){bf2f(w.x & 0xffffu), bf2f(w.x >> 16), bf2f(w.y & 0xffffu), bf2f(w.y >> 16)}; }
DI void stx4(bf16* p, const f32x4 v) { u32x2 w; w.x = pk2(v.x, v.y); w.y = pk2(v.z, v.w); *(u32x2*)p = w; }
DI u32x4 pack8(const float* f) { u32x4 w; w.x = pk2(f[0], f[1]); w.y = pk2(f[2], f[3]); w.z = pk2(f[4], f[5]); w.w = pk2(f[6], f[7]); return w; }

#define XB_TMO      128
#define XB_XCNT(j)  (256  + 64 * (j))
#define XB_XSUB(j)  (1280 + 64 * (j))
#define XB_XGEN(j)  (2304 + 64 * (j))
#define XB_TOP      3328
#define XB_TOPGEN   3392
#define XCD_BAR_WORDS 3456
#define XB_SPIN_CAP (1u << 18)
DI unsigned xb_ld(unsigned* p)              { return __hip_atomic_load(p, __ATOMIC_RELAXED, __HIP_MEMORY_SCOPE_AGENT); }
DI unsigned xb_add(unsigned* p, unsigned v) { return __hip_atomic_fetch_add(p, v, __ATOMIC_RELAXED, __HIP_MEMORY_SCOPE_AGENT); }
DI unsigned xb_xcc_id() { return (unsigned)__builtin_amdgcn_s_getreg((3 << 11) | 20) & 0xFu; }
#define XB_SPIN(cond, bar) do { unsigned _sp = 0; while (cond) { __builtin_amdgcn_s_sleep(1); \
    if ((++_sp & 255u) == 0u) { if (xb_ld(&(bar)[XB_TMO])) break; if (_sp > XB_SPIN_CAP) { atomicAdd(&(bar)[XB_TMO], 1u); break; } } } } while (0)
struct XcdBarrier { unsigned* bar; unsigned x; volatile LAS unsigned* st; };
DI XcdBarrier xcd_barrier_post(unsigned* bar, volatile LAS unsigned* st) {
    XcdBarrier b; b.bar = bar; b.x = xb_xcc_id(); b.st = st;
    if (threadIdx.x == 0) (void)xb_add(&bar[XB_XCNT(b.x)], 1u);
    return b;
}
DI void xcd_barrier_complete(unsigned* bar, unsigned x, unsigned& nloc, unsigned& nx) {
    const unsigned G = gridDim.x * gridDim.y * gridDim.z;
    unsigned sum, cnt, mine, sp = 0u;
    for (;;) {
        sum = 0u; cnt = 0u; mine = 0u;
#pragma unroll
        for (unsigned j = 0; j < 16; ++j) { const unsigned c = xb_ld(&bar[XB_XCNT(j)]); sum += c; cnt += (c > 0u) ? 1u : 0u; mine = (j == x) ? c : mine; }
        if (sum == G) break;
        __builtin_amdgcn_s_sleep(1);
        if ((++sp & 255u) == 0u) { if (xb_ld(&bar[XB_TMO])) break; if (sp > XB_SPIN_CAP) { atomicAdd(&bar[XB_TMO], 1u); break; } }
    }
    nloc = mine > 0u ? mine : 1u; nx = cnt > 0u ? cnt : 1u;
}
DI void xcd_barrier(const XcdBarrier& b) {
    asm volatile("s_waitcnt vmcnt(0)" ::: "memory");
    __syncthreads();
    if (threadIdx.x == 0) {
        unsigned* bar = b.bar;
        __builtin_amdgcn_s_waitcnt(0);
        unsigned nloc = b.st[0], nx = b.st[1];
        if (nloc == 0u) { xcd_barrier_complete(bar, b.x, nloc, nx); b.st[0] = nloc; b.st[1] = nx; }
        const unsigned old = xb_add(&bar[XB_XSUB(b.x)], 1u);
        const unsigned gen = old / nloc;
        if (old + 1u == (gen + 1u) * nloc) {
            __builtin_amdgcn_fence(__ATOMIC_RELEASE, "agent");
            asm volatile("s_waitcnt vmcnt(0)" ::: "memory");
            const unsigned og = xb_add(&bar[XB_TOP], 1u);
            const unsigned tg = og / nx;
            if (og + 1u == (tg + 1u) * nx) xb_add(&bar[XB_TOPGEN], 1u);
            else XB_SPIN(xb_ld(&bar[XB_TOPGEN]) == tg, bar);
            __builtin_amdgcn_fence(__ATOMIC_ACQUIRE, "agent");
            xb_add(&bar[XB_XGEN(b.x)], 1u);
            asm volatile("s_waitcnt vmcnt(0)" ::: "memory");
        } else {
            XB_SPIN(xb_ld(&bar[XB_XGEN(b.x)]) == gen, bar);
            __builtin_amdgcn_fence(__ATOMIC_ACQUIRE, "agent");
            asm volatile("s_waitcnt vmcnt(0)" ::: "memory");
        }
    }
    __syncthreads();
}

namespace pg8 {
#define PG8_LAS __attribute__((address_space(3)))
typedef unsigned short bf16_t;
typedef short bf16x8 __attribute__((ext_vector_type(8)));
typedef float f32x4 __attribute__((ext_vector_type(4)));
typedef unsigned u32x4 __attribute__((ext_vector_type(4)));
constexpr int BM = 256, BK = 64, HALF = 128, HTB = HALF * BK * 2  , STAGE_BYTES = 8 * HTB, NXCD = 8, WGM = 4;

__host__ __device__ __forceinline__ int lds_byte(int r, int c) { const int st = (r >> 4) * 2 + (c >> 5), rr = r & 15, cc = c & 31, ob = rr * 64 + cc * 2; return st * 1024 + (ob ^ (((ob >> 9) & 1) << 5)); }
__host__ __device__ __forceinline__ void stage_rc(int b, int& R, int& C) { const int st = b / 1024, sb = b % 1024, swz = sb ^ (((sb >> 9) & 1) << 5); R = (st >> 1) * 16 + swz / 64; C = (st & 1) * 32 + (swz % 64) / 2; }
__host__ __device__ __forceinline__ int perm32(int rho) { const int n = rho >> 4, i = rho & 15; return 8 * (i >> 2) + 4 * n + (i & 3); }

struct Unit { int pm, pn, e, koff, aux; };
struct Gemm { const bf16_t* A; const bf16_t* Bt; int M, N, K; size_t estride; int Kloop; };
struct StaticOrder {
    int nM, nN, nwg, G, c;
    __host__ __device__ void init(int M, int N, int G_, int c_) { nM = M / BM; nN = N / BM; nwg = nM * nN; G = G_; c = c_; }
    __host__ __device__ bool next(int i, Unit& u) const {
        const long L = (long)i * G + c; if (L >= nwg) return false;
        int wgid = (int)L; { const int q = nwg / NXCD, r = nwg % NXCD, xcd = wgid % NXCD, off = wgid / NXCD; wgid = (xcd < r ? xcd * (q + 1) : r * (q + 1) + (xcd - r) * q) + off; }
        const int nig = WGM * nN, gid = wgid / nig, fm = gid * WGM, gsz = (nM - fm) < WGM ? (nM - fm) : WGM;
        u.pm = fm + ((wgid % nig) % gsz); u.pn = (wgid % nig) / gsz; u.e = 0; u.koff = 0; u.aux = 0; return true;
    }
    __device__ __forceinline__ void a_ready(const Unit&) const {}
    __device__ __forceinline__ void done(const Unit&) const {}
};

__device__ __forceinline__ unsigned cvt_pk_bf16(float lo, float hi) { unsigned r; asm volatile("v_cvt_pk_bf16_f32 %0, %1, %2" : "=v"(r) : "v"(lo), "v"(hi)); return r; }
struct EpiRaw2 {
    static constexpr bool PERM = true, AFTER_DRAIN = false;
    bf16_t* O; int ldc;
    __device__ __forceinline__ void operator()(const f32x4 (&acc)[2][2][4][2], const Unit& u, int wr, int wc, int fr, int fq) const {
        const int row0 = u.pm * BM + wr * 64 + fr, col0 = u.pn * BM + wc * 32 + 8 * fq;
#pragma unroll
        for (int ai = 0; ai < 2; ++ai)
#pragma unroll
            for (int m = 0; m < 4; ++m) { bf16_t* rowp = O + (size_t)(row0 + ai * HALF + m * 16) * ldc + col0;
#pragma unroll
                for (int bj = 0; bj < 2; ++bj) { const f32x4 v0 = acc[ai][bj][m][0], v1 = acc[ai][bj][m][1];
                    u32x4 w; w.x = cvt_pk_bf16(v0[0], v0[1]); w.y = cvt_pk_bf16(v0[2], v0[3]); w.z = cvt_pk_bf16(v1[0], v1[1]); w.w = cvt_pk_bf16(v1[2], v1[3]);
                    *(u32x4*)(rowp + bj * HALF) = w; } }
    }
};
struct EpiQkvK {
    static constexpr bool PERM = true, AFTER_DRAIN = false;
    bf16_t* O; int ldc; int kt_lo, kt_hi; bf16_t* KB; int kbp; const float* kg; const float* R64; bool rope; PG8_LAS float* scr; bool krope;
    __device__ __forceinline__ void operator()(const f32x4 (&acc)[2][2][4][2], const Unit& u, int wr, int wc, int fr_, int fq_) const {
        int fr = fr_, fq = fq_; asm volatile("" : "+v"(fr), "+v"(fq));
        const int row0 = u.pm * BM + wr * 64 + fr, col0 = u.pn * BM + wc * 32 + 8 * fq;
#pragma unroll
        for (int ai = 0; ai < 2; ++ai)
#pragma unroll
            for (int m = 0; m < 4; ++m) { bf16_t* rowp = O + (size_t)(row0 + ai * HALF + m * 16) * ldc + col0;
#pragma unroll
                for (int bj = 0; bj < 2; ++bj) { const f32x4 v0 = acc[ai][bj][m][0], v1 = acc[ai][bj][m][1];
                    u32x4 w; w.x = cvt_pk_bf16(v0[0], v0[1]); w.y = cvt_pk_bf16(v0[2], v0[3]); w.z = cvt_pk_bf16(v1[0], v1[1]); w.w = cvt_pk_bf16(v1[2], v1[3]);
                    *(u32x4*)(rowp + bj * HALF) = w; } }
        if (krope && u.pn == 2 && wc == 0) {
            const float* R32 = R64 + 64 * 16 * 2; const int c8 = 8 * fq;
            const f32x4 g0 = *(const f32x4*)(kg + 64 + c8), g1 = *(const f32x4*)(kg + 64 + c8 + 4);
            const int bt = u.pm / 17, jt = u.pm - bt * 17; const bool lat = (jt != 0);
#pragma unroll
            for (int ai = 0; ai < 2; ++ai)
#pragma unroll
                for (int m = 0; m < 4; ++m) { const int rl = ai * HALF + wr * 64 + m * 16 + fr;
                    f32x4 a = acc[ai][1][m][0], b = acc[ai][1][m][1];
                    float ss = (a[0] * a[0] + a[1] * a[1]) + (a[2] * a[2] + a[3] * a[3]) + (b[0] * b[0] + b[1] * b[1]) + (b[2] * b[2] + b[3] * b[3]);
                    ss += __int_as_float(__builtin_amdgcn_ds_swizzle(__float_as_int(ss), (16 << 10) | 0x1F));
                    { auto rr = __builtin_amdgcn_permlane32_swap(__float_as_uint(ss), __float_as_uint(ss), false, false); ss = __uint_as_float(rr[0]) + __uint_as_float(rr[1]); }
                    const float rs = 1.0f / sqrtf(ss * (1.f / 32.f) + 1e-6f);
                    a = a * rs * g0; b = b * rs * g1;
                    if (lat) { const int t = (jt - 1) * 256 + rl; const int pos = (fq >> 1) ? (t & 63) : (t >> 6);
                        const float* cs = R32 + (size_t)pos * 16; const f32x4 q0 = *(const f32x4*)cs, q1 = *(const f32x4*)(cs + 4), q2 = *(const f32x4*)(cs + 8), q3 = *(const f32x4*)(cs + 12);
                        const f32x4 c0 = {q0[0], q0[2], q1[0], q1[2]}, s0 = {q0[1], q0[3], q1[1], q1[3]}, c1 = {q2[0], q2[2], q3[0], q3[2]}, s1 = {q2[1], q2[3], q3[1], q3[3]};
                        f32x4 oa, ob;
#pragma unroll
                        for (int i = 0; i < 4; ++i) { oa[i] = __int_as_float(__builtin_amdgcn_ds_swizzle(__float_as_int(a[i]), (16 << 10) | 0x1F)); ob[i] = __int_as_float(__builtin_amdgcn_ds_swizzle(__float_as_int(b[i]), (16 << 10) | 0x1F)); }
                        if (fq & 1) { a = oa * s0 + a * c0; b = ob * s1 + b * c1; } else { a = a * c0 - oa * s0; b = b * c1 - ob * s1; } }
                    u32x4 w; w.x = cvt_pk_bf16(a[0], a[1]); w.y = cvt_pk_bf16(a[2], a[3]); w.z = cvt_pk_bf16(b[0], b[1]); w.w = cvt_pk_bf16(b[2], b[3]);
                    bf16_t* kr = KB + (size_t)(u.pm * BM + rl) * 1536 + 64 + c8;
#pragma unroll
                    for (int h = 0; h < 16; ++h) *(u32x4*)(kr + h * 96) = w; }
        }
        if (u.pn < kt_lo || u.pn >= kt_hi) return;
        const int wid = wr * 4 + wc, hi = fq >> 1;
        int frl = fr; asm volatile("" : "+v"(frl));
        PG8_LAS float* sown = scr + (wid * 2) * 8 * 16 + frl; PG8_LAS float* soth = scr + ((wid ^ 1) * 2) * 8 * 16 + frl;
#pragma unroll
        for (int ai = 0; ai < 2; ++ai)
#pragma unroll
            for (int m = 0; m < 4; ++m)
#pragma unroll
                for (int bj = 0; bj < 2; ++bj) { const f32x4 a = acc[ai][bj][m][0], b = acc[ai][bj][m][1];
                    float ss = (a[0] * a[0] + a[1] * a[1]) + (a[2] * a[2] + a[3] * a[3]) + (b[0] * b[0] + b[1] * b[1]) + (b[2] * b[2] + b[3] * b[3]);
                    ss += __int_as_float(__builtin_amdgcn_ds_swizzle(__float_as_int(ss), (16 << 10) | 0x1F));
                    { auto rr = __builtin_amdgcn_permlane32_swap(__float_as_uint(ss), __float_as_uint(ss), false, false); ss = __uint_as_float(rr[0]) + __uint_as_float(rr[1]); }
                    if (fq == 0) sown[(bj * 8 + ai * 4 + m) * 16] = ss; }
        asm volatile("s_waitcnt lgkmcnt(0)" ::: "memory"); __builtin_amdgcn_s_barrier(); asm volatile("" ::: "memory");
        const int cw = (wc & 1) * 32 + 8 * fq;
        f32x4 g0 = *(const f32x4*)(kg + cw), g1 = *(const f32x4*)(kg + cw + 4);
        const int bt = u.pm / 17, jt = u.pm - bt * 17; const bool lat = rope && (jt != 0);
#pragma unroll
        for (int ai = 0; ai < 2; ++ai)
#pragma unroll
            for (int m = 0; m < 4; ++m) {
                const int rl = ai * HALF + wr * 64 + m * 16 + fr;
                const int t = (jt - 1) * 256 + rl; const int pos = (wc & 1) ? (t & 63) : (t >> 6);
                f32x4 c0 = {1.f, 1.f, 1.f, 1.f}, c1 = c0, s0 = {0.f, 0.f, 0.f, 0.f}, s1 = s0;
                if (lat) { const float* cs = R64 + ((size_t)pos * 16 + ((8 * fq) & 15)) * 2; const f32x4 q0 = *(const f32x4*)cs, q1 = *(const f32x4*)(cs + 4), q2 = *(const f32x4*)(cs + 8), q3 = *(const f32x4*)(cs + 12);
                    c0 = (f32x4){q0[0], q0[2], q1[0], q1[2]}; s0 = (f32x4){q0[1], q0[3], q1[1], q1[3]}; c1 = (f32x4){q2[0], q2[2], q3[0], q3[2]}; s1 = (f32x4){q2[1], q2[3], q3[1], q3[3]}; }
#pragma unroll
                for (int bj = 0; bj < 2; ++bj) {
                    const float tot = sown[(bj * 8 + ai * 4 + m) * 16] + soth[(bj * 8 + ai * 4 + m) * 16];
                    const float rs = 1.0f / sqrtf(tot * (1.f / 64.f) + 1e-6f);
                    f32x4 a = acc[ai][bj][m][0] * rs * g0, b = acc[ai][bj][m][1] * rs * g1;
                    if (lat) { f32x4 oa, ob;
#pragma unroll
                        for (int i = 0; i < 4; ++i) { { auto rr = __builtin_amdgcn_permlane32_swap(__float_as_uint(a[i]), __float_as_uint(a[i]), false, false); oa[i] = __uint_as_float(hi ? rr[0] : rr[1]); }
                                                      { auto rr = __builtin_amdgcn_permlane32_swap(__float_as_uint(b[i]), __float_as_uint(b[i]), false, false); ob[i] = __uint_as_float(hi ? rr[0] : rr[1]); } }
                        a = hi ? (oa * s0 + a * c0) : (a * c0 - oa * s0); b = hi ? (ob * s1 + b * c1) : (b * c1 - ob * s1); }
                    u32x4 w; w.x = cvt_pk_bf16(a[0], a[1]); w.y = cvt_pk_bf16(a[2], a[3]); w.z = cvt_pk_bf16(b[0], b[1]); w.w = cvt_pk_bf16(b[2], b[3]);
                    const int head = (u.pn - kt_lo) * 4 + bj * 2 + (wc >> 1);
                    *(u32x4*)(KB + (size_t)(u.pm * BM + rl) * kbp + head * 64 + cw) = w; }
            }
        asm volatile("s_waitcnt lgkmcnt(0)" ::: "memory"); __builtin_amdgcn_s_barrier(); asm volatile("" ::: "memory");
    }
};
struct EpiUkvK {
    static constexpr bool PERM = true, AFTER_DRAIN = false;
    bf16_t* O; int ldc; bf16_t* KB; const float* kg; PG8_LAS float* scr;
    __device__ __forceinline__ void operator()(const f32x4 (&acc)[2][2][4][2], const Unit& u, int wr, int wc, int fr_, int fq_) const {
        int fr = fr_, fq = fq_; asm volatile("" : "+v"(fr), "+v"(fq));
        const int row0 = u.pm * BM + wr * 64 + fr, col0 = u.pn * BM + wc * 32 + 8 * fq;
#pragma unroll
        for (int ai = 0; ai < 2; ++ai)
#pragma unroll
            for (int m = 0; m < 4; ++m) { bf16_t* rowp = O + (size_t)(row0 + ai * HALF + m * 16) * ldc + col0;
#pragma unroll
                for (int bj = 0; bj < 2; ++bj) { const f32x4 v0 = acc[ai][bj][m][0], v1 = acc[ai][bj][m][1];
                    u32x4 w; w.x = cvt_pk_bf16(v0[0], v0[1]); w.y = cvt_pk_bf16(v0[2], v0[3]); w.z = cvt_pk_bf16(v1[0], v1[1]); w.w = cvt_pk_bf16(v1[2], v1[3]);
                    *(u32x4*)(rowp + bj * HALF) = w; } }
        const int wid = wr * 4 + wc; const bool kw = wc < 2;
        int frl = fr; asm volatile("" : "+v"(frl));
        PG8_LAS float* sown = scr + (wid * 2) * 8 * 16 + frl; PG8_LAS float* soth = scr + ((wid ^ 1) * 2) * 8 * 16 + frl;
        if (kw) {
#pragma unroll
            for (int ai = 0; ai < 2; ++ai)
#pragma unroll
                for (int m = 0; m < 4; ++m)
#pragma unroll
                    for (int bj = 0; bj < 2; ++bj) { const f32x4 a = acc[ai][bj][m][0], b = acc[ai][bj][m][1];
                        float ss = (a[0] * a[0] + a[1] * a[1]) + (a[2] * a[2] + a[3] * a[3]) + (b[0] * b[0] + b[1] * b[1]) + (b[2] * b[2] + b[3] * b[3]);
                        ss += __int_as_float(__builtin_amdgcn_ds_swizzle(__float_as_int(ss), (16 << 10) | 0x1F));
                        { auto rr = __builtin_amdgcn_permlane32_swap(__float_as_uint(ss), __float_as_uint(ss), false, false); ss = __uint_as_float(rr[0]) + __uint_as_float(rr[1]); }
                        if (fq == 0) sown[(bj * 8 + ai * 4 + m) * 16] = ss; }
        }
        asm volatile("s_waitcnt lgkmcnt(0)" ::: "memory"); __builtin_amdgcn_s_barrier(); asm volatile("" ::: "memory");
        if (kw) {
            const int cw = wc * 32 + 8 * fq;
            const f32x4 g0 = *(const f32x4*)(kg + cw), g1 = *(const f32x4*)(kg + cw + 4);
#pragma unroll
            for (int ai = 0; ai < 2; ++ai)
#pragma unroll
                for (int m = 0; m < 4; ++m) { const int rl = ai * HALF + wr * 64 + m * 16 + fr;
#pragma unroll
                    for (int bj = 0; bj < 2; ++bj) {
                        const float tot = sown[(bj * 8 + ai * 4 + m) * 16] + soth[(bj * 8 + ai * 4 + m) * 16];
                        const float rs = 1.0f / sqrtf(tot * (1.f / 64.f) + 1e-6f);
                        const f32x4 a = acc[ai][bj][m][0] * rs * g0, b = acc[ai][bj][m][1] * rs * g1;
                        u32x4 w; w.x = cvt_pk_bf16(a[0], a[1]); w.y = cvt_pk_bf16(a[2], a[3]); w.z = cvt_pk_bf16(b[0], b[1]); w.w = cvt_pk_bf16(b[2], b[3]);
                        *(u32x4*)(KB + (size_t)(u.pm * BM + rl) * 1536 + (2 * u.pn + bj) * 96 + cw) = w; } }
        }
        asm volatile("s_waitcnt lgkmcnt(0)" ::: "memory"); __builtin_amdgcn_s_barrier(); asm volatile("" ::: "memory");
    }
};
struct EpiResG {
    static constexpr bool PERM = true, AFTER_DRAIN = false;
    bf16_t* X; const float* MOD; int l, gsel;
    __device__ __forceinline__ void operator()(const f32x4 (&acc)[2][2][4][2], const Unit& u, int wr, int wc, int fr, int fq) const {
        const int b = u.pm / 17, s = (u.pm - b * 17 == 0) ? 4 : b;
        const float* gate = MOD + ((size_t)l * 5 + s) * 6144 + gsel * 1024;
        const int col0 = u.pn * BM + wc * 32 + 8 * fq;
        f32x4 gv[2][2];
#pragma unroll
        for (int bj = 0; bj < 2; ++bj)
#pragma unroll
            for (int n = 0; n < 2; ++n) gv[bj][n] = *(const f32x4*)(gate + col0 + bj * HALF + n * 4);
#pragma unroll
        for (int ai = 0; ai < 2; ++ai)
#pragma unroll
            for (int m = 0; m < 4; ++m) { bf16_t* rowp = X + (size_t)(u.pm * BM + ai * HALF + wr * 64 + m * 16 + fr) * 1024 + col0;
                u32x4 xw[2];
#pragma unroll
                for (int bj = 0; bj < 2; ++bj) xw[bj] = *(const u32x4*)(rowp + bj * HALF);
#pragma unroll
                for (int bj = 0; bj < 2; ++bj) { const f32x4 a0 = acc[ai][bj][m][0], a1 = acc[ai][bj][m][1], g0 = gv[bj][0], g1 = gv[bj][1]; const u32x4 x = xw[bj]; u32x4 w;
                    w.x = cvt_pk_bf16(__uint_as_float(x.x << 16) + g0[0] * a0[0], __uint_as_float(x.x & 0xffff0000u) + g0[1] * a0[1]);
                    w.y = cvt_pk_bf16(__uint_as_float(x.y << 16) + g0[2] * a0[2], __uint_as_float(x.y & 0xffff0000u) + g0[3] * a0[3]);
                    w.z = cvt_pk_bf16(__uint_as_float(x.z << 16) + g1[0] * a1[0], __uint_as_float(x.z & 0xffff0000u) + g1[1] * a1[1]);
                    w.w = cvt_pk_bf16(__uint_as_float(x.w << 16) + g1[2] * a1[2], __uint_as_float(x.w & 0xffff0000u) + g1[3] * a1[3]);
                    *(u32x4*)(rowp + bj * HALF) = w; }
                asm volatile("" ::: "memory"); }
    }
};
__device__ __forceinline__ float swiglu1(float g, float u) { return g * __builtin_amdgcn_rcpf(1.f + __expf(-g)) * u; }
struct EpiSwiglu {
    static constexpr bool PERM = true, AFTER_DRAIN = false;
    bf16_t* ACT; int Fh;
    __device__ __forceinline__ void operator()(const f32x4 (&acc)[2][2][4][2], const Unit& u, int wr, int wc, int fr, int fq) const {
        const int row0 = u.pm * BM + wr * 64 + fr, f0 = u.pn * HALF + wc * 32 + 8 * fq;
#pragma unroll
        for (int ai = 0; ai < 2; ++ai)
#pragma unroll
            for (int m = 0; m < 4; ++m) { const f32x4 g0 = acc[ai][0][m][0], g1 = acc[ai][0][m][1], u0 = acc[ai][1][m][0], u1 = acc[ai][1][m][1];
                u32x4 w; w.x = cvt_pk_bf16(swiglu1(g0[0], u0[0]), swiglu1(g0[1], u0[1])); w.y = cvt_pk_bf16(swiglu1(g0[2], u0[2]), swiglu1(g0[3], u0[3]));
                w.z = cvt_pk_bf16(swiglu1(g1[0], u1[0]), swiglu1(g1[1], u1[1])); w.w = cvt_pk_bf16(swiglu1(g1[2], u1[2]), swiglu1(g1[3], u1[3]));
                *(u32x4*)(ACT + (size_t)(row0 + ai * HALF + m * 16) * Fh + f0) = w; }
    }
};
struct EpiSlab {
    static constexpr bool PERM = false, AFTER_DRAIN = false;
    float* slab;
    __device__ __forceinline__ void operator()(const f32x4 (&acc)[2][2][4][2], const Unit& u, int wr, int wc, int fr, int fq) const {
        const int col0 = u.pn * BM + wc * 32 + 4 * fq;
#pragma unroll
        for (int ai = 0; ai < 2; ++ai)
#pragma unroll
            for (int m = 0; m < 4; ++m) { float* rowp = slab + (size_t)(u.aux + ai * HALF + wr * 64 + m * 16 + fr) * 1024 + col0;
#pragma unroll
                for (int bj = 0; bj < 2; ++bj)
#pragma unroll
                    for (int n = 0; n < 2; ++n) *(f32x4*)(rowp + bj * HALF + n * 16) = acc[ai][bj][m][n]; }
    }
};
struct CtxSplitOrder {
    int S, Kc, G, c;
    __device__ __forceinline__ bool next(int i, Unit& u) const { const int L = i * G + c; if (L >= 16 * S) return false; const int ks = L % S, t = L / S, ct = t >> 2;
        u.pm = 17 * ct; u.pn = t & 3; u.e = 0; u.koff = ks * Kc; u.aux = ks * 1024 + 256 * ct; return true; }
    __device__ __forceinline__ void a_ready(const Unit&) const {}
    __device__ __forceinline__ void done(const Unit&) const {}
};
struct LatOrder {
    StaticOrder s;
    __device__ void init(int N, int G, int c) { s.init(16384, N, G, c); }
    __device__ __forceinline__ bool next(int i, Unit& u) const { if (!s.next(i, u)) return false; u.pm = u.pm + u.pm / 16 + 1; return true; }
    __device__ __forceinline__ void a_ready(const Unit&) const {}
    __device__ __forceinline__ void done(const Unit&) const {}
};
struct RemSplitOrder {
    int T0, nrem, Kc, G, c, o1, o2, o3, o4, o5, o6, o7;
    __device__ __forceinline__ bool next(int i, Unit& u) const { const int L = i * G + c; if (L >= nrem * 16) return false; const int ks = L & 3, t = L >> 2;
        u.pm = T0 + (t >> 2); u.pn = t & 3; const int sl = u.pm * BM; u.e = (sl >= o1) + (sl >= o2) + (sl >= o3) + (sl >= o4) + (sl >= o5) + (sl >= o6) + (sl >= o7);
        u.koff = ks * Kc; u.aux = (ks * nrem + (u.pm - T0)) * BM; return true; }
    __device__ __forceinline__ void a_ready(const Unit&) const {}
    __device__ __forceinline__ void done(const Unit&) const {}
};
struct RowOrder {
    StaticOrder s; bool lat;
    __device__ void init(bool lat_, int N, int G, int c) { lat = lat_; s.init(lat_ ? 16384 : 17408, N, G, c); }
    __device__ __forceinline__ bool next(int i, Unit& u) const { if (!s.next(i, u)) return false; if (lat) u.pm = u.pm + u.pm / 16 + 1; return true; }
    __device__ __forceinline__ void a_ready(const Unit&) const {}
    __device__ __forceinline__ void done(const Unit&) const {}
};
struct MoeOrder {
    StaticOrder s; int o1, o2, o3, o4, o5, o6, o7;
    __device__ __forceinline__ bool next(int i, Unit& u) const { if (!s.next(i, u)) return false; const int sl = u.pm * BM;
        u.e = (sl >= o1) + (sl >= o2) + (sl >= o3) + (sl >= o4) + (sl >= o5) + (sl >= o6) + (sl >= o7); return true; }
    __device__ __forceinline__ void a_ready(const Unit&) const {}
    __device__ __forceinline__ void done(const Unit&) const {}
};
template <class Epi, class Sched, bool ALIGN_EPI = false, bool SP2 = false>
__device__ __forceinline__ void gemm_phase(PG8_LAS unsigned char* lds, const Gemm g, const Sched& S, const Epi& E, const int wave_id) {
    int wid_ = wave_id; asm volatile("" : "+s"(wid_)); int lane_; asm volatile("v_mbcnt_lo_u32_b32 %0, -1, 0\n\tv_mbcnt_hi_u32_b32 %0, -1, %0" : "=v"(lane_));
    const int wid = wid_, lane = lane_, tid = wid * 64 + lane, wr = wid >> 2, wc = wid & 3, fr = lane & 15, fq = lane >> 4;
    const int K = g.K, nt = g.Kloop / BK;
    unsigned voffA[2], voffB[2];
#pragma unroll
    for (int i = 0; i < 2; ++i) { int R, C; stage_rc(tid * 16 + i * 8192, R, C); const int Rb = Epi::PERM ? ((R & ~31) + perm32(R & 31)) : R;
        voffA[i] = (unsigned)(R * K + C) * 2u; voffB[i] = (unsigned)(Rb * K + C) * 2u; }
    const size_t kstep = (size_t)(BK * 2);
    const size_t hstep = (size_t)HALF * K * 2;
    const size_t tstep = 2 * hstep;
    const unsigned ldsw = (unsigned)wid * 1024u;
    const int aoff = lds_byte(wr * 64 + fr, fq * 8), boff = lds_byte(wc * 32 + fr, fq * 8);
#define PG8_SA(b, h) (((b) * 2 + (h)) * HTB)
#define PG8_SB(b, h) ((4 + (b) * 2 + (h)) * HTB)
#define PG8_STAGE(bufoff, gbase, voff) do { _Pragma("unroll") for (int _i = 0; _i < 2; ++_i) \
        __builtin_amdgcn_global_load_lds((const unsigned*)((const char*)(gbase) + (voff)[_i]), (PG8_LAS unsigned*)(lds + (bufoff) + ldsw + _i * 8192), 16, 0, 0); } while (0)
#define PG8_LDA(dst, b, h) do { _Pragma("unroll") for (int m = 0; m < 4; ++m) _Pragma("unroll") for (int k = 0; k < 2; ++k) dst[m][k] = *(const PG8_LAS bf16x8*)(lds + PG8_SA(b, h) + aoff + m * 2048 + k * 1024); } while (0)
#define PG8_LDB(dst, b, h) do { _Pragma("unroll") for (int n = 0; n < 2; ++n) _Pragma("unroll") for (int k = 0; k < 2; ++k) dst[n][k] = *(const PG8_LAS bf16x8*)(lds + PG8_SB(b, h) + boff + n * 2048 + k * 1024); } while (0)
#define PG8_MMA(ai, bj, At, Bt) do { __builtin_amdgcn_s_setprio(1); _Pragma("unroll") for (int m = 0; m < 4; ++m) _Pragma("unroll") for (int n = 0; n < 2; ++n) _Pragma("unroll") for (int k = 0; k < 2; ++k) \
        acc[ai][bj][m][n] = __builtin_amdgcn_mfma_f32_16x16x32_bf16(Bt[n][k], At[m][k], acc[ai][bj][m][n], 0, 0, 0); __builtin_amdgcn_s_setprio(0); } while (0)
#define PG8_WAIT_V(n) asm volatile("s_waitcnt vmcnt(" #n ")" ::: "memory")
#define PG8_WAIT_L(n) asm volatile("s_waitcnt lgkmcnt(" #n ")" ::: "memory")
#define PG8_BAR __builtin_amdgcn_s_barrier()
#define PG8_SCHED __builtin_amdgcn_sched_barrier(0)
    Unit cur, nxt; int ui = 0;
    if (!S.next(0, cur)) return;
    f32x4 acc[2][2][4][2];
#pragma unroll
    for (int a = 0; a < 2; ++a)
#pragma unroll
        for (int b = 0; b < 2; ++b)
#pragma unroll
            for (int m = 0; m < 4; ++m)
#pragma unroll
                for (int n = 0; n < 2; ++n) acc[a][b][m][n] = (f32x4){0.f, 0.f, 0.f, 0.f};
    bf16x8 At[4][2], B0[2][2], B1[2][2];
    const char* cA = (const char*)g.A + (size_t)cur.pm * tstep + (size_t)cur.koff * 2; const char* cB = (const char*)g.Bt + (size_t)cur.e * g.estride + (size_t)cur.pn * tstep + (size_t)cur.koff * 2;
    S.a_ready(cur);
    if constexpr (SP2) {
        PG8_STAGE(PG8_SB(0, 0), cB, voffB); PG8_STAGE(PG8_SB(0, 1), cB + hstep, voffB); PG8_STAGE(PG8_SA(0, 0), cA, voffA); PG8_STAGE(PG8_SA(0, 1), cA + hstep, voffA);
        if (wr == 1) PG8_BAR;
        PG8_WAIT_V(2); PG8_BAR;
        PG8_STAGE(PG8_SB(1, 0), cB + kstep, voffB); PG8_STAGE(PG8_SA(1, 0), cA + kstep, voffA); PG8_STAGE(PG8_SB(1, 1), cB + hstep + kstep, voffB);
        PG8_WAIT_V(6); PG8_BAR;
    } else {
        PG8_STAGE(PG8_SB(0, 0), cB, voffB); PG8_STAGE(PG8_SA(0, 0), cA, voffA); PG8_STAGE(PG8_SB(0, 1), cB + hstep, voffB); PG8_STAGE(PG8_SA(0, 1), cA + hstep, voffA);
        if (wr == 1) PG8_BAR;
        PG8_WAIT_V(4); PG8_BAR;
        PG8_STAGE(PG8_SB(1, 0), cB + kstep, voffB); PG8_STAGE(PG8_SA(1, 0), cA + kstep, voffA); PG8_STAGE(PG8_SB(1, 1), cB + hstep + kstep, voffB);
        PG8_WAIT_V(6); PG8_BAR;
    }
    for (;;) {
        const bool has_next = S.next(ui + 1, nxt);
        const char* nA = has_next ? (const char*)g.A + (size_t)nxt.pm * tstep + (size_t)nxt.koff * 2 : cA; const char* nB = has_next ? (const char*)g.Bt + (size_t)nxt.e * g.estride + (size_t)nxt.pn * tstep + (size_t)nxt.koff * 2 : cB;
        for (int t = 0; t < nt; t += 2) {
            const bool last = (t == nt - 2);
            const char* a1 = cA + (size_t)(t + 1) * kstep;
            const char* a2 = last ? nA : cA + (size_t)(t + 2) * kstep; const char* b2 = last ? nB : cB + (size_t)(t + 2) * kstep;
            const char* a3 = a2 + kstep; const char* b3 = b2 + kstep;
            if (last && has_next) S.a_ready(nxt);
            if constexpr (SP2) {
            PG8_LDB(B0, 0, 0); PG8_LDB(B1, 0, 1); PG8_SCHED; PG8_LDA(At, 0, 0); PG8_STAGE(PG8_SA(1, 1), a1 + hstep, voffA);
            PG8_WAIT_V(8); PG8_WAIT_L(0); PG8_BAR; PG8_MMA(0, 0, At, B0); PG8_MMA(0, 1, At, B1); PG8_BAR; PG8_SCHED;
            PG8_LDA(At, 0, 1); PG8_STAGE(PG8_SB(0, 0), b2, voffB); PG8_STAGE(PG8_SB(0, 1), b2 + hstep, voffB); PG8_STAGE(PG8_SA(0, 0), a2, voffA);
            PG8_WAIT_V(8); PG8_WAIT_L(0); PG8_BAR; PG8_MMA(1, 0, At, B0); PG8_MMA(1, 1, At, B1); PG8_BAR; PG8_SCHED;
            PG8_LDB(B0, 1, 0); PG8_LDB(B1, 1, 1); PG8_SCHED; PG8_LDA(At, 1, 0); PG8_STAGE(PG8_SA(0, 1), a2 + hstep, voffA);
            PG8_WAIT_V(8); PG8_WAIT_L(0); PG8_BAR; PG8_MMA(0, 0, At, B0); PG8_MMA(0, 1, At, B1); PG8_BAR; PG8_SCHED;
            PG8_LDA(At, 1, 1); PG8_STAGE(PG8_SB(1, 0), b3, voffB); PG8_STAGE(PG8_SB(1, 1), b3 + hstep, voffB); PG8_STAGE(PG8_SA(1, 0), a3, voffA);
            PG8_WAIT_V(8); PG8_WAIT_L(0); PG8_BAR; PG8_MMA(1, 0, At, B0); PG8_MMA(1, 1, At, B1); PG8_BAR; PG8_SCHED;
            } else {
            PG8_LDB(B0, 0, 0); PG8_SCHED; PG8_LDA(At, 0, 0); PG8_STAGE(PG8_SA(1, 1), a1 + hstep, voffA);
            PG8_WAIT_L(8); PG8_BAR; PG8_WAIT_L(0); PG8_MMA(0, 0, At, B0); PG8_BAR; PG8_SCHED;
            PG8_LDB(B1, 0, 1); PG8_STAGE(PG8_SB(0, 0), b2, voffB);
            PG8_BAR; PG8_WAIT_L(0); PG8_MMA(0, 1, At, B1); PG8_BAR;
            PG8_LDA(At, 0, 1); PG8_STAGE(PG8_SA(0, 0), a2, voffA);
            PG8_BAR; PG8_WAIT_L(0); PG8_MMA(1, 0, At, B0); PG8_BAR; PG8_SCHED;
            PG8_STAGE(PG8_SB(0, 1), b2 + hstep, voffB);
            PG8_WAIT_V(6); PG8_BAR; PG8_MMA(1, 1, At, B1); PG8_BAR;
            PG8_LDB(B0, 1, 0); PG8_SCHED; PG8_LDA(At, 1, 0); PG8_STAGE(PG8_SA(0, 1), a2 + hstep, voffA);
            PG8_WAIT_L(8); PG8_BAR; PG8_WAIT_L(0); PG8_MMA(0, 0, At, B0); PG8_BAR; PG8_SCHED;
            PG8_LDB(B1, 1, 1); PG8_STAGE(PG8_SB(1, 0), b3, voffB);
            PG8_BAR; PG8_WAIT_L(0); PG8_MMA(0, 1, At, B1); PG8_BAR;
            PG8_LDA(At, 1, 1); PG8_STAGE(PG8_SA(1, 0), a3, voffA);
            PG8_BAR; PG8_WAIT_L(0); PG8_MMA(1, 0, At, B0); PG8_BAR; PG8_SCHED;
            PG8_STAGE(PG8_SB(1, 1), b3 + hstep, voffB);
            PG8_WAIT_V(6); PG8_BAR; PG8_MMA(1, 1, At, B1); PG8_BAR;
            }
        }
        if constexpr (ALIGN_EPI) { if (wr == 0) PG8_BAR; }
        if constexpr (!Epi::AFTER_DRAIN) { int le_; asm volatile("v_mbcnt_lo_u32_b32 %0, -1, 0\n\tv_mbcnt_hi_u32_b32 %0, -1, %0" : "=v"(le_));
            E(acc, cur, wr, wc, le_ & 15, le_ >> 4); S.done(cur); }
        if (!has_next) break;
#pragma unroll
        for (int a = 0; a < 2; ++a)
#pragma unroll
            for (int b = 0; b < 2; ++b)
#pragma unroll
                for (int m = 0; m < 4; ++m)
#pragma unroll
                    for (int n = 0; n < 2; ++n) acc[a][b][m][n] = (f32x4){0.f, 0.f, 0.f, 0.f};
        cur = nxt; cA = nA; cB = nB; ++ui;
        if constexpr (ALIGN_EPI) { if (wr == 1) PG8_BAR; }
    }
    PG8_WAIT_V(0);
    if constexpr (!ALIGN_EPI) { if (wr == 0) PG8_BAR; }
    PG8_BAR;
    if constexpr (Epi::AFTER_DRAIN) { E.fused(acc, cur, wr, wc, fr, fq, lds, wid, lane); S.done(cur); }
#undef PG8_SA
#undef PG8_SB
#undef PG8_STAGE
#undef PG8_LDA
#undef PG8_LDB
#undef PG8_MMA
#undef PG8_WAIT_V
#undef PG8_WAIT_L
#undef PG8_BAR
#undef PG8_SCHED
}
}

constexpr int NJOBS = 18;
struct Job { const float* src; unsigned long long dst_off; int K, N, Nd, nb, mode, item0; };
struct Args {
    const float* x; const float* c; const float* ctx; const float* cctx;
    const float* w_mod[4]; const float* b_mod[4]; const float* g_mix[4]; const float* g_ffn[4];
    const float* q_gain[4]; const float* k_gain[4]; const float* w_router[4];
    const float* rel_bias; const float* g_dq; const float* g_dkv;
    float* out; unsigned char* ws;
    Job jobs[NJOBS];
    int n_items; int lo; int hi; int pad;
};

struct Frame {
    LAS unsigned char* lds;
    int tid, lane, wave, gw, NGW, wave0;
    unsigned char* ws;
    float* MOD; bf16* X; bf16* H;
};
DI void slab_sum(const float* sl, int S, int lane, f32x4 (&sum)[4]) {
#pragma unroll
    for (int j = 0; j < 4; ++j) sum[j] = (f32x4){0.f, 0.f, 0.f, 0.f};
#pragma unroll 1
    for (int k0 = 0; k0 < S; k0 += 2) { const int k1 = (k0 + 1 < S) ? k0 + 1 : k0; f32x4 t0[4], t1[4];
#pragma unroll
        for (int j = 0; j < 4; ++j) { t0[j] = *(const f32x4*)(sl + (size_t)k0 * 1024 * 1024 + 4 * lane + 256 * j); t1[j] = *(const f32x4*)(sl + (size_t)k1 * 1024 * 1024 + 4 * lane + 256 * j); }
#pragma unroll
        for (int j = 0; j < 4; ++j) { sum[j] += t0[j]; if (k0 + 1 < S) sum[j] += t1[j]; } }
}
DI int lane_id() { int ln; asm volatile("v_mbcnt_lo_u32_b32 %0, -1, 0\n\tv_mbcnt_hi_u32_b32 %0, -1, %0" : "=v"(ln)); return ln; }
DI void refresh(Frame& F) { int w = F.wave0; asm volatile("" : "+s"(w)); int ln = lane_id(); asm volatile("" : "+v"(ln)); F.wave = w; F.lane = ln; F.tid = w * 64 + ln; F.gw = blockIdx.x * 8 + w; }
DI int row_mod_idx(int m) { const int b = m / SB, p = m - b * SB; return p < NCTX ? 4 : b; }

DI void conv_item(const Args& a, Frame& F, LAS float* scr, int item) {
    int j = 0;
#pragma unroll 1
    for (int t = 1; t < NJOBS; ++t) if (item >= a.jobs[t].item0) j = t;
    const Job jb = a.jobs[j];
    const int it = item - jb.item0, nblk = jb.N / 32, kb = it / nblk, nbk = it % nblk;
    const int k0g = 64 * kb, n0 = 32 * nbk, e = k0g / jb.K, k0 = k0g - e * jb.K;
    const float* W = jb.src + (size_t)k0g * jb.N + n0;
    const int lane = F.lane;
    { f32x4 t[8]; const int kr = lane >> 3, n4 = (lane & 7) * 4;
#pragma unroll
      for (int i = 0; i < 8; ++i) t[i] = *(const f32x4*)(W + (size_t)(8 * i + kr) * jb.N + n4);
#pragma unroll
      for (int i = 0; i < 8; ++i) { LAS float* d = scr + (8 * i + kr) * 33 + n4; d[0] = t[i].x; d[1] = t[i].y; d[2] = t[i].z; d[3] = t[i].w; } }
    asm volatile("s_waitcnt lgkmcnt(0)" ::: "memory");
    int drow = n0;
    if (jb.mode == 1) { const int Fh = jb.N / 2; if (n0 < Fh) drow = (n0 / 128) * 256 + (n0 % 128); else { const int n1 = n0 - Fh; drow = (n1 / 128) * 256 + 128 + (n1 % 128); } }
    bf16* dst = (bf16*)(a.ws + jb.dst_off) + ((size_t)e * jb.Nd + drow) * jb.K + k0;
    const int c = lane & 7;
#pragma unroll
    for (int jj = 0; jj < 4; ++jj) { const int n = (lane >> 3) + 8 * jj; const LAS float* s = scr + (8 * c) * 33 + n;
        u32x4 o; o.x = pk2(s[0 * 33], s[1 * 33]); o.y = pk2(s[2 * 33], s[3 * 33]); o.z = pk2(s[4 * 33], s[5 * 33]); o.w = pk2(s[6 * 33], s[7 * 33]);
        *(u32x4*)(dst + (size_t)n * jb.K + 8 * c) = o; }
    asm volatile("s_waitcnt lgkmcnt(0)" ::: "memory");
}
DI float silu_f(float v) { return v / (1.f + __expf(-v)); }
DI void p0_prologue(const Args& a, Frame& F) {
    refresh(F);
    LAS float* red = (LAS float*)F.lds;
    LAS float* sil = (LAS float*)(F.lds + 16384);
    for (int t = F.tid; t < 5 * 1024; t += 512) { const int sidx = t >> 10, k = t & 1023; sil[t] = silu_f(sidx < 4 ? a.c[sidx * 1024 + k] : a.cctx[k]); }
    __syncthreads();
    for (int it = blockIdx.x; it < 4 * 96; it += gridDim.x) {
        const int l = it / 96, j0 = (it % 96) * 64;
        const float* wm = a.w_mod[l] + (size_t)(128 * F.wave) * 6144 + j0 + F.lane;
        float acc[5] = {0.f, 0.f, 0.f, 0.f, 0.f};
#pragma unroll 1
        for (int k8 = 0; k8 < 128; k8 += 16) {
            float w[16];
#pragma unroll
            for (int u = 0; u < 16; ++u) w[u] = wm[(size_t)(k8 + u) * 6144];
#pragma unroll
            for (int u = 0; u < 16; ++u) { const int kk = 128 * F.wave + k8 + u;
#pragma unroll
                for (int sidx = 0; sidx < 5; ++sidx) acc[sidx] += sil[sidx * 1024 + kk] * w[u]; }
        }
#pragma unroll
        for (int sidx = 0; sidx < 5; ++sidx) red[(F.wave * 5 + sidx) * 64 + F.lane] = acc[sidx];
        __syncthreads();
        if (F.tid < 320) { const int sidx = F.tid >> 6, ln = F.tid & 63; float t = a.b_mod[l][j0 + ln];
#pragma unroll
            for (int w = 0; w < 8; ++w) t += red[(w * 5 + sidx) * 64 + ln];
            F.MOD[((size_t)l * 5 + sidx) * 6144 + j0 + ln] = t; }
        __syncthreads();
    }
    if (blockIdx.x == 0) {
        float* R64 = (float*)(a.ws + WS_ROPE); float* R32 = R64 + 64 * 16 * 2;
        for (int t = F.tid; t < 64 * 16; t += 512) { const int pos = t >> 4, i = t & 15; const float f = expf(-9.210340371976184f * (float)i / 16.f), ang = (float)pos * f; R64[2 * t] = cosf(ang); R64[2 * t + 1] = sinf(ang); }
        for (int t = F.tid; t < 64 * 8; t += 512) { const int pos = t >> 3, i = t & 7; const float f = expf(-9.210340371976184f * (float)i / 8.f), ang = (float)pos * f; R32[2 * t] = cosf(ang); R32[2 * t + 1] = sinf(ang); }
    }
    if (blockIdx.x == 1 && F.wave < 4) {
        const int l = F.wave, kind = l % 3; const float* qg = a.q_gain[l]; const float* kg = a.k_gain[l];
        float q0 = fabsf(qg[F.lane]), k0 = fabsf(kg[F.lane]), q1 = 0.f, k1 = 0.f, bm = 0.f;
        if (kind == 2 && F.lane < 32) { q1 = fabsf(qg[64 + F.lane]); k1 = fabsf(kg[64 + F.lane]); }
        if (kind == 1) for (int i = F.lane; i < 16 * 465; i += 64) bm = fmaxf(bm, fabsf(a.rel_bias[i]));
        q0 = wave_max(q0); k0 = wave_max(k0); q1 = wave_max(q1); k1 = wave_max(k1); bm = wave_max(bm);
        float bound;
        if (kind == 2) bound = sqrtf(64.f * q0 * q0 + 32.f * q1 * q1) * sqrtf(64.f * k0 * k0 + 32.f * k1 * k1) * C2_96;
        else bound = 64.f * q0 * k0 * C2_64 + bm * LOG2E;
        if (F.lane == 0) ((float*)(a.ws + WS_BOUND))[l] = bound;
    }
    { u32x4* z = (u32x4*)(a.ws + W_IN + (size_t)672 * 1024 * 2); const int n16 = 96 * 1024 * 2 / 16;
      for (int t = blockIdx.x * 512 + F.tid; t < n16; t += gridDim.x * 512) z[t] = (u32x4){0u, 0u, 0u, 0u}; }
    __syncthreads();
    LAS float* scr = (LAS float*)(F.lds + F.wave * 16384);
    for (int it = F.gw; it < a.n_items; it += F.NGW) conv_item(a, F, scr, it);
}

DI void norm_rows(const Args& a, Frame& F, int l, int which  , bool first, bool skip_ctx, int moe_idx, int pendS = 0, int pl = 0, int pg = 0) {
    refresh(F);
    constexpr int UNR = 9;
    const float* gvec = which == 0 ? a.g_mix[l] : a.g_ffn[l];
    f32x4 g[4];
#pragma unroll
    for (int j = 0; j < 4; ++j) g[j] = *(const f32x4*)(gvec + 4 * F.lane + 256 * j);
#pragma unroll 1
    for (int m0 = F.gw; m0 < M; m0 += UNR * F.NGW) {
        f32x4 v[UNR][4]; bool ok[UNR]; int bb[UNR]; bool ic[UNR];
#pragma unroll
        for (int u = 0; u < UNR; ++u) {
            const int m = m0 + u * F.NGW; const int mm = m < M ? m : 0; const int b = mm / SB, p = mm - b * SB; const bool isctx = p < NCTX;
            ok[u] = (m < M) && !(skip_ctx && isctx); bb[u] = b; ic[u] = isctx;
            const float* src = isctx ? a.ctx + ((size_t)b * NCTX + p) * D : a.x + ((size_t)b * SEQ + (p - NCTX)) * D;
#pragma unroll
            for (int j = 0; j < 4; ++j) v[u][j] = !ok[u] ? (f32x4){0.f, 0.f, 0.f, 0.f} : first ? *(const f32x4*)(src + 4 * F.lane + 256 * j) : ldx4(F.X + (size_t)mm * D + 4 * F.lane + 256 * j);
        }
#pragma unroll
        for (int u = 0; u < UNR; ++u) {
            if (!ok[u]) continue;
            const int m = m0 + u * F.NGW;
            if (pendS > 0 && ic[u]) {
                const int crow_ = bb[u] * NCTX + (m - bb[u] * SB); const float* sl = (const float*)(a.ws + WS_SLAB) + (size_t)crow_ * 1024; const float* gt = F.MOD + ((size_t)pl * 5 + 4) * 6144 + pg * 1024;
                f32x4 sum[4]; slab_sum(sl, pendS, F.lane, sum);
#pragma unroll
                for (int j = 0; j < 4; ++j) { v[u][j] += *(const f32x4*)(gt + 4 * F.lane + 256 * j) * sum[j]; stx4(F.X + (size_t)m * D + 4 * F.lane + 256 * j, v[u][j]); }
            }
            float ss = 0.f;
#pragma unroll
            for (int j = 0; j < 4; ++j) ss += (v[u][j].x * v[u][j].x + v[u][j].y * v[u][j].y) + (v[u][j].z * v[u][j].z + v[u][j].w * v[u][j].w);
            if (first) {
#pragma unroll
                for (int j = 0; j < 4; ++j) stx4(F.X + (size_t)m * D + 4 * F.lane + 256 * j, v[u][j]);
            }
            const float rstd = 1.0f / sqrtf(wave_sum(ss) * (1.f / D) + EPS);
            const float* md = F.MOD + ((size_t)l * 5 + (ic[u] ? 4 : bb[u])) * 6144 + (which ? 3072 : 0);
            f32x4 hv[4];
#pragma unroll
            for (int j = 0; j < 4; ++j) { const f32x4 sh = *(const f32x4*)(md + 4 * F.lane + 256 * j), sc = *(const f32x4*)(md + 1024 + 4 * F.lane + 256 * j);
                hv[j] = (v[u][j] * rstd) * g[j] * (1.f + sc) + sh;
                u32x2 o; o.x = pk2(hv[j].x, hv[j].y); o.y = pk2(hv[j].z, hv[j].w);
                *(u32x2*)(F.H + (size_t)m * D + 4 * F.lane + 256 * j) = o; }
        }
    }
}

DI void norm_route_rows(const Args& a, Frame& F, int l, bool skip_ctx, int moe_idx, int pendS) {
    refresh(F);
    constexpr int RPW = 16;
    LAS int* wcnt = (LAS int*)F.lds;
    LAS int* stg = (LAS int*)(F.lds + 256) + F.wave * RPW * 6;
    int brun[8] = {0, 0, 0, 0, 0, 0, 0, 0};
    const float* gvec = a.g_ffn[l];
    f32x4 g[4];
#pragma unroll
    for (int j = 0; j < 4; ++j) g[j] = *(const f32x4*)(gvec + 4 * F.lane + 256 * j);
    f32x4 wr0[4][4], wr1[4][4];
#pragma unroll
    for (int j = 0; j < 4; ++j)
#pragma unroll
        for (int i = 0; i < 4; ++i) { const int k = 4 * F.lane + 256 * j + i; wr0[j][i] = *(const f32x4*)(a.w_router[l] + (size_t)k * 8); wr1[j][i] = *(const f32x4*)(a.w_router[l] + (size_t)k * 8 + 4); }
    unsigned* cnt = (unsigned*)(a.ws + WS_CTL) + CW_CNT + 512 * moe_idx;
#pragma unroll 1
    for (int base = 0; base < M; base += RPW * F.NGW) {
        int cw[8] = {0, 0, 0, 0, 0, 0, 0, 0};
        u32x2 nx[4];
        { const int m1 = base + F.gw; const int mc = m1 < M ? m1 : 0;
#pragma unroll
          for (int j = 0; j < 4; ++j) nx[j] = *(const u32x2*)(F.X + (size_t)mc * D + 4 * F.lane + 256 * j); }
#pragma unroll 1
        for (int i = 0; i < RPW; ++i) {
            const int m = base + i * F.NGW + F.gw; if (m >= M) break;
            const int b = m / SB, p = m - b * SB; const bool isctx = p < NCTX;
            f32x4 v[4]; float ss = 0.f;
#pragma unroll
            for (int j = 0; j < 4; ++j) v[j] = (f32x4){bf2f(nx[j].x & 0xffffu), bf2f(nx[j].x >> 16), bf2f(nx[j].y & 0xffffu), bf2f(nx[j].y >> 16)};
            { const int m2 = m + F.NGW; const int mc = (m2 < M && i + 1 < RPW) ? m2 : m;
#pragma unroll
              for (int j = 0; j < 4; ++j) nx[j] = *(const u32x2*)(F.X + (size_t)mc * D + 4 * F.lane + 256 * j); }
            if (skip_ctx && isctx) { if (F.lane == 0) stg[i * 6] = -1; continue; }
            if (pendS > 0 && isctx) {
                const float* sl = (const float*)(a.ws + WS_SLAB) + (size_t)(b * NCTX + p) * 1024; const float* gt = F.MOD + ((size_t)l * 5 + 4) * 6144 + 2 * 1024;
                f32x4 sum[4]; slab_sum(sl, pendS, F.lane, sum);
#pragma unroll
                for (int j = 0; j < 4; ++j) { v[j] += *(const f32x4*)(gt + 4 * F.lane + 256 * j) * sum[j]; stx4(F.X + (size_t)m * D + 4 * F.lane + 256 * j, v[j]); }
            }
#pragma unroll
            for (int j = 0; j < 4; ++j) ss += (v[j].x * v[j].x + v[j].y * v[j].y) + (v[j].z * v[j].z + v[j].w * v[j].w);
            const float rstd = 1.0f / sqrtf(wave_sum(ss) * (1.f / D) + EPS);
            const float* md = F.MOD + ((size_t)l * 5 + (isctx ? 4 : b)) * 6144 + 3072;
            float lg[8] = {0.f, 0.f, 0.f, 0.f, 0.f, 0.f, 0.f, 0.f};
#pragma unroll
            for (int j = 0; j < 4; ++j) { const f32x4 sh = *(const f32x4*)(md + 4 * F.lane + 256 * j), sc = *(const f32x4*)(md + 1024 + 4 * F.lane + 256 * j);
                const f32x4 hv = (v[j] * rstd) * g[j] * (1.f + sc) + sh;
                u32x2 o; o.x = pk2(hv.x, hv.y); o.y = pk2(hv.z, hv.w);
                *(u32x2*)(F.H + (size_t)m * D + 4 * F.lane + 256 * j) = o;
#pragma unroll
                for (int ii = 0; ii < 4; ++ii) { const float hx = hv[ii]; const f32x4 w0 = wr0[j][ii], w1 = wr1[j][ii];
                    lg[0] += hx * w0.x; lg[1] += hx * w0.y; lg[2] += hx * w0.z; lg[3] += hx * w0.w; lg[4] += hx * w1.x; lg[5] += hx * w1.y; lg[6] += hx * w1.z; lg[7] += hx * w1.w; } }
#pragma unroll
            for (int e = 0; e < 8; ++e) lg[e] = wave_sum(lg[e]);
            int e0 = 0; float v0 = lg[0];
#pragma unroll
            for (int e = 1; e < 8; ++e) if (lg[e] > v0) { v0 = lg[e]; e0 = e; }
            int e1 = -1; float v1 = -INFINITY;
#pragma unroll
            for (int e = 0; e < 8; ++e) if (e != e0 && lg[e] > v1) { v1 = lg[e]; e1 = e; }
            const float ex = __expf(v1 - v0), w0 = 1.f / (1.f + ex), w1 = ex / (1.f + ex);
            int p0 = 0, p1 = 0;
#pragma unroll
            for (int e = 0; e < 8; ++e) { p0 = (e == e0) ? cw[e] : p0; p1 = (e == e1) ? cw[e] : p1; cw[e] += (e == e0) + (e == e1); }
            if (F.lane == 0) { stg[i * 6 + 0] = e0; stg[i * 6 + 1] = e1; stg[i * 6 + 2] = p0; stg[i * 6 + 3] = p1; stg[i * 6 + 4] = __float_as_int(w0); stg[i * 6 + 5] = __float_as_int(w1); }
        }
        if (F.lane == 0) {
#pragma unroll
            for (int e = 0; e < 8; ++e) wcnt[F.wave * 8 + e] = cw[e]; }
        __syncthreads();
        int pre[8];
#pragma unroll
        for (int e = 0; e < 8; ++e) { int pw = 0, tot = 0;
#pragma unroll
            for (int w = 0; w < 8; ++w) { const int c = wcnt[w * 8 + e]; pw += (w < F.wave) ? c : 0; tot += c; }
            pre[e] = brun[e] + pw; brun[e] += tot; }
        if (F.lane < RPW) { const int i = F.lane; const int m = base + i * F.NGW + F.gw;
            if (m < M) { const int e0 = stg[i * 6]; if (e0 >= 0) { const int e1 = stg[i * 6 + 1];
                int b0 = 0, b1 = 0;
#pragma unroll
                for (int e = 0; e < 8; ++e) { b0 = (e == e0) ? pre[e] : b0; b1 = (e == e1) ? pre[e] : b1; }
                int* r = (int*)(a.ws + WS_ROUTE) + (size_t)m * 8;
                r[0] = e0; r[1] = e1; r[2] = stg[i * 6 + 2] + b0; r[3] = stg[i * 6 + 3] + b1; r[4] = stg[i * 6 + 4]; r[5] = stg[i * 6 + 5]; r[6] = (int)blockIdx.x; } } }
        __syncthreads();
    }
    if (F.tid == 0) { int* bc = (int*)(a.ws + WS_BC) + ((size_t)moe_idx * 1024 + blockIdx.x) * 8;
#pragma unroll
        for (int e = 0; e < 8; ++e) { bc[e] = brun[e]; if (brun[e]) atomicAdd(cnt + 64 * e, (unsigned)brun[e]); } }
}


struct MoeOff { int o[9]; };
DI MoeOff moe_offsets(const Args& a, int moe_idx) {
    const unsigned* cnt = (const unsigned*)(a.ws + WS_CTL) + CW_CNT + 512 * moe_idx;
    MoeOff r; r.o[0] = 0;
#pragma unroll
    for (int e = 0; e < 8; ++e) { const int c = (int)__builtin_amdgcn_readfirstlane((int)__hip_atomic_load(cnt + 64 * e, __ATOMIC_RELAXED, __HIP_MEMORY_SCOPE_AGENT)); r.o[e + 1] = r.o[e] + ((c + 255) & ~255); }
    return r;
}
DI int moe_off_of(const MoeOff& mo, int e) { int r = 0;
#pragma unroll
    for (int i = 1; i < 8; ++i) if (e >= i) r = mo.o[i];
    return r; }
DI int moe_expert_of_slot(const MoeOff& mo, int slot) { int e = 0;
#pragma unroll
    for (int i = 1; i < 8; ++i) if (slot >= mo.o[i]) e = i;
    return e; }

DI int moe_split_t0(const MoeOff& mo, int G) { const int nM = mo.o[8] >> 8, rem_tiles = ((4 * nM) % G) >> 2; return (rem_tiles == 0 || rem_tiles > 16) ? nM : nM - rem_tiles; }
DI void moe_gather(const Args& a, Frame& F, int moe_idx, bool skip_ctx) {
    refresh(F);
    const MoeOff mo = moe_offsets(a, moe_idx);
    bf16* HP = (bf16*)(a.ws + WS_HP);
    const int G = gridDim.x, nb = (G + 63) / 64;
    LAS int* raw = (LAS int*)F.lds; LAS int* part = (LAS int*)(F.lds + 32768); LAS int* PB = (LAS int*)(F.lds + 36864);
    { const int* bc = (const int*)(a.ws + WS_BC) + (size_t)moe_idx * 1024 * 8; for (int i = F.tid; i < G * 8; i += 512) raw[i] = bc[i]; }
    __syncthreads();
    { const int e = F.wave; int sl = 0; for (int j = 0; j < nb; ++j) { const int b = F.lane * nb + j; if (b < G) sl += raw[b * 8 + e]; }
      int inc = sl;
#pragma unroll
      for (int d = 1; d < 64; d <<= 1) { const int o = __builtin_amdgcn_ds_bpermute((F.lane - d) << 2, inc); if (F.lane >= d) inc += o; }
      int run = inc - sl;
      for (int j = 0; j < nb; ++j) { const int b = F.lane * nb + j; if (b < G) { PB[b * 8 + e] = run; run += raw[b * 8 + e]; } } }
    (void)part;
    __syncthreads();
    constexpr int UNR = 8;
#pragma unroll 1
    for (int it0 = F.gw; it0 < 2 * M; it0 += UNR * F.NGW) {
        u32x4 d0[UNR], d1[UNR]; int slot[UNR]; bool ok[UNR];
#pragma unroll
        for (int u = 0; u < UNR; ++u) {
            const int it = it0 + u * F.NGW; const int itc = it < 2 * M ? it : 0; const int m = itc >> 1, k = itc & 1; const int p = m % SB;
            ok[u] = (it < 2 * M) && !(skip_ctx && p < NCTX);
            int* r = (int*)(a.ws + WS_ROUTE) + (size_t)m * 8;
            const int e = ok[u] ? r[k] : 0, pos = ok[u] ? r[2 + k] : 0, blk = ok[u] ? r[6] : 0; slot[u] = moe_off_of(mo, e) + PB[blk * 8 + e] + pos;
            if (ok[u] && F.lane == 0) r[2 + k] = slot[u];
            const u32x4* s = (const u32x4*)(F.H + (size_t)m * D);
            d0[u] = s[F.lane]; d1[u] = s[F.lane + 64];
        }
#pragma unroll
        for (int u = 0; u < UNR; ++u) if (ok[u]) { u32x4* d = (u32x4*)(HP + (size_t)slot[u] * D); d[F.lane] = d0[u]; d[F.lane + 64] = d1[u]; }
    }
}
DI void moe_combine(const Args& a, Frame& F, int l, int moe_idx) {
    refresh(F);
    const MoeOff mo = moe_offsets(a, moe_idx);
    const bf16* Y = (const bf16*)(a.ws + WS_HP); const float* SL = (const float*)(a.ws + WS_SLAB2);
    const int T0 = moe_split_t0(mo, (int)gridDim.x); const size_t kst = (size_t)((mo.o[8] >> 8) - T0) * 256 * 1024;
    const bool last = (l == 3);
    constexpr int UNR = 3;
    f32x4 g[4];
#pragma unroll
    for (int j = 0; j < 4; ++j) g[j] = last ? (f32x4){0.f, 0.f, 0.f, 0.f} : *(const f32x4*)(a.g_mix[l + 1] + 4 * F.lane + 256 * j);
#pragma unroll 1
    for (int m0 = F.gw; m0 < M; m0 += UNR * F.NGW) {
        f32x4 y0[UNR][4], y1[UNR][4]; f32x4 xv[UNR][4]; float w0[UNR], w1[UNR]; bool ok[UNR]; int bb[UNR], pp[UNR];
#pragma unroll
        for (int u = 0; u < UNR; ++u) {
            const int m = m0 + u * F.NGW; const int mm = m < M ? m : 0; const int b = mm / SB, p = mm - b * SB; const bool isctx = p < NCTX;
            ok[u] = (m < M) && !(last && isctx); bb[u] = b; pp[u] = p;
            const int* r = (const int*)(a.ws + WS_ROUTE) + (size_t)mm * 8;
            const int e0 = ok[u] ? r[0] : 0, e1 = ok[u] ? r[1] : 0, q0 = ok[u] ? r[2] : 0, q1 = ok[u] ? r[3] : 0;
            const int s0 = q0, s1 = q1; (void)e0; (void)e1; w0[u] = __int_as_float(r[4]); w1[u] = __int_as_float(r[5]);
#pragma unroll
            for (int j = 0; j < 4; ++j) { const int col = 4 * F.lane + 256 * j;
                y0[u][j] = ldx4(Y + (size_t)s0 * D + col); y1[u][j] = ldx4(Y + (size_t)s1 * D + col); xv[u][j] = ldx4(F.X + (size_t)mm * D + col); }
            if ((s0 >> 8) >= T0 || (s1 >> 8) >= T0) {
#pragma unroll
              for (int j = 0; j < 4; ++j) { const int col = 4 * F.lane + 256 * j;
                if ((s0 >> 8) >= T0) { const float* sp = SL + (size_t)(s0 - T0 * 256) * 1024 + col; y0[u][j] = (*(const f32x4*)sp + *(const f32x4*)(sp + kst)) + (*(const f32x4*)(sp + 2 * kst) + *(const f32x4*)(sp + 3 * kst)); y0[u][j] = (f32x4){bf2f(f2bf(y0[u][j].x)), bf2f(f2bf(y0[u][j].y)), bf2f(f2bf(y0[u][j].z)), bf2f(f2bf(y0[u][j].w))}; }
                if ((s1 >> 8) >= T0) { const float* sp = SL + (size_t)(s1 - T0 * 256) * 1024 + col; y1[u][j] = (*(const f32x4*)sp + *(const f32x4*)(sp + kst)) + (*(const f32x4*)(sp + 2 * kst) + *(const f32x4*)(sp + 3 * kst)); y1[u][j] = (f32x4){bf2f(f2bf(y1[u][j].x)), bf2f(f2bf(y1[u][j].y)), bf2f(f2bf(y1[u][j].z)), bf2f(f2bf(y1[u][j].w))}; } } }
        }
#pragma unroll
        for (int u = 0; u < UNR; ++u) {
            if (!ok[u]) continue;
            const int m = m0 + u * F.NGW; const int b = bb[u], p = pp[u]; const bool isctx = p < NCTX;
            const float* md = F.MOD + ((size_t)l * 5 + (isctx ? 4 : b)) * 6144 + 5 * 1024;
            f32x4 v[4]; float ss = 0.f;
#pragma unroll
            for (int j = 0; j < 4; ++j) { const int col = 4 * F.lane + 256 * j; const f32x4 g2 = *(const f32x4*)(md + col);
                const f32x4 f = w0[u] * y0[u][j] + w1[u] * y1[u][j];
                v[j] = xv[u][j] + g2 * f; ss += (v[j].x * v[j].x + v[j].y * v[j].y) + (v[j].z * v[j].z + v[j].w * v[j].w); }
            if (last) {
                float* o = a.out + ((size_t)b * SEQ + (p - NCTX)) * D;
#pragma unroll
                for (int j = 0; j < 4; ++j) *(f32x4*)(o + 4 * F.lane + 256 * j) = v[j];
            } else {
#pragma unroll
                for (int j = 0; j < 4; ++j) stx4(F.X + (size_t)m * D + 4 * F.lane + 256 * j, v[j]);
                const float rstd = 1.0f / sqrtf(wave_sum(ss) * (1.f / D) + EPS);
                const float* md2 = F.MOD + ((size_t)(l + 1) * 5 + (isctx ? 4 : b)) * 6144;
#pragma unroll
                for (int j = 0; j < 4; ++j) { const f32x4 sh = *(const f32x4*)(md2 + 4 * F.lane + 256 * j), sc = *(const f32x4*)(md2 + 1024 + 4 * F.lane + 256 * j);
                    const f32x4 hv = (v[j] * rstd) * g[j] * (1.f + sc) + sh; u32x2 o; o.x = pk2(hv.x, hv.y); o.y = pk2(hv.z, hv.w);
                    *(u32x2*)(F.H + (size_t)m * D + 4 * F.lane + 256 * j) = o; }
            }
        }
    }
}

DI void load16(const bf16* p, float* v) { const u32x4 a = *(const u32x4*)p, b = *(const u32x4*)(p + 8); unpack8(a, v); unpack8(b, v + 8); }
DI void store16(bf16* p, const float* v) { *(u32x4*)p = pack8(v); *(u32x4*)(p + 8) = pack8(v + 8); }
DI void rms64_gain(float* v, const float* gain, int part) {
    float ss = 0.f;
#pragma unroll
    for (int i = 0; i < 16; ++i) ss += v[i] * v[i];
    ss += swz_xor<1>(ss); ss += swz_xor<2>(ss);
    const float r = 1.0f / sqrtf(ss * (1.f / 64.f) + EPS);
#pragma unroll
    for (int i = 0; i < 16; ++i) v[i] = v[i] * r * gain[part * 16 + i];
}
DI void rope64(float* v, const float* R64, int part, int gr, int gc) {
    const int pos = part < 2 ? gr : gc; const float* cs = R64 + pos * 32;
#pragma unroll
    for (int i = 0; i < 16; ++i) { const float other = swz_xor<1>(v[i]); const float c = cs[2 * i], s = cs[2 * i + 1];
        v[i] = (part & 1) ? (other * s + v[i] * c) : (v[i] * c - other * s); }
}
DI void rms32_rope(float* v, const float* gain  , int part, bool do_rope, const float* R32, int gr, int gc) {
    float ss = 0.f;
#pragma unroll
    for (int i = 0; i < 16; ++i) ss += v[i] * v[i];
    ss += swz_xor<1>(ss);
    const float r = 1.0f / sqrtf(ss * (1.f / 32.f) + EPS);
#pragma unroll
    for (int i = 0; i < 16; ++i) v[i] = v[i] * r * gain[part * 16 + i];
    if (do_rope) { const int pos = part == 0 ? gr : gc; const float* cs = R32 + pos * 16;
#pragma unroll
        for (int i = 0; i < 8; ++i) { const float c = cs[2 * i], s = cs[2 * i + 1]; const float x1 = v[i], x2 = v[i + 8]; v[i] = x1 * c - x2 * s; v[i + 8] = x1 * s + x2 * c; } }
}
DI void unpack16(const u32x4 a, const u32x4 b, float* v) { unpack8(a, v); unpack8(b, v + 8); }
DI void prep_rows(const Args& a, Frame& F, int l, int kind, const bool full) {
    refresh(F);
    const float* R64 = (const float*)(a.ws + WS_ROPE); const float* R32 = R64 + 64 * 16 * 2;
    const float* qg = a.q_gain[l]; const float* kg = a.k_gain[l];
    bf16* QB = (bf16*)(a.ws + WS_QB); bf16* KB = (bf16*)(a.ws + WS_KB); bf16* VB = (bf16*)(a.ws + WS_VB);
    const int lane = F.lane, part = lane & 3;
    constexpr int UNR = 3;
#pragma unroll 1
    for (int m0 = F.gw; m0 < M; m0 += UNR * F.NGW) {
        u32x4 r0[UNR][2], r1[UNR][2], r2[UNR][2], r3[UNR][2], r4[UNR][2];
#pragma unroll
        for (int u = 0; u < UNR; ++u) {
            const int m = (m0 + u * F.NGW) < M ? (m0 + u * F.NGW) : 0;
            if (kind == 0) {
                const bf16* raw = (const bf16*)(a.ws + WS_RAW) + (size_t)m * 1536; const int l16 = lane & 15;
                if (full) { r0[u][0] = *(const u32x4*)(raw + lane * 16); r0[u][1] = *(const u32x4*)(raw + lane * 16 + 8); r2[u][0] = *(const u32x4*)(raw + 1280 + l16 * 16); r2[u][1] = *(const u32x4*)(raw + 1280 + l16 * 16 + 8); }
                r1[u][0] = *(const u32x4*)(raw + 1024 + l16 * 16); r1[u][1] = *(const u32x4*)(raw + 1024 + l16 * 16 + 8);
            } else if (kind == 1) {
                const bf16* raw = (const bf16*)(a.ws + WS_RAW) + (size_t)m * 3072;
                if (full) { r0[u][0] = *(const u32x4*)(raw + lane * 16); r0[u][1] = *(const u32x4*)(raw + lane * 16 + 8); r2[u][0] = *(const u32x4*)(raw + 2048 + lane * 16); r2[u][1] = *(const u32x4*)(raw + 2048 + lane * 16 + 8); }
                r1[u][0] = *(const u32x4*)(raw + 1024 + lane * 16); r1[u][1] = *(const u32x4*)(raw + 1024 + lane * 16 + 8);
            } else {
                const bf16* qraw = (const bf16*)(a.ws + RAW_Q) + (size_t)m * 1536; const bf16* kvraw = (const bf16*)(a.ws + RAW_KV) + (size_t)m * 2048; const bf16* rin = (const bf16*)(a.ws + RAW_IN) + (size_t)m * 768;
                const int h = lane >> 2, h2 = (lane >> 1) & 15, p2 = lane & 1;
                if (full) { r0[u][0] = *(const u32x4*)(qraw + h * 96 + part * 16); r0[u][1] = *(const u32x4*)(qraw + h * 96 + part * 16 + 8);
                    r1[u][0] = *(const u32x4*)(qraw + h2 * 96 + 64 + p2 * 16); r1[u][1] = *(const u32x4*)(qraw + h2 * 96 + 64 + p2 * 16 + 8);
                    r3[u][0] = *(const u32x4*)(kvraw + h * 128 + 64 + part * 16); r3[u][1] = *(const u32x4*)(kvraw + h * 128 + 64 + part * 16 + 8); }
                r2[u][0] = *(const u32x4*)(kvraw + h * 128 + part * 16); r2[u][1] = *(const u32x4*)(kvraw + h * 128 + part * 16 + 8);
                r4[u][0] = *(const u32x4*)(rin + 640 + p2 * 16); r4[u][1] = *(const u32x4*)(rin + 640 + p2 * 16 + 8);
            }
        }
#pragma unroll
        for (int u = 0; u < UNR; ++u) {
            const int m = m0 + u * F.NGW; if (m >= M) continue;
            const int p = m % SB; const bool isctx = p < NCTX; const int t = isctx ? 0 : p - NCTX; const int gr = t >> 6, gc = t & 63;
            float v[16];
            if (kind == 0) {
                const int l16 = lane & 15;
                if (full) { unpack16(r0[u][0], r0[u][1], v); rms64_gain(v, qg, part); if (!isctx) rope64(v, R64, part, gr, gc);
#pragma unroll
                    for (int i = 0; i < 16; ++i) v[i] *= C2_64;
                    store16(QB + (size_t)m * 1024 + lane * 16, v); }
                unpack16(r1[u][0], r1[u][1], v); rms64_gain(v, kg, part); if (!isctx) rope64(v, R64, part, gr, gc);
                if (lane < 16) store16(KB + (size_t)m * 256 + l16 * 16, v);
                if (full && lane >= 16 && lane < 32) { u32x4* d = (u32x4*)(VB + (size_t)m * 256 + l16 * 16); d[0] = r2[u][0]; d[1] = r2[u][1]; }
            } else if (kind == 1) {
                if (full) { unpack16(r0[u][0], r0[u][1], v); rms64_gain(v, qg, part);
#pragma unroll
                    for (int i = 0; i < 16; ++i) v[i] *= C2_64;
                    store16(QB + (size_t)m * 1024 + lane * 16, v); }
                unpack16(r1[u][0], r1[u][1], v); rms64_gain(v, kg, part); store16(KB + (size_t)m * 1024 + lane * 16, v);
                if (full) { u32x4* d = (u32x4*)(VB + (size_t)m * 1024 + lane * 16); d[0] = r2[u][0]; d[1] = r2[u][1]; }
            } else {
                const int h = lane >> 2, h2 = (lane >> 1) & 15, p2 = lane & 1;
                if (full) { unpack16(r0[u][0], r0[u][1], v); rms64_gain(v, qg, part);
#pragma unroll
                    for (int i = 0; i < 16; ++i) v[i] *= C2_96;
                    store16(QB + (size_t)m * 1536 + h * 96 + part * 16, v);
                    unpack16(r1[u][0], r1[u][1], v); rms32_rope(v, qg + 64, p2, !isctx, R32, gr, gc);
#pragma unroll
                    for (int i = 0; i < 16; ++i) v[i] *= C2_96;
                    if (lane < 32) store16(QB + (size_t)m * 1536 + h2 * 96 + 64 + p2 * 16, v); }
                unpack16(r2[u][0], r2[u][1], v); rms64_gain(v, kg, part); store16(KB + (size_t)m * 1536 + h * 96 + part * 16, v);
                if (full) { u32x4* d = (u32x4*)(VB + (size_t)m * 1024 + h * 64 + part * 16); d[0] = r3[u][0]; d[1] = r3[u][1]; }
                unpack16(r4[u][0], r4[u][1], v); rms32_rope(v, kg + 64, p2, !isctx, R32, gr, gc);
                if (lane < 32) store16(KB + (size_t)m * 1536 + h2 * 96 + 64 + p2 * 16, v);
            }
        }
    }
}
DI void mla_mid(const Args& a, Frame& F) {
    refresh(F);
    const int lane = F.lane;
    constexpr int UNR = 4;
    float gq[6], gk[4];
#pragma unroll
    for (int i = 0; i < 6; ++i) gq[i] = a.g_dq[6 * lane + i];
#pragma unroll
    for (int i = 0; i < 4; ++i) gk[i] = a.g_dkv[4 * lane + i];
#pragma unroll 1
    for (int m0 = F.gw; m0 < M; m0 += UNR * F.NGW) {
        unsigned qw[UNR][3]; u32x2 kw[UNR];
#pragma unroll
        for (int u = 0; u < UNR; ++u) { const int m = (m0 + u * F.NGW) < M ? (m0 + u * F.NGW) : 0; const bf16* rin = (const bf16*)(a.ws + RAW_IN) + (size_t)m * 768;
            const unsigned* q3 = (const unsigned*)(rin + 6 * lane); qw[u][0] = q3[0]; qw[u][1] = q3[1]; qw[u][2] = q3[2]; kw[u] = *(const u32x2*)(rin + 384 + 4 * lane); }
#pragma unroll
        for (int u = 0; u < UNR; ++u) {
            const int m = m0 + u * F.NGW; if (m >= M) continue;
            float q[6]; float ss = 0.f;
#pragma unroll
            for (int i = 0; i < 3; ++i) { q[2 * i] = bf2f(qw[u][i] & 0xffffu); q[2 * i + 1] = bf2f(qw[u][i] >> 16); }
#pragma unroll
            for (int i = 0; i < 6; ++i) ss += q[i] * q[i];
            float r = 1.0f / sqrtf(wave_sum(ss) * (1.f / 384.f) + EPS);
            unsigned* oq = (unsigned*)((bf16*)(a.ws + RAW_CQ) + (size_t)m * 384 + 6 * lane);
#pragma unroll
            for (int i = 0; i < 3; ++i) oq[i] = pk2(q[2 * i] * r * gq[2 * i], q[2 * i + 1] * r * gq[2 * i + 1]);
            float k[4] = {bf2f(kw[u].x & 0xffffu), bf2f(kw[u].x >> 16), bf2f(kw[u].y & 0xffffu), bf2f(kw[u].y >> 16)};
            ss = k[0] * k[0] + k[1] * k[1] + k[2] * k[2] + k[3] * k[3];
            r = 1.0f / sqrtf(wave_sum(ss) * (1.f / 256.f) + EPS);
            u32x2 ok; ok.x = pk2(k[0] * r * gk[0], k[1] * r * gk[1]); ok.y = pk2(k[2] * r * gk[2], k[3] * r * gk[3]);
            *(u32x2*)((bf16*)(a.ws + RAW_CKV) + (size_t)m * 256 + 4 * lane) = ok;
        }
    }
}

DI int crow(int r, int hi) { return (r & 3) + 8 * (r >> 2) + 4 * hi; }

namespace fa {
typedef __attribute__((address_space(3))) const char* lds_cptr;
typedef short v4i16_t __attribute__((ext_vector_type(4)));
typedef short s16x4 __attribute__((ext_vector_type(4)));
DI s16x4 vtr(lds_cptr p) { return __builtin_bit_cast(s16x4, __builtin_amdgcn_ds_read_tr16_b64_v4i16((__attribute__((address_space(3))) v4i16_t*)p)); }
DI unsigned cvtpk(float lo, float hi) { typedef float f2 __attribute__((ext_vector_type(2))); typedef __bf16 b2 __attribute__((ext_vector_type(2))); f2 v = {lo, hi}; b2 b = __builtin_convertvector(v, b2); return __builtin_bit_cast(unsigned, b); }
DI int clampi(int v, int lo, int hi) { return v < lo ? lo : (v > hi ? hi : v); }
#define FA_MFMA(a, b, c) __builtin_amdgcn_mfma_f32_32x32x16_bf16((a), (b), (c), 0, 0, 0)

template <int DK, int KIND>
DI void attn_fast(const Args& a, Frame& F, bool need_ctx) {
    refresh(F);
    constexpr int QP = NHEAD * DK, KP = KIND == 0 ? 256 : NHEAD * DK, VP = KIND == 0 ? 256 : 1024;
    constexpr int KSLOT = 64 * DK * 2, VSLOT = 8192, ND = DK / 16;
    constexpr int L_K = 0, L_V = 3 * KSLOT, L_WS = L_V + 3 * VSLOT, L_BIAS = L_WS + 2048;
    const bf16* QB = (const bf16*)(a.ws + WS_QB); const bf16* KB = (const bf16*)(a.ws + WS_KB); const bf16* VB = (const bf16*)(a.ws + WS_VB); bf16* O = (bf16*)(a.ws + WS_O);
    const int tid = F.tid, lane = F.lane, wid = F.wave, r32 = lane & 31, hi = lane >> 5;
    LAS unsigned char* lds = F.lds;
    LAS float* wsf = (LAS float*)(lds + L_WS) + wid * 64;
    LAS float* biasL = (LAS float*)(lds + L_BIAS);
    const int G = gridDim.x, bx = blockIdx.x; const int vcu = (G % 8 == 0) ? (bx % 8) * (G / 8) + bx / 8 : bx;
    const int nunits = 1024 + (need_ctx ? 64 : 0);
    const lds_cptr kfp = (lds_cptr)lds + L_K + hi * 1024 + r32 * 16;
    const lds_cptr vfp = (lds_cptr)lds + L_V + ((lane >> 4) & 1) * 32 + (lane & 3) * 8 + (4 * hi + ((lane & 15) >> 2)) * 64;
#pragma unroll 1
    for (int u = vcu; u < nunits; u += G) {
        int b, h, qrow0, nt, kr_lo = 0, gr0 = 0; bool isctx;
        if (u < 1024) { const int bh = u >> 4, qb = u & 15; b = bh >> 4; h = bh & 15; qrow0 = b * SB + NCTX + 256 * qb; isctx = false;
            if (KIND == 1) { gr0 = 4 * qb; kr_lo = clampi(gr0 - 4, 0, 56); const int kr_hi = clampi(gr0 - 1, 0, 56) + 7; nt = 4 + kr_hi - kr_lo + 1; } else nt = SB / 64; }
        else { const int j = u - 1024; b = j >> 4; h = j & 15; qrow0 = b * SB; nt = 4; isctx = true; }
        const int kvh = KIND == 0 ? (h >> 2) : h;
        const bf16* Kh = KB + (size_t)b * SB * KP + kvh * DK; const bf16* Vh = VB + (size_t)b * SB * VP + kvh * 64;
        if (KIND == 1 && !isctx) { for (int i = tid; i < 465; i += 512) biasL[i] = a.rel_bias[h * 465 + i] * LOG2E; }
        bf16x8 qr[ND];
        { const bf16* qp = QB + (size_t)(qrow0 + 32 * wid + r32) * QP + h * DK + 8 * hi;
#pragma unroll
          for (int d0 = 0; d0 < ND; ++d0) qr[d0] = *(const bf16x8*)(qp + 16 * d0); }
#define FA_ISSUE(t, slot) do { const int kr_ = 64 * (t) + ((t) >= 4 ? 64 * kr_lo : 0); \
            __builtin_amdgcn_global_load_lds((const unsigned*)(Kh + (size_t)(kr_ + lane) * KP + wid * 8), (LAS unsigned*)(lds + L_K + (slot) * KSLOT + wid * 1024), 16, 0, 0); \
            if (DK == 96) __builtin_amdgcn_global_load_lds((const unsigned*)(Kh + (size_t)(kr_ + lane) * KP + (8 + (wid & 3)) * 8), (LAS unsigned*)(lds + L_K + (slot) * KSLOT + (8 + (wid & 3)) * 1024), 16, 0, 0); \
            __builtin_amdgcn_global_load_lds((const unsigned*)(Vh + (size_t)(kr_ + 16 * (wid & 3) + (lane >> 2)) * VP + (wid >> 2) * 32 + (lane & 3) * 8), (LAS unsigned*)(lds + L_V + (slot) * VSLOT + wid * 1024), 16, 0, 0); } while (0)
        FA_ISSUE(0, 0); FA_ISSUE(1, 1);
        float m_run = -INFINITY, l_run = 0.f; f32x16 o0 = {}, o1 = {};
        int sl_cur = 0, sl_nn = 2;
#pragma unroll 1
        for (int t = 0; t < nt; ++t) {
            if (t + 1 < nt) { if (DK == 96) asm volatile("s_waitcnt vmcnt(3) lgkmcnt(0)" ::: "memory"); else asm volatile("s_waitcnt vmcnt(2) lgkmcnt(0)" ::: "memory"); }
            else asm volatile("s_waitcnt vmcnt(0) lgkmcnt(0)" ::: "memory");
            __builtin_amdgcn_s_barrier(); asm volatile("" ::: "memory");
            if (t + 2 < nt) FA_ISSUE(t + 2, sl_nn);
            bool active = true; int kr = 0, gr = 0;
            if (KIND == 1 && !isctx && t >= 4) { kr = kr_lo + t - 4; gr = gr0 + (wid >> 1); const int r0 = clampi(gr - 4, 0, 56); active = (kr >= r0) && (kr < r0 + 8); }
            if (active) {
                const lds_cptr kp = kfp + sl_cur * KSLOT; const lds_cptr vp = vfp + sl_cur * VSLOT;
                f32x16 s0 = {}, s1 = {};
#pragma unroll
                for (int d0 = 0; d0 < ND; ++d0) { const bf16x8 k0 = *(const __attribute__((address_space(3))) bf16x8*)(kp + d0 * 2048), k1 = *(const __attribute__((address_space(3))) bf16x8*)(kp + d0 * 2048 + 512);
                    s0 = FA_MFMA(k0, qr[d0], s0); s1 = FA_MFMA(k1, qr[d0], s1); }
                if (KIND == 1 && !isctx && t >= 4) {
                    const int gc = (wid & 1) * 32 + r32, c0 = clampi(gc - 8, 0, 48); const LAS float* bl = biasL + (kr - gr + 7) * 31 + 15 - gc;
#pragma unroll
                    for (int r = 0; r < 16; ++r) { const int kc = crow(r, hi);
                        s0[r] = (kc >= c0 && kc < c0 + 16) ? s0[r] + bl[kc] : -INFINITY;
                        s1[r] = (kc + 32 >= c0 && kc + 32 < c0 + 16) ? s1[r] + bl[kc + 32] : -INFINITY; }
                }
                float rm = fmaxf(s0[0], s1[0]);
#pragma unroll
                for (int r = 1; r < 16; ++r) rm = fmaxf(rm, fmaxf(s0[r], s1[r]));
                { auto rr = __builtin_amdgcn_permlane32_swap(__float_as_uint(rm), __float_as_uint(rm), false, false); rm = fmaxf(__uint_as_float(rr[0]), __uint_as_float(rr[1])); }
                const float mn = fmaxf(m_run, rm);
                if (__any(mn > m_run)) {
                    const float al = __builtin_amdgcn_exp2f(m_run - mn); l_run *= al;
                    if (hi == 0) wsf[r32] = al;
#pragma unroll
                    for (int r = 0; r < 16; ++r) { const float f = wsf[crow(r, hi)]; o0[r] *= f; o1[r] *= f; }
                }
                m_run = mn;
                float ps = 0.f;
#pragma unroll
                for (int r = 0; r < 16; ++r) { s0[r] = __builtin_amdgcn_exp2f(s0[r] - mn); s1[r] = __builtin_amdgcn_exp2f(s1[r] - mn); ps += s0[r] + s1[r]; }
                l_run += ps;
                u32x4 pw[4];
#pragma unroll
                for (int i = 0; i < 4; ++i) { pw[0][i] = cvtpk(s0[2 * i], s0[2 * i + 1]); pw[1][i] = cvtpk(s0[8 + 2 * i], s0[8 + 2 * i + 1]); pw[2][i] = cvtpk(s1[2 * i], s1[2 * i + 1]); pw[3][i] = cvtpk(s1[8 + 2 * i], s1[8 + 2 * i + 1]); }
#pragma unroll
                for (int ks = 0; ks < 4; ++ks) {
                    const s16x4 a0 = vtr(vp + ks * 1024), a1 = vtr(vp + ks * 1024 + 512), b0 = vtr(vp + 4096 + ks * 1024), b1 = vtr(vp + 4096 + ks * 1024 + 512);
                    const bf16x8 v0 = {a0[0], a0[1], a0[2], a0[3], a1[0], a1[1], a1[2], a1[3]}, v1 = {b0[0], b0[1], b0[2], b0[3], b1[0], b1[1], b1[2], b1[3]};
                    const bf16x8 pa = __builtin_bit_cast(bf16x8, pw[ks]);
                    o0 = FA_MFMA(pa, v0, o0); o1 = FA_MFMA(pa, v1, o1);
                }
            }
            sl_cur = sl_cur == 2 ? 0 : sl_cur + 1; sl_nn = sl_nn == 2 ? 0 : sl_nn + 1;
        }
        { auto rr = __builtin_amdgcn_permlane32_swap(__float_as_uint(l_run), __float_as_uint(l_run), false, false); l_run = __uint_as_float(rr[0]) + __uint_as_float(rr[1]); }
        if (hi == 0) wsf[32 + r32] = 1.0f / l_run;
        bf16* Ow = O + (size_t)(qrow0 + 32 * wid) * 1024 + h * 64 + r32;
#pragma unroll
        for (int r = 0; r < 16; ++r) { const int q = crow(r, hi); const float il = wsf[32 + q];
            Ow[(size_t)q * 1024] = (bf16)f2bf(o0[r] * il); Ow[(size_t)q * 1024 + 32] = (bf16)f2bf(o1[r] * il); }
        asm volatile("s_waitcnt lgkmcnt(0)" ::: "memory");
        __builtin_amdgcn_s_barrier(); asm volatile("" ::: "memory");
#undef FA_ISSUE
    }
}
#undef FA_MFMA
}


namespace fa2 {
using fa::lds_cptr; using fa::s16x4; using fa::v4i16_t;
#define SBAR() __builtin_amdgcn_sched_barrier(0)
constexpr int NSLOT = 3, SLOTB = 8192;
constexpr int LDS_K = 0, LDS_V = NSLOT * SLOTB, LDS_WS = 2 * NSLOT * SLOTB, LDS_OST = LDS_WS + 8 * 64 * 4, LDS_BIAS = LDS_OST + 8 * 4096, LDS_BYTES = LDS_BIAS + 2048;
DI void glds16(const void* gsrc, unsigned lds_dst) { unsigned keep;
    asm volatile("s_mov_b32 %0, m0\n\ts_mov_b32 m0, %2\n\ts_nop 0\n\tglobal_load_lds_dwordx4 %1, off\n\ts_mov_b32 m0, %0" : "=&s"(keep) : "v"(gsrc), "s"(lds_dst) : "memory"); }
DI void glds16s(const void* sbase, unsigned voff, unsigned lds_dst) { unsigned keep;
    asm volatile("s_mov_b32 %0, m0\n\ts_mov_b32 m0, %3\n\ts_nop 0\n\tglobal_load_lds_dwordx4 %1, %2\n\ts_mov_b32 m0, %0" : "=&s"(keep) : "v"(voff), "s"(sbase), "s"(lds_dst) : "memory"); }
DI float max3f(float a, float b, float c) { float r; asm("v_max3_f32 %0, %1, %2, %3" : "=v"(r) : "v"(a), "v"(b), "v"(c)); return r; }
DI float max2f(float a, float b) { float r; asm("v_max_f32_e32 %0, %1, %2" : "=v"(r) : "v"(a), "v"(b)); return r; }
DI float fadd_s(float a, float b) { float r; asm("v_add_f32_e32 %0, %1, %2" : "=v"(r) : "v"(a), "v"(b)); return r; }
DI float fsub_s(float a, float b) { float r; asm("v_sub_f32_e32 %0, %1, %2" : "=v"(r) : "v"(a), "v"(b)); return r; }
DI unsigned cvtpk_s(float lo, float hi) { return fa::cvtpk(lo, hi); }
#define WAIT_BAR(N) asm volatile("s_waitcnt vmcnt(" #N ") lgkmcnt(0)\n\ts_barrier" ::: "memory")
typedef const __attribute__((address_space(3))) bf16x8* lds_b8p;
DI void qkt(f32x16& p0, f32x16& p1, lds_cptr kb, const bf16x8* qr, const f32x16& negm) {
#pragma unroll
    for (int d0 = 0; d0 < 4; ++d0) {
        const bf16x8 b0 = *(lds_b8p)(kb + d0 * 2048); const bf16x8 b1 = *(lds_b8p)(kb + d0 * 2048 + 512);
        if (d0 == 0) { p0 = __builtin_amdgcn_mfma_f32_32x32x16_bf16(b0, qr[0], negm, 0, 0, 0); p1 = __builtin_amdgcn_mfma_f32_32x32x16_bf16(b1, qr[0], negm, 0, 0, 0); }
        else { p0 = __builtin_amdgcn_mfma_f32_32x32x16_bf16(b0, qr[d0], p0, 0, 0, 0); p1 = __builtin_amdgcn_mfma_f32_32x32x16_bf16(b1, qr[d0], p1, 0, 0, 0); } }
}
DI void kload8(bf16x8* kf, lds_cptr kp) {
    kf[0] = *(lds_b8p)(kp);        kf[1] = *(lds_b8p)(kp + 512);  kf[2] = *(lds_b8p)(kp + 2048); kf[3] = *(lds_b8p)(kp + 2560);
    kf[4] = *(lds_b8p)(kp + 4096); kf[5] = *(lds_b8p)(kp + 4608); kf[6] = *(lds_b8p)(kp + 6144); kf[7] = *(lds_b8p)(kp + 6656);
}
DI void kload2(bf16x8* kf, lds_cptr kp, int j) { kf[2 * j] = *(lds_b8p)(kp + j * 2048); kf[2 * j + 1] = *(lds_b8p)(kp + j * 2048 + 512); }
DI float rowmax(const f32x16& p0, const f32x16& p1) {
    float a = max3f(p0[0], p0[1], p1[0]), b = max3f(p0[2], p0[3], p1[1]); a = max3f(a, p1[2], p1[3]);
#pragma unroll
    for (int r = 4; r < 16; r += 4) { a = max3f(a, p0[r], p0[r + 1]); b = max3f(b, p0[r + 2], p0[r + 3]); a = max3f(a, p1[r], p1[r + 1]); b = max3f(b, p1[r + 2], p1[r + 3]); }
    const float m = max2f(a, b);
    auto rr = __builtin_amdgcn_permlane32_swap(__float_as_uint(m), __float_as_uint(m), false, false);
    return max2f(__uint_as_float(rr[0]), __uint_as_float(rr[1]));
}
DI void pv(f32x16* o, int vb, bf16x8 pa0, bf16x8 pa1, bf16x8 pa2, bf16x8 pa3) {
#pragma unroll
    for (int d0 = 0; d0 < 2; ++d0) { s16x4 lo[4], hi[4];
#pragma unroll
        for (int ks = 0; ks < 4; ++ks) {
            asm volatile("ds_read_b64_tr_b16 %0,%1 offset:%c2" : "=&v"(lo[ks]) : "v"(vb), "i"(d0 * 4096 + ks * 1024) : "memory");
            asm volatile("ds_read_b64_tr_b16 %0,%1 offset:%c2" : "=&v"(hi[ks]) : "v"(vb), "i"(d0 * 4096 + ks * 1024 + 512) : "memory"); }
        asm volatile("s_waitcnt lgkmcnt(0)" ::: "memory"); SBAR();
#define PK(k) (bf16x8){lo[k][0], lo[k][1], lo[k][2], lo[k][3], hi[k][0], hi[k][1], hi[k][2], hi[k][3]}
        o[d0] = __builtin_amdgcn_mfma_f32_32x32x16_bf16(pa0, PK(0), o[d0], 0, 0, 0);
        o[d0] = __builtin_amdgcn_mfma_f32_32x32x16_bf16(pa1, PK(1), o[d0], 0, 0, 0);
        o[d0] = __builtin_amdgcn_mfma_f32_32x32x16_bf16(pa2, PK(2), o[d0], 0, 0, 0);
        o[d0] = __builtin_amdgcn_mfma_f32_32x32x16_bf16(pa3, PK(3), o[d0], 0, 0, 0);
#undef PK
    }
}
DI float partner32(float v, int hi) { auto rr = __builtin_amdgcn_permlane32_swap(__float_as_uint(v), __float_as_uint(v), false, false); return __uint_as_float(hi ? rr[0] : rr[1]); }
DI void qfrag64(bf16x8* qr, const bf16* qp  , const float* qg, const float* R64, bool rope, int gr, int gc, int hi) {
    float v[4][8]; float ss = 0.f;
#pragma unroll
    for (int d0 = 0; d0 < 4; ++d0) { unpack8(*(const u32x4*)(qp + 16 * d0), v[d0]);
#pragma unroll
        for (int j = 0; j < 8; ++j) ss += v[d0][j] * v[d0][j]; }
    ss += partner32(ss, hi);
    const float rs = 1.0f / sqrtf(ss * (1.f / 64.f) + EPS);
#pragma unroll
    for (int d0 = 0; d0 < 4; ++d0)
#pragma unroll
        for (int j = 0; j < 8; ++j) v[d0][j] *= rs * qg[16 * d0 + 8 * hi + j];
    if (rope) { const float* cr = R64 + (gr * 16 + 8 * hi) * 2; const float* cc = R64 + (gc * 16 + 8 * hi) * 2;
#pragma unroll
        for (int j = 0; j < 8; ++j) { float c = cr[2 * j], sn = cr[2 * j + 1], x1 = v[0][j], x2 = v[1][j]; v[0][j] = x1 * c - x2 * sn; v[1][j] = x1 * sn + x2 * c;
            c = cc[2 * j]; sn = cc[2 * j + 1]; x1 = v[2][j]; x2 = v[3][j]; v[2][j] = x1 * c - x2 * sn; v[3][j] = x1 * sn + x2 * c; } }
#pragma unroll
    for (int d0 = 0; d0 < 4; ++d0) { float t8[8];
#pragma unroll
        for (int j = 0; j < 8; ++j) t8[j] = v[d0][j] * C2_64;
        qr[d0] = __builtin_bit_cast(bf16x8, pack8(t8)); }
}
DI void qfrag96(bf16x8* qr, const bf16* qp  , const float* qg, const float* R32, bool rope, int gr, int gc, int hi) {
    float v[6][8]; float sn_ = 0.f, sr_ = 0.f;
#pragma unroll
    for (int d0 = 0; d0 < 6; ++d0) { unpack8(*(const u32x4*)(qp + 16 * d0), v[d0]);
#pragma unroll
        for (int j = 0; j < 8; ++j) { if (d0 < 4) sn_ += v[d0][j] * v[d0][j]; else sr_ += v[d0][j] * v[d0][j]; } }
    sn_ += partner32(sn_, hi); sr_ += partner32(sr_, hi);
    const float rn = 1.0f / sqrtf(sn_ * (1.f / 64.f) + EPS), rr = 1.0f / sqrtf(sr_ * (1.f / 32.f) + EPS);
#pragma unroll
    for (int d0 = 0; d0 < 6; ++d0)
#pragma unroll
        for (int j = 0; j < 8; ++j) v[d0][j] *= (d0 < 4 ? rn : rr) * qg[16 * d0 + 8 * hi + j];
    if (rope) {
#pragma unroll
        for (int blk = 4; blk < 6; ++blk) { const float* cs = R32 + ((blk == 4 ? gr : gc) * 8) * 2;
#pragma unroll
            for (int j = 0; j < 8; ++j) { const float other = partner32(v[blk][j], hi), c = cs[2 * j], sn = cs[2 * j + 1];
                v[blk][j] = hi ? (other * sn + v[blk][j] * c) : (v[blk][j] * c - other * sn); } } }
#pragma unroll
    for (int d0 = 0; d0 < 6; ++d0) { float t8[8];
#pragma unroll
        for (int j = 0; j < 8; ++j) t8[j] = v[d0][j] * C2_96;
        qr[d0] = __builtin_bit_cast(bf16x8, pack8(t8)); }
}
DI void nat_mask(f32x16& p0, f32x16& p1, int kr, int gr, int gc, int hi, const LAS float* biasL) {
    const int r0 = fa::clampi(gr - 4, 0, 56); const bool row_ok = (kr >= r0) && (kr < r0 + 8);
    if (!row_ok) {
#pragma unroll
        for (int r = 0; r < 16; ++r) { p0[r] = -INFINITY; p1[r] = -INFINITY; }
        return;
    }
    const int c0 = fa::clampi(gc - 8, 0, 48);
    const LAS float* bl = biasL + (kr - gr + 7) * 31 + 15 - gc + 4 * hi;
    const unsigned d0 = (unsigned)(4 * hi - c0);
#pragma unroll
    for (int r = 0; r < 16; ++r) { const int kq = (r & 3) + 8 * (r >> 2);
        const float b0 = bl[kq], b1 = bl[kq + 32];
        p0[r] = (d0 + (unsigned)kq < 16u) ? p0[r] + b0 : -INFINITY;
        p1[r] = (d0 + (unsigned)(kq + 32) < 16u) ? p1[r] + b1 : -INFINITY; }
}

template <int KIND, int QP, int KP, int VP>
DI void attn_unit(const bf16* Qw, const bf16* Kh, const bf16* Vh, bf16* Ow, const int NT, const int nt_real, const int kr_lo, const int gr, LAS unsigned char* shm, const int lane, const int wid,
                  const float* qg, const float* R64, const bool rope_q, const int qt0  ) {
    const int r32 = lane & 31, hi = lane >> 5;
    const unsigned lds0 = (unsigned)(size_t)shm;
    LAS float* wsf = (LAS float*)(shm + LDS_WS) + wid * 64;
    const LAS float* biasL = (const LAS float*)(shm + LDS_BIAS);
    const unsigned koff = (unsigned)(lane * KP + wid * 8) * 2u;
    const unsigned voff = (unsigned)((16 * (wid & 3) + (lane >> 2)) * VP + (wid >> 2) * 32 + (lane & 3) * 8) * 2u;
    const unsigned kdst = lds0 + LDS_K + wid * 1024, vdst = lds0 + LDS_V + wid * 1024;
#define TROW(t) ((KIND == 1) ? (((t) >= nt_real) ? 0 : 64 * (t) + ((t) >= 4 ? 64 * kr_lo : 0)) : 64 * (t))
#define DMA_K(t, slot) glds16s(Kh + (long)TROW(t) * KP, koff, (unsigned)__builtin_amdgcn_readfirstlane(kdst + (slot)))
#define DMA_V(t, slot) glds16s(Vh + (long)TROW(t) * VP, voff, (unsigned)__builtin_amdgcn_readfirstlane(vdst + (slot)))
    bf16x8 kf[8];
    const lds_cptr shm3 = (lds_cptr)shm; const lds_cptr kp0 = shm3 + LDS_K + hi * 1024 + r32 * 16; const lds_cptr vp0 = shm3 + LDS_V + ((lane >> 4) & 1) * 32 + (lane & 3) * 8 + (4 * hi + ((lane & 15) >> 2)) * 64;
    DMA_K(0, 0); DMA_V(0, 0); DMA_K(1, SLOTB);
    bf16x8 qr[4];
#pragma unroll
    for (int d0 = 0; d0 < 4; ++d0) qr[d0] = bf16x8{};
    qfrag64(qr, Qw + (long)r32 * QP + hi * 8, qg, R64, rope_q, (qt0 + r32) >> 6, (qt0 + r32) & 63, hi);
    float l_reg = 0.f; f32x16 o[2]; o[0] = f32x16{}; o[1] = f32x16{}; const f32x16 zero16 = f32x16{};
    const int gc = (wid & 1) * 32 + r32;
#define CMASK(P0, P1, t) do { if (KIND == 1 && (t) >= 4) nat_mask(P0, P1, ((t) < nt_real) ? kr_lo + (t) - 4 : -100, gr, gc, hi, biasL); } while (0)
    f32x16 pA0, pA1, pB0, pB1;
    int sl_prev = 0, sl_cur = 0, sl_next = SLOTB;
#define ROT() do { sl_prev = sl_cur; sl_cur = sl_next; sl_next = (sl_next == (NSLOT - 1) * SLOTB) ? 0 : sl_next + SLOTB; } while (0)
    DMA_K(2, 2 * SLOTB);
    WAIT_BAR(3);
    qkt(pA0, pA1, kp0, qr, zero16); asm volatile("s_nop 15\n\ts_nop 7" : "+v"(pA0), "+v"(pA1));
    _Pragma("unroll") for (int r = 0; r < 16; ++r) { pA0[r] = __builtin_amdgcn_exp2f(pA0[r]); pA1[r] = __builtin_amdgcn_exp2f(pA1[r]); }
    WAIT_BAR(0);
    DMA_K(3, 0); DMA_V(1, SLOTB);
    ROT();
    kload8(kf, kp0 + sl_cur);
    WAIT_BAR(2);
    s16x4 vlo[8], vhi[8]; u32x4 pw0, pw1, pw2, pw3;
#define PKW(P, B) cvtpk_s(P[B], P[B + 1])
#define PAF(k) __builtin_bit_cast(bf16x8, pw##k)
#define VFR(i) (bf16x8){vlo[i][0], vlo[i][1], vlo[i][2], vlo[i][3], vhi[i][0], vhi[i][1], vhi[i][2], vhi[i][3]}
#define PIN(x) asm volatile("" : "+v"(x))
#define GAPA(MF, A0, A1, A2, A3, W0, W1, PW) do { MF; sacc += A0; sacc += A1; sacc += A2; sacc += A3; PIN(sacc); W0; W1; PIN(PW); SBAR(); } while (0)
#define EX(v) __builtin_amdgcn_exp2f(v)
#define GAPB(MF, X, B) do { MF; X[B] = EX(X[B]); X[B + 1] = EX(X[B + 1]); X[B + 2] = EX(X[B + 2]); X[B + 3] = EX(X[B + 3]); PIN(X); SBAR(); } while (0)
#define VRD(i) do { vlo[i] = fa::vtr(vp_ + (((i) >> 2) * 4096 + ((i) & 3) * 1024)); vhi[i] = fa::vtr(vp_ + (((i) >> 2) * 4096 + ((i) & 3) * 1024 + 512)); } while (0)
#define KRD(G, j) do { if (G) { kload2(kf, kp0 + sl_next, j); SBAR(); } } while (0)
#define STEP(C0, C1, P0, P1, t, GK, GV, GL) do { SBAR(); \
    const lds_cptr vp_ = vp0 + sl_prev; \
    VRD(0); SBAR(); float sacc = (P0[0] + P0[1]); \
    GAPA(C0 = __builtin_amdgcn_mfma_f32_32x32x16_bf16(kf[0], qr[0], zero16, 0, 0, 0), P0[2], P0[3], P0[4], P0[5],     pw0[0] = PKW(P0, 0), pw0[1] = PKW(P0, 2), pw0); \
    VRD(4); SBAR(); GAPA(C1 = __builtin_amdgcn_mfma_f32_32x32x16_bf16(kf[1], qr[0], zero16, 0, 0, 0), P0[6], P0[7], P0[8], P0[9],     pw0[2] = PKW(P0, 4), pw0[3] = PKW(P0, 6), pw0); \
    VRD(1); SBAR(); GAPA(C0 = __builtin_amdgcn_mfma_f32_32x32x16_bf16(kf[2], qr[1], C0, 0, 0, 0),   P0[10], P0[11], P0[12], P0[13], pw1[0] = PKW(P0, 8), pw1[1] = PKW(P0, 10), pw1); \
    VRD(5); SBAR(); GAPA(C1 = __builtin_amdgcn_mfma_f32_32x32x16_bf16(kf[3], qr[1], C1, 0, 0, 0),   P0[14], P0[15], P1[0], P1[1],   pw1[2] = PKW(P0, 12), pw1[3] = PKW(P0, 14), pw1); \
    VRD(2); SBAR(); GAPA(C0 = __builtin_amdgcn_mfma_f32_32x32x16_bf16(kf[4], qr[2], C0, 0, 0, 0),   P1[2], P1[3], P1[4], P1[5],     pw2[0] = PKW(P1, 0), pw2[1] = PKW(P1, 2), pw2); \
    VRD(6); SBAR(); GAPA(C1 = __builtin_amdgcn_mfma_f32_32x32x16_bf16(kf[5], qr[2], C1, 0, 0, 0),   P1[6], P1[7], P1[8], P1[9],     pw2[2] = PKW(P1, 4), pw2[3] = PKW(P1, 6), pw2); \
    VRD(3); SBAR(); GAPA(C0 = __builtin_amdgcn_mfma_f32_32x32x16_bf16(kf[6], qr[3], C0, 0, 0, 0),   P1[10], P1[11], P1[12], P1[13], pw3[0] = PKW(P1, 8), pw3[1] = PKW(P1, 10), pw3); \
    VRD(7); SBAR(); GAPA(C1 = __builtin_amdgcn_mfma_f32_32x32x16_bf16(kf[7], qr[3], C1, 0, 0, 0),   P1[14], P1[15], 0.f, 0.f,       pw3[2] = PKW(P1, 12), pw3[3] = PKW(P1, 14), pw3); \
    l_reg += sacc; \
    if (GK) { DMA_K((t) + 3, sl_cur); } if (GV) { DMA_V((t) + 1, sl_next); } \
    CMASK(C0, C1, t); \
    SBAR(); \
    GAPB(o[0] = __builtin_amdgcn_mfma_f32_32x32x16_bf16(PAF(0), VFR(0), o[0], 0, 0, 0), C0, 0); \
    GAPB(o[1] = __builtin_amdgcn_mfma_f32_32x32x16_bf16(PAF(0), VFR(4), o[1], 0, 0, 0), C0, 4); \
    KRD(GL, 0); GAPB(o[0] = __builtin_amdgcn_mfma_f32_32x32x16_bf16(PAF(1), VFR(1), o[0], 0, 0, 0), C0, 8); \
    KRD(GL, 1); GAPB(o[1] = __builtin_amdgcn_mfma_f32_32x32x16_bf16(PAF(1), VFR(5), o[1], 0, 0, 0), C0, 12); \
    KRD(GL, 2); GAPB(o[0] = __builtin_amdgcn_mfma_f32_32x32x16_bf16(PAF(2), VFR(2), o[0], 0, 0, 0), C1, 0); \
    KRD(GL, 3); GAPB(o[1] = __builtin_amdgcn_mfma_f32_32x32x16_bf16(PAF(2), VFR(6), o[1], 0, 0, 0), C1, 4); \
    GAPB(o[0] = __builtin_amdgcn_mfma_f32_32x32x16_bf16(PAF(3), VFR(3), o[0], 0, 0, 0), C1, 8); \
    GAPB(o[1] = __builtin_amdgcn_mfma_f32_32x32x16_bf16(PAF(3), VFR(7), o[1], 0, 0, 0), C1, 12); \
    } while (0)
    int t = 1;
#define ENDW(tt) do { if ((tt) + 3 < NT) { WAIT_BAR(2); } else if ((tt) + 2 < NT) { WAIT_BAR(1); } else { WAIT_BAR(0); } } while (0)
    if (KIND == 0) {
#undef CMASK
#define CMASK(P0, P1, t) do { } while (0)
        for (; t + 5 < NT; t += 2) {
            STEP(pB0, pB1, pA0, pA1, t, true, true, true);     WAIT_BAR(2); ROT();
            STEP(pA0, pA1, pB0, pB1, t + 1, true, true, true); WAIT_BAR(2); ROT();
        }
#undef CMASK
#define CMASK(P0, P1, t) do { if (KIND == 1 && (t) >= 4) nat_mask(P0, P1, ((t) < nt_real) ? kr_lo + (t) - 4 : -100, gr, gc, hi, biasL); } while (0)
    }
    for (; t + 1 < NT; t += 2) {
        STEP(pB0, pB1, pA0, pA1, t, (t + 3 < NT), (t + 1 < NT), (t + 1 < NT));         ENDW(t);     ROT();
        STEP(pA0, pA1, pB0, pB1, t + 1, (t + 4 < NT), (t + 2 < NT), (t + 2 < NT));     ENDW(t + 1); ROT();
    }
    STEP(pB0, pB1, pA0, pA1, NT - 1, false, false, false);
    { float sacc = pB0[0] + pB0[1]; _Pragma("unroll") for (int r = 2; r < 16; ++r) sacc += pB0[r]; _Pragma("unroll") for (int r = 0; r < 16; ++r) sacc += pB1[r]; l_reg += sacc;
      pw0 = (u32x4){PKW(pB0, 0), PKW(pB0, 2), PKW(pB0, 4), PKW(pB0, 6)}; pw1 = (u32x4){PKW(pB0, 8), PKW(pB0, 10), PKW(pB0, 12), PKW(pB0, 14)}; pw2 = (u32x4){PKW(pB1, 0), PKW(pB1, 2), PKW(pB1, 4), PKW(pB1, 6)}; pw3 = (u32x4){PKW(pB1, 8), PKW(pB1, 10), PKW(pB1, 12), PKW(pB1, 14)};
      const int vb0 = (int)(lds0 + LDS_V) + ((lane >> 4) & 1) * 32 + (lane & 3) * 8 + (4 * hi + ((lane & 15) >> 2)) * 64;
      SBAR(); pv(o, vb0 + sl_cur, PAF(0), PAF(1), PAF(2), PAF(3)); }
    { auto rr = __builtin_amdgcn_permlane32_swap(__float_as_uint(l_reg), __float_as_uint(l_reg), false, false); l_reg = __uint_as_float(rr[0]) + __uint_as_float(rr[1]); }
    if (hi == 0) wsf[32 + r32] = l_reg; asm volatile("s_waitcnt lgkmcnt(0)" ::: "memory");
    float rli[16];
#pragma unroll
    for (int r = 0; r < 16; ++r) rli[r] = __builtin_amdgcn_rcpf(wsf[32 + crow(r, hi)]);
    { LAS bf16* stg = (LAS bf16*)(shm + LDS_OST) + wid * 2048;
#pragma unroll
      for (int r = 0; r < 16; ++r) { const int orow = crow(r, hi);
#pragma unroll
          for (int d0 = 0; d0 < 2; ++d0) stg[orow * 64 + d0 * 32 + r32] = (bf16)f2bf(o[d0][r] * rli[r]); }
      asm volatile("s_waitcnt lgkmcnt(0)" ::: "memory");
#pragma unroll
      for (int i = 0; i < 4; ++i) { const int row = i * 8 + (lane >> 3), ch = lane & 7; const u32x4 v = *(const LAS u32x4*)(stg + row * 64 + ch * 8); *(u32x4*)(Ow + (long)row * 1024 + ch * 8) = v; } }
    asm volatile("s_waitcnt lgkmcnt(0)\n\ts_barrier" ::: "memory");
#undef TROW
#undef DMA_K
#undef DMA_V
#undef CMASK
#undef ROT
#undef PKW
#undef PAF
#undef VFR
#undef PIN
#undef GAPA
#undef GAPB
#undef EX
#undef VRD
#undef KRD
#undef STEP
#undef ENDW
}
#undef SBAR
#undef WAIT_BAR

template <int KIND>
DI void attn_phase(const Args& a, Frame& F, bool need_ctx, int l) {
    refresh(F);
    constexpr int KP = KIND == 0 ? 256 : 1024, RP = KIND == 0 ? 1536 : 3072  , VOFF = KIND == 0 ? 1280 : 2048;
    const bf16* RAW = (const bf16*)(a.ws + WS_RAW); const bf16* KB = (const bf16*)(a.ws + WS_KB); bf16* O = (bf16*)(a.ws + WS_O);
    const float* qg = a.q_gain[l]; const float* R64 = (const float*)(a.ws + WS_ROPE);
    const int wid = F.wave;
    LAS unsigned char* lds = F.lds; LAS float* biasL = (LAS float*)(lds + LDS_BIAS);
    const int G = gridDim.x, bx = blockIdx.x; const int vcu = (G % 8 == 0) ? (bx % 8) * (G / 8) + bx / 8 : bx;
    const int nunits = 1024 + (need_ctx ? 64 : 0);
#pragma unroll 1
    for (int u = vcu; u < nunits; u += G) {
        int b, h, qrow0, nt, kr_lo = 0, gr0 = 0, qt0 = 0; bool isctx;
        if (u < 1024) { const int bh = u >> 4, qb = u & 15; b = bh >> 4; h = bh & 15; qrow0 = b * SB + NCTX + 256 * qb; qt0 = 256 * qb + 32 * wid; isctx = false;
            if (KIND == 1) { gr0 = 4 * qb; kr_lo = fa::clampi(gr0 - 4, 0, 56); const int kr_hi = fa::clampi(gr0 - 1, 0, 56) + 7; nt = 4 + kr_hi - kr_lo + 1; } else nt = SB / 64; }
        else { const int j = u - 1024; b = j >> 4; h = j & 15; qrow0 = b * SB; nt = 4; isctx = true; }
        const int kvh = KIND == 0 ? (h >> 2) : h;
        const bf16* Kh = KB + (size_t)b * SB * KP + kvh * 64; const bf16* Vh = RAW + (size_t)b * SB * RP + VOFF + kvh * 64;
        const bf16* Qw = RAW + (size_t)(qrow0 + 32 * wid) * RP + h * 64; bf16* Ow = O + (size_t)(qrow0 + 32 * wid) * 1024 + h * 64;
        const int lane_u = lane_id();
        if (KIND == 1 && !isctx) { const int i = wid * 64 + lane_u; if (i < 465) biasL[i] = a.rel_bias[h * 465 + i] * LOG2E; }
        const int NT = (nt + 1) & ~1;
        if (KIND == 1 && !isctx) attn_unit<1, RP, KP, RP>(Qw, Kh, Vh, Ow, NT, nt, kr_lo, gr0 + (wid >> 1), lds, lane_u, wid, qg, R64, false, 0);
        else attn_unit<0, RP, KP, RP>(Qw, Kh, Vh, Ow, NT, nt, 0, 0, lds, lane_u, wid, qg, R64, KIND == 0 && !isctx, qt0);
    }
}
}


namespace fa2 {
#define SBAR() __builtin_amdgcn_sched_barrier(0)
#define WAIT_BAR(N) asm volatile("s_waitcnt vmcnt(" #N ") lgkmcnt(0)\n\ts_barrier" ::: "memory")
constexpr int SLOTK96 = 12288;
constexpr int L96_K = 0, L96_V = NSLOT * SLOTK96, L96_WS = L96_V + NSLOT * SLOTB, L96_OST = L96_WS + 8 * 64 * 4, L96_BYTES = L96_OST + 8 * 4096;
DI void attn_unit96(const bf16* Qw, const bf16* Kh, const bf16* Vh, bf16* Ow, const int NT, LAS unsigned char* shm, const int lane, const int wid, const float* qg, const float* R32, const bool rope_q, const int qt0) {
    constexpr int QP = 1536, KP = 1536, VP = 2048;
    const int r32 = lane & 31, hi = lane >> 5;
    const unsigned lds0 = (unsigned)(size_t)shm;
    LAS float* wsf = (LAS float*)(shm + L96_WS) + wid * 64;
    const unsigned koff = (unsigned)(lane * KP + wid * 8) * 2u;
    const unsigned voff = (unsigned)((16 * (wid & 3) + (lane >> 2)) * VP + (wid >> 2) * 32 + (lane & 3) * 8) * 2u;
    const int c2d = (8 + (wid & 3) - wid) * 8;
    const unsigned kdst = lds0 + L96_K + wid * 1024, kdst2 = lds0 + L96_K + (8 + (wid & 3)) * 1024, vdst = lds0 + L96_V + wid * 1024;
#define DMA_K(t, si) do { glds16s(Kh + (long)(64 * (t)) * KP, koff, (unsigned)__builtin_amdgcn_readfirstlane(kdst + (si) * SLOTK96)); glds16s(Kh + (long)(64 * (t)) * KP + c2d, koff, (unsigned)__builtin_amdgcn_readfirstlane(kdst2 + (si) * SLOTK96)); } while (0)
#define DMA_V(t, si) glds16s(Vh + (long)(64 * (t)) * VP, voff, (unsigned)__builtin_amdgcn_readfirstlane(vdst + (si) * SLOTB))
    bf16x8 kf[12];
    const lds_cptr shm3 = (lds_cptr)shm; const lds_cptr kp0 = shm3 + L96_K + hi * 1024 + r32 * 16; const lds_cptr vp0 = shm3 + L96_V + ((lane >> 4) & 1) * 32 + (lane & 3) * 8 + (4 * hi + ((lane & 15) >> 2)) * 64;
    DMA_K(0, 0); DMA_V(0, 0); DMA_K(1, 1);
    bf16x8 qr[6];
#pragma unroll
    for (int d0 = 0; d0 < 6; ++d0) qr[d0] = bf16x8{};
    qfrag96(qr, Qw + (long)r32 * QP + hi * 8, qg, R32, rope_q, (qt0 + r32) >> 6, (qt0 + r32) & 63, hi);
    float l_reg = 0.f; f32x16 o[2]; o[0] = f32x16{}; o[1] = f32x16{}; const f32x16 zero16 = f32x16{};
    f32x16 pA0, pA1, pB0, pB1;
    int i_prev = 0, i_cur = 0, i_next = 1;
#define ROT() do { i_prev = i_cur; i_cur = i_next; i_next = (i_next == NSLOT - 1) ? 0 : i_next + 1; } while (0)
    DMA_K(2, 2);
    WAIT_BAR(5);
    { pA0 = zero16; pA1 = zero16;
#pragma unroll
      for (int d0 = 0; d0 < 6; ++d0) { const bf16x8 b0 = *(lds_b8p)(kp0 + d0 * 2048); const bf16x8 b1 = *(lds_b8p)(kp0 + d0 * 2048 + 512);
          pA0 = __builtin_amdgcn_mfma_f32_32x32x16_bf16(b0, qr[d0], pA0, 0, 0, 0); pA1 = __builtin_amdgcn_mfma_f32_32x32x16_bf16(b1, qr[d0], pA1, 0, 0, 0); } }
    asm volatile("s_nop 15\n\ts_nop 7" : "+v"(pA0), "+v"(pA1));
    _Pragma("unroll") for (int r = 0; r < 16; ++r) { pA0[r] = __builtin_amdgcn_exp2f(pA0[r]); pA1[r] = __builtin_amdgcn_exp2f(pA1[r]); }
    WAIT_BAR(0);
    DMA_K(3, 0); DMA_V(1, 1);
    ROT();
    { const lds_cptr kp = kp0 + i_cur * SLOTK96;
#pragma unroll
      for (int j = 0; j < 6; ++j) { kf[2 * j] = *(lds_b8p)(kp + j * 2048); kf[2 * j + 1] = *(lds_b8p)(kp + j * 2048 + 512); } }
    WAIT_BAR(3);
    s16x4 vlo[8], vhi[8]; u32x4 pw0, pw1, pw2, pw3;
#define PKW(P, B) cvtpk_s(P[B], P[B + 1])
#define PAF(k) __builtin_bit_cast(bf16x8, pw##k)
#define VFR(i) (bf16x8){vlo[i][0], vlo[i][1], vlo[i][2], vlo[i][3], vhi[i][0], vhi[i][1], vhi[i][2], vhi[i][3]}
#define PIN(x) asm volatile("" : "+v"(x))
#define GAPA(MF, A0, A1, A2, W0, W1, PW) do { MF; sacc += A0; sacc += A1; sacc += A2; PIN(sacc); W0; W1; PIN(PW); SBAR(); } while (0)
#define GAPN(MF, A0, A1, A2) do { MF; sacc += A0; sacc += A1; sacc += A2; PIN(sacc); SBAR(); } while (0)
#define GAP0(MF) do { MF; SBAR(); } while (0)
#define EX(v) __builtin_amdgcn_exp2f(v)
#define GAPB(MF, X, B) do { MF; X[B] = EX(X[B]); X[B + 1] = EX(X[B + 1]); X[B + 2] = EX(X[B + 2]); X[B + 3] = EX(X[B + 3]); PIN(X); SBAR(); } while (0)
#define VRD(i) do { vlo[i] = fa::vtr(vp_ + (((i) >> 2) * 4096 + ((i) & 3) * 1024)); vhi[i] = fa::vtr(vp_ + (((i) >> 2) * 4096 + ((i) & 3) * 1024 + 512)); } while (0)
#define KRD(G, j) do { if (G) { kload2(kf, kn_, j); SBAR(); } } while (0)
#define MF(C, i, d, CIN) C = __builtin_amdgcn_mfma_f32_32x32x16_bf16(kf[i], qr[d], CIN, 0, 0, 0)
#define STEP(C0, C1, P0, P1, t, GK, GV, GL) do { SBAR(); \
    const lds_cptr vp_ = vp0 + i_prev * SLOTB; const lds_cptr kn_ = kp0 + i_next * SLOTK96; \
    VRD(0); SBAR(); float sacc = (P0[0] + P0[1]); \
    GAPA(MF(C0, 0, 0, zero16), P0[2], P0[3], P0[4],     pw0[0] = PKW(P0, 0), pw0[1] = PKW(P0, 2), pw0); \
    VRD(4); SBAR(); GAPA(MF(C1, 1, 0, zero16), P0[5], P0[6], P0[7],     pw0[2] = PKW(P0, 4), pw0[3] = PKW(P0, 6), pw0); \
    VRD(1); SBAR(); GAPA(MF(C0, 2, 1, C0), P0[8], P0[9], P0[10],   pw1[0] = PKW(P0, 8), pw1[1] = PKW(P0, 10), pw1); \
    VRD(5); SBAR(); GAPA(MF(C1, 3, 1, C1), P0[11], P0[12], P0[13], pw1[2] = PKW(P0, 12), pw1[3] = PKW(P0, 14), pw1); \
    VRD(2); SBAR(); GAPA(MF(C0, 4, 2, C0), P0[14], P0[15], P1[0],  pw2[0] = PKW(P1, 0), pw2[1] = PKW(P1, 2), pw2); \
    VRD(6); SBAR(); GAPA(MF(C1, 5, 2, C1), P1[1], P1[2], P1[3],    pw2[2] = PKW(P1, 4), pw2[3] = PKW(P1, 6), pw2); \
    VRD(3); SBAR(); GAPA(MF(C0, 6, 3, C0), P1[4], P1[5], P1[6],    pw3[0] = PKW(P1, 8), pw3[1] = PKW(P1, 10), pw3); \
    VRD(7); SBAR(); GAPA(MF(C1, 7, 3, C1), P1[7], P1[8], P1[9],    pw3[2] = PKW(P1, 12), pw3[3] = PKW(P1, 14), pw3); \
    GAPN(MF(C0, 8, 4, C0), P1[10], P1[11], P1[12]); \
    GAPN(MF(C1, 9, 4, C1), P1[13], P1[14], P1[15]); \
    GAP0(MF(C0, 10, 5, C0)); \
    GAP0(MF(C1, 11, 5, C1)); \
    l_reg += sacc; \
    if (GK) { DMA_K((t) + 3, i_cur); } if (GV) { DMA_V((t) + 1, i_next); } \
    SBAR(); \
    GAPB(o[0] = __builtin_amdgcn_mfma_f32_32x32x16_bf16(PAF(0), VFR(0), o[0], 0, 0, 0), C0, 0); \
    KRD(GL, 0); GAPB(o[1] = __builtin_amdgcn_mfma_f32_32x32x16_bf16(PAF(0), VFR(4), o[1], 0, 0, 0), C0, 4); \
    KRD(GL, 1); GAPB(o[0] = __builtin_amdgcn_mfma_f32_32x32x16_bf16(PAF(1), VFR(1), o[0], 0, 0, 0), C0, 8); \
    KRD(GL, 2); GAPB(o[1] = __builtin_amdgcn_mfma_f32_32x32x16_bf16(PAF(1), VFR(5), o[1], 0, 0, 0), C0, 12); \
    KRD(GL, 3); GAPB(o[0] = __builtin_amdgcn_mfma_f32_32x32x16_bf16(PAF(2), VFR(2), o[0], 0, 0, 0), C1, 0); \
    KRD(GL, 4); GAPB(o[1] = __builtin_amdgcn_mfma_f32_32x32x16_bf16(PAF(2), VFR(6), o[1], 0, 0, 0), C1, 4); \
    KRD(GL, 5); GAPB(o[0] = __builtin_amdgcn_mfma_f32_32x32x16_bf16(PAF(3), VFR(3), o[0], 0, 0, 0), C1, 8); \
    GAPB(o[1] = __builtin_amdgcn_mfma_f32_32x32x16_bf16(PAF(3), VFR(7), o[1], 0, 0, 0), C1, 12); \
    } while (0)
    int t = 1;
#define ENDW(tt) do { if ((tt) + 3 < NT) { WAIT_BAR(3); } else if ((tt) + 2 < NT) { WAIT_BAR(1); } else { WAIT_BAR(0); } } while (0)
    for (; t + 5 < NT; t += 2) {
        STEP(pB0, pB1, pA0, pA1, t, true, true, true);     WAIT_BAR(3); ROT();
        STEP(pA0, pA1, pB0, pB1, t + 1, true, true, true); WAIT_BAR(3); ROT();
    }
    for (; t + 1 < NT; t += 2) {
        STEP(pB0, pB1, pA0, pA1, t, (t + 3 < NT), (t + 1 < NT), (t + 1 < NT));         ENDW(t);     ROT();
        STEP(pA0, pA1, pB0, pB1, t + 1, (t + 4 < NT), (t + 2 < NT), (t + 2 < NT));     ENDW(t + 1); ROT();
    }
    STEP(pB0, pB1, pA0, pA1, NT - 1, false, false, false);
    { float sacc = pB0[0] + pB0[1]; _Pragma("unroll") for (int r = 2; r < 16; ++r) sacc += pB0[r]; _Pragma("unroll") for (int r = 0; r < 16; ++r) sacc += pB1[r]; l_reg += sacc;
      pw0 = (u32x4){PKW(pB0, 0), PKW(pB0, 2), PKW(pB0, 4), PKW(pB0, 6)}; pw1 = (u32x4){PKW(pB0, 8), PKW(pB0, 10), PKW(pB0, 12), PKW(pB0, 14)}; pw2 = (u32x4){PKW(pB1, 0), PKW(pB1, 2), PKW(pB1, 4), PKW(pB1, 6)}; pw3 = (u32x4){PKW(pB1, 8), PKW(pB1, 10), PKW(pB1, 12), PKW(pB1, 14)};
      const int vb0 = (int)(lds0 + L96_V) + ((lane >> 4) & 1) * 32 + (lane & 3) * 8 + (4 * hi + ((lane & 15) >> 2)) * 64;
      SBAR(); pv(o, vb0 + i_cur * SLOTB, PAF(0), PAF(1), PAF(2), PAF(3)); }
    { auto rr = __builtin_amdgcn_permlane32_swap(__float_as_uint(l_reg), __float_as_uint(l_reg), false, false); l_reg = __uint_as_float(rr[0]) + __uint_as_float(rr[1]); }
    if (hi == 0) wsf[32 + r32] = l_reg; asm volatile("s_waitcnt lgkmcnt(0)" ::: "memory");
    float rli[16];
#pragma unroll
    for (int r = 0; r < 16; ++r) rli[r] = __builtin_amdgcn_rcpf(wsf[32 + crow(r, hi)]);
    { LAS bf16* stg = (LAS bf16*)(shm + L96_OST) + wid * 2048;
#pragma unroll
      for (int r = 0; r < 16; ++r) { const int orow = crow(r, hi);
#pragma unroll
          for (int d0 = 0; d0 < 2; ++d0) stg[orow * 64 + d0 * 32 + r32] = (bf16)f2bf(o[d0][r] * rli[r]); }
      asm volatile("s_waitcnt lgkmcnt(0)" ::: "memory");
#pragma unroll
      for (int i = 0; i < 4; ++i) { const int row = i * 8 + (lane >> 3), ch = lane & 7; const u32x4 v = *(const LAS u32x4*)(stg + row * 64 + ch * 8); *(u32x4*)(Ow + (long)row * 1024 + ch * 8) = v; } }
    asm volatile("s_waitcnt lgkmcnt(0)\n\ts_barrier" ::: "memory");
#undef DMA_K
#undef DMA_V
#undef ROT
#undef PKW
#undef PAF
#undef VFR
#undef PIN
#undef GAPA
#undef GAPN
#undef GAP0
#undef GAPB
#undef EX
#undef VRD
#undef KRD
#undef MF
#undef STEP
#undef ENDW
}
#undef SBAR
#undef WAIT_BAR
DI void attn_phase96(const Args& a, Frame& F, bool need_ctx, int l) {
    refresh(F);
    const bf16* QR = (const bf16*)(a.ws + RAW_Q); const bf16* KB = (const bf16*)(a.ws + WS_KB); const bf16* KV = (const bf16*)(a.ws + RAW_KV); bf16* O = (bf16*)(a.ws + WS_O);
    const float* qg = a.q_gain[l]; const float* R32 = (const float*)(a.ws + WS_ROPE) + 64 * 16 * 2;
    const int wid = F.wave;
    const int G = gridDim.x, bx = blockIdx.x; const int vcu = (G % 8 == 0) ? (bx % 8) * (G / 8) + bx / 8 : bx;
    const int nunits = 1024 + (need_ctx ? 64 : 0);
#pragma unroll 1
    for (int u = vcu; u < nunits; u += G) {
        int b, h, qrow0, nt, qt0 = 0; bool isctx = false;
        if (u < 1024) { const int bh = u >> 4, qb = u & 15; b = bh >> 4; h = bh & 15; qrow0 = b * SB + NCTX + 256 * qb; qt0 = 256 * qb + 32 * wid; nt = SB / 64; }
        else { const int j = u - 1024; b = j >> 4; h = j & 15; qrow0 = b * SB; nt = 4; isctx = true; }
        const bf16* Kh = KB + (size_t)b * SB * 1536 + h * 96; const bf16* Vh = KV + (size_t)b * SB * 2048 + h * 128 + 64;
        const bf16* Qw = QR + (size_t)(qrow0 + 32 * wid) * 1536 + h * 96; bf16* Ow = O + (size_t)(qrow0 + 32 * wid) * 1024 + h * 64;
        const int lane_u = lane_id();
        attn_unit96(Qw, Kh, Vh, Ow, nt, F.lds, lane_u, wid, qg, R32, !isctx, qt0);
    }
}
}

constexpr int LDS_BYTES = 147456;
constexpr int MISC_OFF = 131072 + 320;
enum { PJ_NORM1 = 0, PJ_QKV = 1, PJ_MLAMID = 2, PJ_MLAUP = 3, PJ_PREP = 4, PJ_ATTN = 5, PJ_WO = 6, PJ_NORM2 = 7, PJ_GATHER = 8, PJ_GU = 9, PJ_DOWN = 10, PJ_COMBINE = 11 };
__host__ __device__ constexpr int pid_of(int l, int j) { return 1 + 16 * l + j; }
__host__ __device__ inline bool phase_exists(int l, int j) {
    const int kind = l % 3; const bool moe = (l & 1) != 0;
    switch (j) {
        case PJ_NORM1: return l == 0 || l == 1 || l == 3;
        case PJ_MLAMID: case PJ_MLAUP: return kind == 2;
        case PJ_GATHER: case PJ_COMBINE: return moe;
        case PJ_QKV: case PJ_PREP: case PJ_ATTN: case PJ_WO: case PJ_NORM2: case PJ_GU: case PJ_DOWN: return true;
        default: return false;
    }
}

__global__ void __launch_bounds__(512, 2) fwd_kernel(Args a) {
    extern __shared__ __attribute__((aligned(16))) unsigned char lds_raw[];
    Frame F;
    F.lds = (LAS unsigned char*)lds_raw;
    F.tid = threadIdx.x; F.lane = F.tid & 63; F.wave = __builtin_amdgcn_readfirstlane(F.tid >> 6); F.wave0 = F.wave;
    F.gw = blockIdx.x * 8 + F.wave; F.NGW = gridDim.x * 8;
    F.ws = a.ws; F.MOD = (float*)(a.ws + WS_MOD); F.X = (bf16*)(a.ws + WS_X); F.H = (bf16*)(a.ws + WS_H);
    volatile LAS unsigned* MISC = (volatile LAS unsigned*)(F.lds + MISC_OFF);
    if (F.tid < 32) MISC[F.tid] = 0u;
    __syncthreads();
    const int lo = a.lo, hi = a.hi;
    const bool one_launch = (hi - lo) > 1;
    XcdBarrier bar; bar.bar = (unsigned*)(a.ws + WS_CTL) + CW_BAR; bar.x = 0; bar.st = nullptr;
    if (one_launch) bar = xcd_barrier_post((unsigned*)(a.ws + WS_CTL) + CW_BAR, MISC + 8);
#define IN(k) (lo <= (k) && (k) < hi)
    volatile LAS unsigned long long* TP = (volatile LAS unsigned long long*)(F.lds + MISC_OFF + 64);
    if (PROBE_TMASK && threadIdx.x == 0) { TP[0] = __builtin_amdgcn_s_memrealtime(); TP[1] = 0ull; }
#define SEAM(k) do { if (one_launch && IN(k) && (k) + 1 < hi) { xcd_barrier(bar); } \
        if (PROBE_TMASK && F.wave0 == 0 && lane_id() == 0) { const unsigned long long now_ = __builtin_amdgcn_s_memrealtime(); const int k_ = (k); const bool sel_ = k_ == 0 ? (((PROBE_TMASK) >> 12) & 1) : TSEL((k_ - 1) >> 4, (k_ - 1) & 15); if (sel_) TP[1] = TP[1] + (now_ - TP[0]); TP[0] = now_; } } while (0)

    if (IN(0)) p0_prologue(a, F); SEAM(0);

#pragma unroll 1
    for (int l = 0; l < 4; ++l) {
        const int kind = l % 3; const bool moe = (l & 1) != 0; const bool need_ctx = l < 3; const int moe_idx = l >> 1;
        const int P = 1 + 16 * l;
        if (l != 2) { if (IN(P + PJ_NORM1)) { norm_rows(a, F, l, 0, l == 0, false, 0, (l == 1 || l == 3) ? FF / 256 : 0, l - 1, 5); } SEAM(P + PJ_NORM1); }
        if (IN(P + PJ_QKV)) {
            const int N = kind == 0 ? 1536 : (kind == 1 ? 3072 : 768);
            const bf16* Wt = (const bf16*)(a.ws + (l == 0 ? W_QKV0 : l == 1 ? W_QKV1 : l == 2 ? W_IN : W_QKV3));
            pg8::Gemm g{F.H, Wt, M, N, D, 0, D}; pg8::StaticOrder S; S.init(M, N, (int)gridDim.x, (int)blockIdx.x);
            pg8::EpiQkvK E{(bf16*)(a.ws + WS_RAW), N, kind == 2 ? 0 : 4, kind == 0 ? 5 : (kind == 1 ? 8 : 0), (bf16*)(a.ws + WS_KB), kind == 0 ? 256 : 1024, a.k_gain[l], (const float*)(a.ws + WS_ROPE), kind == 0,
                           (LAS float*)(F.lds + 135168), kind == 2};
            pg8::gemm_phase<pg8::EpiQkvK, pg8::StaticOrder, true, true>(F.lds, g, S, E, F.wave0);
        } SEAM(P + PJ_QKV);
        if (kind == 2) {
            if (IN(P + PJ_MLAMID)) mla_mid(a, F); SEAM(P + PJ_MLAMID);
            if (IN(P + PJ_MLAUP)) {
                { pg8::Gemm g{(const bf16*)(a.ws + RAW_CQ), (const bf16*)(a.ws + W_UQ), M, 1536, QLORA, 0, QLORA}; pg8::StaticOrder S; S.init(M, 1536, (int)gridDim.x, (int)blockIdx.x); pg8::EpiRaw2 E{(bf16*)(a.ws + RAW_Q), 1536};
                  pg8::gemm_phase<pg8::EpiRaw2, pg8::StaticOrder, true, true>(F.lds, g, S, E, F.wave0); }
                { pg8::Gemm g{(const bf16*)(a.ws + RAW_CKV), (const bf16*)(a.ws + W_UKV), M, 2048, KVLORA, 0, KVLORA}; pg8::StaticOrder S; S.init(M, 2048, (int)gridDim.x, (int)((blockIdx.x + 104u) % gridDim.x)); pg8::EpiUkvK E{(bf16*)(a.ws + RAW_KV), 2048, (bf16*)(a.ws + WS_KB), a.k_gain[l], (LAS float*)(F.lds + 135168)};
                  pg8::gemm_phase<pg8::EpiUkvK, pg8::StaticOrder, true, true>(F.lds, g, S, E, F.wave0); }
            } SEAM(P + PJ_MLAUP);
        }
        { const bool full = !(((const float*)(a.ws + WS_BOUND))[l] <= 64.f);
          if (full) { if (IN(P + PJ_PREP)) prep_rows(a, F, l, kind, full); SEAM(P + PJ_PREP); } }
        if (IN(P + PJ_ATTN)) {
            const bool bounded = ((const float*)(a.ws + WS_BOUND))[l] <= 64.f;
            if (kind == 0) { if (bounded) fa2::attn_phase<0>(a, F, need_ctx, l); else fa::attn_fast<64, 0>(a, F, need_ctx); }
            else if (kind == 1) { if (bounded) fa2::attn_phase<1>(a, F, need_ctx, l); else fa::attn_fast<64, 1>(a, F, need_ctx); }
            else { if (bounded) fa2::attn_phase96(a, F, need_ctx, l); else fa::attn_fast<96, 2>(a, F, need_ctx); }
        } SEAM(P + PJ_ATTN);
        if (IN(P + PJ_WO)) {
            pg8::Gemm g{(const bf16*)(a.ws + WS_O), (const bf16*)(a.ws + W_O + (size_t)l * 2 * MiB), M, D, D, 0, D}; pg8::RowOrder S; S.init(true, D, (int)gridDim.x, (int)blockIdx.x); pg8::EpiResG E{F.X, F.MOD, l, 2};
            pg8::gemm_phase<pg8::EpiResG, pg8::RowOrder, true, true>(F.lds, g, S, E, F.wave0);
            if (need_ctx) { pg8::Gemm g2 = g; g2.Kloop = 256; pg8::CtxSplitOrder S2{4, 256, (int)gridDim.x, (int)blockIdx.x}; pg8::EpiSlab E2{(float*)(a.ws + WS_SLAB)};
                pg8::gemm_phase<pg8::EpiSlab, pg8::CtxSplitOrder, true, true>(F.lds, g2, S2, E2, F.wave0); }
        } SEAM(P + PJ_WO);
        if (IN(P + PJ_NORM2)) { if (moe) norm_route_rows(a, F, l, !need_ctx, moe_idx, need_ctx ? 4 : 0); else norm_rows(a, F, l, 1, false, !need_ctx, 0, need_ctx ? 4 : 0, l, 2); } SEAM(P + PJ_NORM2);
        if (!moe) {
            const int di = l >> 1;
            if (IN(P + PJ_GU)) {
                pg8::Gemm g{F.H, (const bf16*)(a.ws + W_GU + (size_t)di * 11 * MiB), M, 2 * FF, D, 0, D}; pg8::StaticOrder S; S.init(M, 2 * FF, (int)gridDim.x, (int)blockIdx.x); pg8::EpiSwiglu E{(bf16*)(a.ws + WS_ACT), FF};
                pg8::gemm_phase<pg8::EpiSwiglu, pg8::StaticOrder, true, true>(F.lds, g, S, E, F.wave0);
            } SEAM(P + PJ_GU);
            if (IN(P + PJ_DOWN)) {
                pg8::Gemm g{(const bf16*)(a.ws + WS_ACT), (const bf16*)(a.ws + W_DN + (size_t)di * 11 * MiB / 2), M, D, FF, 0, FF}; pg8::RowOrder S; S.init(true, D, (int)gridDim.x, (int)blockIdx.x); pg8::EpiResG E{F.X, F.MOD, l, 5};
                pg8::gemm_phase<pg8::EpiResG, pg8::RowOrder, true, true>(F.lds, g, S, E, F.wave0);
                { pg8::Gemm g2 = g; g2.Kloop = 256; pg8::CtxSplitOrder S2{FF / 256, 256, (int)gridDim.x, (int)blockIdx.x}; pg8::EpiSlab E2{(float*)(a.ws + WS_SLAB)};
                  pg8::gemm_phase<pg8::EpiSlab, pg8::CtxSplitOrder, true, true>(F.lds, g2, S2, E2, F.wave0); }
            } SEAM(P + PJ_DOWN);
        } else {
            if (IN(P + PJ_GATHER)) moe_gather(a, F, moe_idx, !need_ctx); SEAM(P + PJ_GATHER);
            if (IN(P + PJ_GU)) {
                const MoeOff mo = moe_offsets(a, moe_idx);
                pg8::Gemm g{(const bf16*)(a.ws + WS_HP), (const bf16*)(a.ws + WE_GU(0) + (size_t)moe_idx * 168 * MiB), mo.o[8], 2 * FFE, D, (size_t)2 * FFE * D * 2, D};
                pg8::MoeOrder S; S.s.init(mo.o[8], 2 * FFE, (int)gridDim.x, (int)blockIdx.x); S.o1 = mo.o[1]; S.o2 = mo.o[2]; S.o3 = mo.o[3]; S.o4 = mo.o[4]; S.o5 = mo.o[5]; S.o6 = mo.o[6]; S.o7 = mo.o[7];
                pg8::EpiSwiglu E{(bf16*)(a.ws + WS_ACT), FFE};
                pg8::gemm_phase<pg8::EpiSwiglu, pg8::MoeOrder, true, true>(F.lds, g, S, E, F.wave0);
            } SEAM(P + PJ_GU);
            if (IN(P + PJ_DOWN)) {
                const MoeOff mo = moe_offsets(a, moe_idx);
                pg8::Gemm g{(const bf16*)(a.ws + WS_ACT), (const bf16*)(a.ws + WE_DN(0) + (size_t)moe_idx * 168 * MiB), mo.o[8], D, FFE, (size_t)D * FFE * 2, FFE};
                const int nM = mo.o[8] >> 8, T0 = moe_split_t0(mo, (int)gridDim.x);
                pg8::MoeOrder S; S.s.init(T0 * 256, D, (int)gridDim.x, (int)blockIdx.x); S.o1 = mo.o[1]; S.o2 = mo.o[2]; S.o3 = mo.o[3]; S.o4 = mo.o[4]; S.o5 = mo.o[5]; S.o6 = mo.o[6]; S.o7 = mo.o[7];
                pg8::EpiRaw2 E{(bf16*)(a.ws + WS_HP), D};
                pg8::gemm_phase<pg8::EpiRaw2, pg8::MoeOrder, true, true>(F.lds, g, S, E, F.wave0);
                if (T0 < nM) { pg8::Gemm g2 = g; g2.Kloop = FFE / 4; pg8::RemSplitOrder S2{T0, nM - T0, FFE / 4, (int)gridDim.x, (int)blockIdx.x, mo.o[1], mo.o[2], mo.o[3], mo.o[4], mo.o[5], mo.o[6], mo.o[7]};
                    pg8::EpiSlab E2{(float*)(a.ws + WS_SLAB2)}; pg8::gemm_phase<pg8::EpiSlab, pg8::RemSplitOrder, true, true>(F.lds, g2, S2, E2, F.wave0); }
            } SEAM(P + PJ_DOWN);
            if (IN(P + PJ_COMBINE)) moe_combine(a, F, l, moe_idx); SEAM(P + PJ_COMBINE);
        }
    }
    if (PROBE_TMASK && blockIdx.x == 0 && F.wave0 == 0 && lane_id() == 0) { const unsigned long long t0 = __builtin_amdgcn_s_memrealtime(), tw = 4ull * TP[1]; while (__builtin_amdgcn_s_memrealtime() - t0 < tw) __builtin_amdgcn_s_sleep(8); }
#undef IN
#undef SEAM
}

extern "C" void kernel_launch(void* const* d_in, const int* in_sizes, int n_in, void* d_out, int out_size, void* d_ws, size_t ws_size, hipStream_t stream) {
    static int grid = 0;
    if (grid == 0) {
        if (n_in != 51 || ws_size < WS_END || out_size != NB * SEQ * D) { fprintf(stderr, "kernel_launch: unexpected problem (n_in %d, ws %zu, out %d)\n", n_in, ws_size, out_size); grid = -1; return; }
        int dev = 0, cus = 0;
        if (hipGetDevice(&dev) != hipSuccess || hipDeviceGetAttribute(&cus, hipDeviceAttributeMultiprocessorCount, dev) != hipSuccess) { grid = -1; return; }
        if (hipFuncSetAttribute((const void*)fwd_kernel, hipFuncAttributeMaxDynamicSharedMemorySize, LDS_BYTES) != hipSuccess) { fprintf(stderr, "kernel_launch: hipFuncSetAttribute failed\n"); grid = -1; return; }
        int per_cu = 0;
        if (hipOccupancyMaxActiveBlocksPerMultiprocessor(&per_cu, (const void*)fwd_kernel, 512, LDS_BYTES) != hipSuccess || per_cu < 1) { fprintf(stderr, "kernel_launch: occupancy query says %d\n", per_cu); }
        (void)hipGetLastError();
        grid = cus;
    }
    if (grid < 0) return;
    (void)hipMemsetAsync((char*)d_ws + WS_CTL, 0, CTL_BYTES, stream);
    Args a{};
    const float* const* in = (const float* const*)d_in;
    a.x = in[0]; a.c = in[1]; a.ctx = in[2]; a.cctx = in[3];
    const int base[4] = {4, 14, 26, 40};
    for (int l = 0; l < 4; ++l) { a.w_mod[l] = in[base[l]]; a.b_mod[l] = in[base[l] + 1]; a.g_mix[l] = in[base[l] + 2]; a.g_ffn[l] = in[base[l] + 3]; a.w_router[l] = nullptr; }
    a.q_gain[0] = in[9]; a.k_gain[0] = in[10]; a.q_gain[1] = in[19]; a.k_gain[1] = in[20]; a.q_gain[2] = in[35]; a.k_gain[2] = in[36]; a.q_gain[3] = in[45]; a.k_gain[3] = in[46];
    a.w_router[1] = in[23]; a.w_router[3] = in[48]; a.rel_bias = in[21]; a.g_dq = in[31]; a.g_dkv = in[32];
    a.out = (float*)d_out; a.ws = (unsigned char*)d_ws;
    int nj = 0, item0 = 0;
    auto job = [&](int idx, size_t off, int K, int N, int Nd, int nb, int mode) { Job& j = a.jobs[nj++]; j.src = in[idx]; j.dst_off = off; j.K = K; j.N = N; j.Nd = Nd; j.nb = nb; j.mode = mode; j.item0 = item0; item0 += (nb * K / 64) * (N / 32); };
    job(8, W_QKV0, 1024, 1536, 1536, 1, 0); job(18, W_QKV1, 1024, 3072, 3072, 1, 0); job(30, W_IN, 1024, 672, 768, 1, 0); job(33, W_UQ, 384, 1536, 1536, 1, 0); job(34, W_UKV, 256, 2048, 2048, 1, 0); job(44, W_QKV3, 1024, 1536, 1536, 1, 0);
    job(11, W_O, 1024, 1024, 1024, 1, 0); job(22, W_O + 2 * MiB, 1024, 1024, 1024, 1, 0); job(37, W_O + 4 * MiB, 1024, 1024, 1024, 1, 0); job(47, W_O + 6 * MiB, 1024, 1024, 1024, 1, 0);
    job(12, W_GU, 1024, 2 * FF, 2 * FF, 1, 1); job(38, W_GU + 11 * MiB, 1024, 2 * FF, 2 * FF, 1, 1); job(13, W_DN, FF, 1024, 1024, 1, 0); job(39, W_DN + 11 * MiB / 2, FF, 1024, 1024, 1, 0);
    job(24, WE_GU(0), 1024, 2 * FFE, 2 * FFE, 8, 1); job(25, WE_DN(0), FFE, 1024, 1024, 8, 0); job(49, WE_GU(1), 1024, 2 * FFE, 2 * FFE, 8, 1); job(50, WE_DN(1), FFE, 1024, 1024, 8, 0);
    a.n_items = item0; a.pad = 0;
#if N_LAUNCH_MODE == 1
    a.lo = 0; a.hi = pid_of(3, PJ_COMBINE) + 1;
    hipLaunchKernelGGL(fwd_kernel, dim3(grid), dim3(512), LDS_BYTES, stream, a);
#else
    a.lo = 0; a.hi = 1;
    hipLaunchKernelGGL(fwd_kernel, dim3(grid), dim3(512), LDS_BYTES, stream, a);
    for (int l = 0; l < 4; ++l) for (int j = 0; j < 12; ++j) if (phase_exists(l, j)) { a.lo = pid_of(l, j); a.hi = a.lo + 1; hipLaunchKernelGGL(fwd_kernel, dim3(grid), dim3(512), LDS_BYTES, stream, a); }
#endif
}
```

```cpp
#include <hip/hip_runtime.h>
#include <cstdio>
#include <cstdint>

#ifndef PROBE_TMASK
#define PROBE_TMASK 0
#endif
#define TSEL(l, j) ((((PROBE_TMASK) >> (j)) & 1) && (((PROBE_TMASK) >> (16 + (l))) & 1))
#ifndef N_LAUNCH_MODE
#define N_LAUNCH_MODE 1
#endif

constexpr int D = 1024, NB = 4, SEQ = 4096, NCTX = 256, SB = SEQ + NCTX  , M = NB * SB  ;
constexpr int NHEAD = 16, HD = 64;
constexpr int FF = 2816, FFE = 3584, NEXP = 8;
constexpr int QLORA = 384, KVLORA = 256, MLA_QK = 96;
constexpr int MAXSLOT = 36864;
constexpr float EPS = 1e-6f;
constexpr float LOG2E = 1.4426950408889634f;
constexpr float C2_64 = 0.125f * LOG2E;
constexpr float C2_96 = 0.10206207261596575f * LOG2E;

constexpr size_t MiB = 1u << 20;
constexpr size_t WS_CTL = 0, CTL_BYTES = 64 * 1024;
constexpr size_t WS_MOD = 1 * MiB;
constexpr size_t WS_ROPE = WS_MOD + 512 * 1024;
constexpr size_t WS_BOUND = WS_ROPE + 16 * 1024;
constexpr size_t WS_ROUTE = 2 * MiB;
constexpr size_t WS_BC = WS_ROUTE + 768 * 1024;
constexpr size_t WS_X = 3 * MiB;
constexpr size_t WS_H = 71 * MiB;
constexpr size_t WS_HP = 105 * MiB;
constexpr size_t WS_ATT = 177 * MiB;
constexpr size_t WS_RAW = WS_ATT;
constexpr size_t WS_QB = WS_ATT + 166 * MiB;
constexpr size_t WS_KB = WS_QB + 51 * MiB;
constexpr size_t WS_VB = WS_KB + 51 * MiB;
constexpr size_t WS_O = WS_VB + 34 * MiB;
constexpr size_t WS_ACT = WS_ATT;
constexpr size_t WS_SLAB2 = WS_ATT + 252 * MiB;
constexpr size_t WS_SLAB = WS_QB;
constexpr size_t WS_W = 513 * MiB;
constexpr size_t WS_WE = 571 * MiB;
constexpr size_t WS_END = WS_WE + 2 * 168 * MiB;
constexpr size_t RAW_IN = WS_RAW;
constexpr size_t RAW_CQ = RAW_IN + (size_t)M * 768 * 2;
constexpr size_t RAW_CKV = RAW_CQ + (size_t)M * 384 * 2;
constexpr size_t RAW_Q = RAW_CKV + (size_t)M * 256 * 2;
constexpr size_t RAW_KV = RAW_Q + (size_t)M * 1536 * 2;
static_assert(RAW_KV + (size_t)M * 2048 * 2 <= WS_QB, "raw region");
static_assert(WS_ACT + (size_t)MAXSLOT * FFE * 2 <= WS_W, "act overlay");
constexpr size_t W_QKV0 = WS_W, W_QKV1 = W_QKV0 + 3 * MiB, W_IN = W_QKV1 + 6 * MiB, W_UQ = W_IN + 3 * MiB / 2, W_UKV = W_UQ + 1179648, W_QKV3 = W_UKV + 1 * MiB;
constexpr size_t W_O = W_QKV3 + 3 * MiB;
constexpr size_t W_GU = W_O + 8 * MiB;
constexpr size_t W_DN = W_GU + 22 * MiB;
static_assert(W_DN + 11 * MiB <= WS_WE, "dense weights");
constexpr size_t WE_GU(int i) { return WS_WE + (size_t)i * 168 * MiB; }
constexpr size_t WE_DN(int i) { return WS_WE + (size_t)i * 168 * MiB + 112 * MiB; }
constexpr int CW_CNT = 64;
constexpr int CW_BAR = 4096;

#define LAS __attribute__((address_space(3)))
typedef unsigned short bf16;
typedef float f32x4 __attribute__((ext_vector_type(4)));
typedef float f32x16 __attribute__((ext_vector_type(16)));
typedef short bf16x8 __attribute__((ext_vector_type(8)));
typedef unsigned u32x4 __attribute__((ext_vector_type(4)));
typedef unsigned u32x2 __attribute__((ext_vector_type(2)));
#define DI __device__ __forceinline__
DI float bf2f(unsigned v) { return __uint_as_float(v << 16); }
DI unsigned f2bf(float f) { unsigned u = __float_as_uint(f); return (u + 0x7fffu + ((u >> 16) & 1u)) >> 16; }
DI unsigned pk2(float lo, float hi) { return f2bf(lo) | (f2bf(hi) << 16); }
template <int X> DI float swz_xor(float v) { static_assert(X >= 1 && X < 32, "swz_xor"); return __int_as_float(__builtin_amdgcn_ds_swizzle(__float_as_int(v), (X << 10) | 0x1F)); }
DI float wave_sum(float v) {
    v += swz_xor<1>(v); v += swz_xor<2>(v); v += swz_xor<4>(v); v += swz_xor<8>(v); v += swz_xor<16>(v);
    auto rr = __builtin_amdgcn_permlane32_swap(__float_as_uint(v), __float_as_uint(v), false, false);
    return __uint_as_float(rr[0]) + __uint_as_float(rr[1]);
}
DI float wave_max(float v) {
    v = fmaxf(v, swz_xor<1>(v)); v = fmaxf(v, swz_xor<2>(v)); v = fmaxf(v, swz_xor<4>(v)); v = fmaxf(v, swz_xor<8>(v)); v = fmaxf(v, swz_xor<16>(v));
    auto rr = __builtin_amdgcn_permlane32_swap(__float_as_uint(v), __float_as_uint(v), false, false);
    return fmaxf(__uint_as_float(rr[0]), __uint_as_float(rr[1]));
}
DI void unpack8(const u32x4 w, float* f) {
    f[0] = bf2f(w.x & 0xffffu); f[1] = bf2f(w.x >> 16); f[2] = bf2f(w.y & 0xffffu); f[3] = bf2f(w.y >> 16);
    f[4] = bf2f(w.z & 0xffffu); f[5] = bf2f(w.z >> 16); f[6] = bf2f(w.w & 0xffffu); f[7] = bf2f(w.w >> 16);
}
DI f32x4 ldx4(const bf16* p) { const u32x2 w = *(const u32x2*)p; return (f32x4){bf2f(w.x & 0xffffu), bf2f(w.x >> 16), bf2f(w.y & 0xffffu), bf2f(w.y >> 16)}; }
DI void stx4(bf16* p, const f32x4 v) { u32x2 w; w.x = pk2(v.x, v.y); w.y = pk2(v.z, v.w); *(u32x2*)p = w; }
DI u32x4 pack8(const float* f) { u32x4 w; w.x = pk2(f[0], f[1]); w.y = pk2(f[2], f[3]); w.z = pk2(f[4], f[5]); w.w = pk2(f[6], f[7]); return w; }

#define XB_TMO      128
#define XB_XCNT(j)  (256  + 64 * (j))
#define XB_XSUB(j)  (1280 + 64 * (j))
#define XB_XGEN(j)  (2304 + 64 * (j))
#define XB_TOP      3328
#define XB_TOPGEN   3392
#define XCD_BAR_WORDS 3456
#define XB_SPIN_CAP (1u << 18)
DI unsigned xb_ld(unsigned* p)              { return __hip_atomic_load(p, __ATOMIC_RELAXED, __HIP_MEMORY_SCOPE_AGENT); }
DI unsigned xb_add(unsigned* p, unsigned v) { return __hip_atomic_fetch_add(p, v, __ATOMIC_RELAXED, __HIP_MEMORY_SCOPE_AGENT); }
DI unsigned xb_xcc_id() { return (unsigned)__builtin_amdgcn_s_getreg((3 << 11) | 20) & 0xFu; }
#define XB_SPIN(cond, bar) do { unsigned _sp = 0; while (cond) { __builtin_amdgcn_s_sleep(1); \
    if ((++_sp & 255u) == 0u) { if (xb_ld(&(bar)[XB_TMO])) break; if (_sp > XB_SPIN_CAP) { atomicAdd(&(bar)[XB_TMO], 1u); break; } } } } while (0)
struct XcdBarrier { unsigned* bar; unsigned x; volatile LAS unsigned* st; };
DI XcdBarrier xcd_barrier_post(unsigned* bar, volatile LAS unsigned* st) {
    XcdBarrier b; b.bar = bar; b.x = xb_xcc_id(); b.st = st;
    if (threadIdx.x == 0) (void)xb_add(&bar[XB_XCNT(b.x)], 1u);
    return b;
}
DI void xcd_barrier_complete(unsigned* bar, unsigned x, unsigned& nloc, unsigned& nx) {
    const unsigned G = gridDim.x * gridDim.y * gridDim.z;
    unsigned sum, cnt, mine, sp = 0u;
    for (;;) {
        sum = 0u; cnt = 0u; mine = 0u;
#pragma unroll
        for (unsigned j = 0; j < 16; ++j) { const unsigned c = xb_ld(&bar[XB_XCNT(j)]); sum += c; cnt += (c > 0u) ? 1u : 0u; mine = (j == x) ? c : mine; }
        if (sum == G) break;
        __builtin_amdgcn_s_sleep(1);
        if ((++sp & 255u) == 0u) { if (xb_ld(&bar[XB_TMO])) break; if (sp > XB_SPIN_CAP) { atomicAdd(&bar[XB_TMO], 1u); break; } }
    }
    nloc = mine > 0u ? mine : 1u; nx = cnt > 0u ? cnt : 1u;
}
DI void xcd_barrier(const XcdBarrier& b) {
    asm volatile("s_waitcnt vmcnt(0)" ::: "memory");
    __syncthreads();
    if (threadIdx.x == 0) {
        unsigned* bar = b.bar;
        __builtin_amdgcn_s_waitcnt(0);
        unsigned nloc = b.st[0], nx = b.st[1];
        if (nloc == 0u) { xcd_barrier_complete(bar, b.x, nloc, nx); b.st[0] = nloc; b.st[1] = nx; }
        const unsigned old = xb_add(&bar[XB_XSUB(b.x)], 1u);
        const unsigned gen = old / nloc;
        if (old + 1u == (gen + 1u) * nloc) {
            __builtin_amdgcn_fence(__ATOMIC_RELEASE, "agent");
            asm volatile("s_waitcnt vmcnt(0)" ::: "memory");
            const unsigned og = xb_add(&bar[XB_TOP], 1u);
            const unsigned tg = og / nx;
            if (og + 1u == (tg + 1u) * nx) xb_add(&bar[XB_TOPGEN], 1u);
            else XB_SPIN(xb_ld(&bar[XB_TOPGEN]) == tg, bar);
            __builtin_amdgcn_fence(__ATOMIC_ACQUIRE, "agent");
            xb_add(&bar[XB_XGEN(b.x)], 1u);
            asm volatile("s_waitcnt vmcnt(0)" ::: "memory");
        } else {
            XB_SPIN(xb_ld(&bar[XB_XGEN(b.x)]) == gen, bar);
            __builtin_amdgcn_fence(__ATOMIC_ACQUIRE, "agent");
            asm volatile("s_waitcnt vmcnt(0)" ::: "memory");
        }
    }
    __syncthreads();
}

namespace pg8 {
#define PG8_LAS __attribute__((address_space(3)))
typedef unsigned short bf16_t;
typedef short bf16x8 __attribute__((ext_vector_type(8)));
typedef float f32x4 __attribute__((ext_vector_type(4)));
typedef unsigned u32x4 __attribute__((ext_vector_type(4)));
constexpr int BM = 256, BK = 64, HALF = 128, HTB = HALF * BK * 2  , STAGE_BYTES = 8 * HTB, NXCD = 8, WGM = 4;

__host__ __device__ __forceinline__ int lds_byte(int r, int c) { const int st = (r >> 4) * 2 + (c >> 5), rr = r & 15, cc = c & 31, ob = rr * 64 + cc * 2; return st * 1024 + (ob ^ (((ob >> 9) & 1) << 5)); }
__host__ __device__ __forceinline__ void stage_rc(int b, int& R, int& C) { const int st = b / 1024, sb = b % 1024, swz = sb ^ (((sb >> 9) & 1) << 5); R = (st >> 1) * 16 + swz / 64; C = (st & 1) * 32 + (swz % 64) / 2; }
__host__ __device__ __forceinline__ int perm32(int rho) { const int n = rho >> 4, i = rho & 15; return 8 * (i >> 2) + 4 * n + (i & 3); }

struct Unit { int pm, pn, e, koff, aux; };
struct Gemm { const bf16_t* A; const bf16_t* Bt; int M, N, K; size_t estride; int Kloop; };
struct StaticOrder {
    int nM, nN, nwg, G, c;
    __host__ __device__ void init(int M, int N, int G_, int c_) { nM = M / BM; nN = N / BM; nwg = nM * nN; G = G_; c = c_; }
    __host__ __device__ bool next(int i, Unit& u) const {
        const long L = (long)i * G + c; if (L >= nwg) return false;
        int wgid = (int)L; { const int q = nwg / NXCD, r = nwg % NXCD, xcd = wgid % NXCD, off = wgid / NXCD; wgid = (xcd < r ? xcd * (q + 1) : r * (q + 1) + (xcd - r) * q) + off; }
        const int nig = WGM * nN, gid = wgid / nig, fm = gid * WGM, gsz = (nM - fm) < WGM ? (nM - fm) : WGM;
        u.pm = fm + ((wgid % nig) % gsz); u.pn = (wgid % nig) / gsz; u.e = 0; u.koff = 0; u.aux = 0; return true;
    }
    __device__ __forceinline__ void a_ready(const Unit&) const {}
    __device__ __forceinline__ void done(const Unit&) const {}
};

__device__ __forceinline__ unsigned cvt_pk_bf16(float lo, float hi) { unsigned r; asm volatile("v_cvt_pk_bf16_f32 %0, %1, %2" : "=v"(r) : "v"(lo), "v"(hi)); return r; }
struct EpiRaw2 {
    static constexpr bool PERM = true, AFTER_DRAIN = false;
    bf16_t* O; int ldc;
    __device__ __forceinline__ void operator()(const f32x4 (&acc)[2][2][4][2], const Unit& u, int wr, int wc, int fr, int fq) const {
        const int row0 = u.pm * BM + wr * 64 + fr, col0 = u.pn * BM + wc * 32 + 8 * fq;
#pragma unroll
        for (int ai = 0; ai < 2; ++ai)
#pragma unroll
            for (int m = 0; m < 4; ++m) { bf16_t* rowp = O + (size_t)(row0 + ai * HALF + m * 16) * ldc + col0;
#pragma unroll
                for (int bj = 0; bj < 2; ++bj) { const f32x4 v0 = acc[ai][bj][m][0], v1 = acc[ai][bj][m][1];
                    u32x4 w; w.x = cvt_pk_bf16(v0[0], v0[1]); w.y = cvt_pk_bf16(v0[2], v0[3]); w.z = cvt_pk_bf16(v1[0], v1[1]); w.w = cvt_pk_bf16(v1[2], v1[3]);
                    *(u32x4*)(rowp + bj * HALF) = w; } }
    }
};
struct EpiQkvK {
    static constexpr bool PERM = true, AFTER_DRAIN = false;
    bf16_t* O; int ldc; int kt_lo, kt_hi; bf16_t* KB; int kbp; const float* kg; const float* R64; bool rope; PG8_LAS float* scr; bool krope;
    __device__ __forceinline__ void operator()(const f32x4 (&acc)[2][2][4][2], const Unit& u, int wr, int wc, int fr_, int fq_) const {
        int fr = fr_, fq = fq_; asm volatile("" : "+v"(fr), "+v"(fq));
        const int row0 = u.pm * BM + wr * 64 + fr, col0 = u.pn * BM + wc * 32 + 8 * fq;
#pragma unroll
        for (int ai = 0; ai < 2; ++ai)
#pragma unroll
            for (int m = 0; m < 4; ++m) { bf16_t* rowp = O + (size_t)(row0 + ai * HALF + m * 16) * ldc + col0;
#pragma unroll
                for (int bj = 0; bj < 2; ++bj) { const f32x4 v0 = acc[ai][bj][m][0], v1 = acc[ai][bj][m][1];
                    u32x4 w; w.x = cvt_pk_bf16(v0[0], v0[1]); w.y = cvt_pk_bf16(v0[2], v0[3]); w.z = cvt_pk_bf16(v1[0], v1[1]); w.w = cvt_pk_bf16(v1[2], v1[3]);
                    *(u32x4*)(rowp + bj * HALF) = w; } }
        if (krope && u.pn == 2 && wc == 0) {
            const float* R32 = R64 + 64 * 16 * 2; const int c8 = 8 * fq;
            const f32x4 g0 = *(const f32x4*)(kg + 64 + c8), g1 = *(const f32x4*)(kg + 64 + c8 + 4);
            const int bt = u.pm / 17, jt = u.pm - bt * 17; const bool lat = (jt != 0);
#pragma unroll
            for (int ai = 0; ai < 2; ++ai)
#pragma unroll
                for (int m = 0; m < 4; ++m) { const int rl = ai * HALF + wr * 64 + m * 16 + fr;
                    f32x4 a = acc[ai][1][m][0], b = acc[ai][1][m][1];
                    float ss = (a[0] * a[0] + a[1] * a[1]) + (a[2] * a[2] + a[3] * a[3]) + (b[0] * b[0] + b[1] * b[1]) + (b[2] * b[2] + b[3] * b[3]);
                    ss += __int_as_float(__builtin_amdgcn_ds_swizzle(__float_as_int(ss), (16 << 10) | 0x1F));
                    { auto rr = __builtin_amdgcn_permlane32_swap(__float_as_uint(ss), __float_as_uint(ss), false, false); ss = __uint_as_float(rr[0]) + __uint_as_float(rr[1]); }
                    const float rs = 1.0f / sqrtf(ss * (1.f / 32.f) + 1e-6f);
                    a = a * rs * g0; b = b * rs * g1;
                    if (lat) { const int t = (jt - 1) * 256 + rl; const int pos = (fq >> 1) ? (t & 63) : (t >> 6);
                        const float* cs = R32 + (size_t)pos * 16; const f32x4 q0 = *(const f32x4*)cs, q1 = *(const f32x4*)(cs + 4), q2 = *(const f32x4*)(cs + 8), q3 = *(const f32x4*)(cs + 12);
                        const f32x4 c0 = {q0[0], q0[2], q1[0], q1[2]}, s0 = {q0[1], q0[3], q1[1], q1[3]}, c1 = {q2[0], q2[2], q3[0], q3[2]}, s1 = {q2[1], q2[3], q3[1], q3[3]};
                        f32x4 oa, ob;
#pragma unroll
                        for (int i = 0; i < 4; ++i) { oa[i] = __int_as_float(__builtin_amdgcn_ds_swizzle(__float_as_int(a[i]), (16 << 10) | 0x1F)); ob[i] = __int_as_float(__builtin_amdgcn_ds_swizzle(__float_as_int(b[i]), (16 << 10) | 0x1F)); }
                        if (fq & 1) { a = oa * s0 + a * c0; b = ob * s1 + b * c1; } else { a = a * c0 - oa * s0; b = b * c1 - ob * s1; } }
                    u32x4 w; w.x = cvt_pk_bf16(a[0], a[1]); w.y = cvt_pk_bf16(a[2], a[3]); w.z = cvt_pk_bf16(b[0], b[1]); w.w = cvt_pk_bf16(b[2], b[3]);
                    bf16_t* kr = KB + (size_t)(u.pm * BM + rl) * 1536 + 64 + c8;
#pragma unroll
                    for (int h = 0; h < 16; ++h) *(u32x4*)(kr + h * 96) = w; }
        }
        if (u.pn < kt_lo || u.pn >= kt_hi) return;
        const int wid = wr * 4 + wc, hi = fq >> 1;
        int frl = fr; asm volatile("" : "+v"(frl));
        PG8_LAS float* sown = scr + (wid * 2) * 8 * 16 + frl; PG8_LAS float* soth = scr + ((wid ^ 1) * 2) * 8 * 16 + frl;
#pragma unroll
        for (int ai = 0; ai < 2; ++ai)
#pragma unroll
            for (int m = 0; m < 4; ++m)
#pragma unroll
                for (int bj = 0; bj < 2; ++bj) { const f32x4 a = acc[ai][bj][m][0], b = acc[ai][bj][m][1];
                    float ss = (a[0] * a[0] + a[1] * a[1]) + (a[2] * a[2] + a[3] * a[3]) + (b[0] * b[0] + b[1] * b[1]) + (b[2] * b[2] + b[3] * b[3]);
                    ss += __int_as_float(__builtin_amdgcn_ds_swizzle(__float_as_int(ss), (16 << 10) | 0x1F));
                    { auto rr = __builtin_amdgcn_permlane32_swap(__float_as_uint(ss), __float_as_uint(ss), false, false); ss = __uint_as_float(rr[0]) + __uint_as_float(rr[1]); }
                    if (fq == 0) sown[(bj * 8 + ai * 4 + m) * 16] = ss; }
        asm volatile("s_waitcnt lgkmcnt(0)" ::: "memory"); __builtin_amdgcn_s_barrier(); asm volatile("" ::: "memory");
        const int cw = (wc & 1) * 32 + 8 * fq;
        f32x4 g0 = *(const f32x4*)(kg + cw), g1 = *(const f32x4*)(kg + cw + 4);
        const int bt = u.pm / 17, jt = u.pm - bt * 17; const bool lat = rope && (jt != 0);
#pragma unroll
        for (int ai = 0; ai < 2; ++ai)
#pragma unroll
            for (int m = 0; m < 4; ++m) {
                const int rl = ai * HALF + wr * 64 + m * 16 + fr;
                const int t = (jt - 1) * 256 + rl; const int pos = (wc & 1) ? (t & 63) : (t >> 6);
                f32x4 c0 = {1.f, 1.f, 1.f, 1.f}, c1 = c0, s0 = {0.f, 0.f, 0.f, 0.f}, s1 = s0;
                if (lat) { const float* cs = R64 + ((size_t)pos * 16 + ((8 * fq) & 15)) * 2; const f32x4 q0 = *(const f32x4*)cs, q1 = *(const f32x4*)(cs + 4), q2 = *(const f32x4*)(cs + 8), q3 = *(const f32x4*)(cs + 12);
                    c0 = (f32x4){q0[0], q0[2], q1[0], q1[2]}; s0 = (f32x4){q0[1], q0[3], q1[1], q1[3]}; c1 = (f32x4){q2[0], q2[2], q3[0], q3[2]}; s1 = (f32x4){q2[1], q2[3], q3[1], q3[3]}; }
#pragma unroll
                for (int bj = 0; bj < 2; ++bj) {
                    const float tot = sown[(bj * 8 + ai * 4 + m) * 16] + soth[(bj * 8 + ai * 4 + m) * 16];
                    const float rs = 1.0f / sqrtf(tot * (1.f / 64.f) + 1e-6f);
                    f32x4 a = acc[ai][bj][m][0] * rs * g0, b = acc[ai][bj][m][1] * rs * g1;
                    if (lat) { f32x4 oa, ob;
#pragma unroll
                        for (int i = 0; i < 4; ++i) { { auto rr = __builtin_amdgcn_permlane32_swap(__float_as_uint(a[i]), __float_as_uint(a[i]), false, false); oa[i] = __uint_as_float(hi ? rr[0] : rr[1]); }
                                                      { auto rr = __builtin_amdgcn_permlane32_swap(__float_as_uint(b[i]), __float_as_uint(b[i]), false, false); ob[i] = __uint_as_float(hi ? rr[0] : rr[1]); } }
                        a = hi ? (oa * s0 + a * c0) : (a * c0 - oa * s0); b = hi ? (ob * s1 + b * c1) : (b * c1 - ob * s1); }
                    u32x4 w; w.x = cvt_pk_bf16(a[0], a[1]); w.y = cvt_pk_bf16(a[2], a[3]); w.z = cvt_pk_bf16(b[0], b[1]); w.w = cvt_pk_bf16(b[2], b[3]);
                    const int head = (u.pn - kt_lo) * 4 + bj * 2 + (wc >> 1);
                    *(u32x4*)(KB + (size_t)(u.pm * BM + rl) * kbp + head * 64 + cw) = w; }
            }
        asm volatile("s_waitcnt lgkmcnt(0)" ::: "memory"); __builtin_amdgcn_s_barrier(); asm volatile("" ::: "memory");
    }
};
struct EpiUkvK {
    static constexpr bool PERM = true, AFTER_DRAIN = false;
    bf16_t* O; int ldc; bf16_t* KB; const float* kg; PG8_LAS float* scr;
    __device__ __forceinline__ void operator()(const f32x4 (&acc)[2][2][4][2], const Unit& u, int wr, int wc, int fr_, int fq_) const {
        int fr = fr_, fq = fq_; asm volatile("" : "+v"(fr), "+v"(fq));
        const int row0 = u.pm * BM + wr * 64 + fr, col0 = u.pn * BM + wc * 32 + 8 * fq;
#pragma unroll
        for (int ai = 0; ai < 2; ++ai)
#pragma unroll
            for (int m = 0; m < 4; ++m) { bf16_t* rowp = O + (size_t)(row0 + ai * HALF + m * 16) * ldc + col0;
#pragma unroll
                for (int bj = 0; bj < 2; ++bj) { const f32x4 v0 = acc[ai][bj][m][0], v1 = acc[ai][bj][m][1];
                    u32x4 w; w.x = cvt_pk_bf16(v0[0], v0[1]); w.y = cvt_pk_bf16(v0[2], v0[3]); w.z = cvt_pk_bf16(v1[0], v1[1]); w.w = cvt_pk_bf16(v1[2], v1[3]);
                    *(u32x4*)(rowp + bj * HALF) = w; } }
        const int wid = wr * 4 + wc; const bool kw = wc < 2;
        int frl = fr; asm volatile("" : "+v"(frl));
        PG8_LAS float* sown = scr + (wid * 2) * 8 * 16 + frl; PG8_LAS float* soth = scr + ((wid ^ 1) * 2) * 8 * 16 + frl;
        if (kw) {
#pragma unroll
            for (int ai = 0; ai < 2; ++ai)
#pragma unroll
                for (int m = 0; m < 4; ++m)
#pragma unroll
                    for (int bj = 0; bj < 2; ++bj) { const f32x4 a = acc[ai][bj][m][0], b = acc[ai][bj][m][1];
                        float ss = (a[0] * a[0] + a[1] * a[1]) + (a[2] * a[2] + a[3] * a[3]) + (b[0] * b[0] + b[1] * b[1]) + (b[2] * b[2] + b[3] * b[3]);
                        ss += __int_as_float(__builtin_amdgcn_ds_swizzle(__float_as_int(ss), (16 << 10) | 0x1F));
                        { auto rr = __builtin_amdgcn_permlane32_swap(__float_as_uint(ss), __float_as_uint(ss), false, false); ss = __uint_as_float(rr[0]) + __uint_as_float(rr[1]); }
                        if (fq == 0) sown[(bj * 8 + ai * 4 + m) * 16] = ss; }
        }
        asm volatile("s_waitcnt lgkmcnt(0)" ::: "memory"); __builtin_amdgcn_s_barrier(); asm volatile("" ::: "memory");
        if (kw) {
            const int cw = wc * 32 + 8 * fq;
            const f32x4 g0 = *(const f32x4*)(kg + cw), g1 = *(const f32x4*)(kg + cw + 4);
#pragma unroll
            for (int ai = 0; ai < 2; ++ai)
#pragma unroll
                for (int m = 0; m < 4; ++m) { const int rl = ai * HALF + wr * 64 + m * 16 + fr;
#pragma unroll
                    for (int bj = 0; bj < 2; ++bj) {
                        const float tot = sown[(bj * 8 + ai * 4 + m) * 16] + soth[(bj * 8 + ai * 4 + m) * 16];
                        const float rs = 1.0f / sqrtf(tot * (1.f / 64.f) + 1e-6f);
                        const f32x4 a = acc[ai][bj][m][0] * rs * g0, b = acc[ai][bj][m][1] * rs * g1;
                        u32x4 w; w.x = cvt_pk_bf16(a[0], a[1]); w.y = cvt_pk_bf16(a[2], a[3]); w.z = cvt_pk_bf16(b[0], b[1]); w.w = cvt_pk_bf16(b[2], b[3]);
                        *(u32x4*)(KB + (size_t)(u.pm * BM + rl) * 1536 + (2 * u.pn + bj) * 96 + cw) = w; } }
        }
        asm volatile("s_waitcnt lgkmcnt(0)" ::: "memory"); __builtin_amdgcn_s_barrier(); asm volatile("" ::: "memory");
    }
};
struct EpiResG {
    static constexpr bool PERM = true, AFTER_DRAIN = false;
    bf16_t* X; const float* MOD; int l, gsel;
    __device__ __forceinline__ void operator()(const f32x4 (&acc)[2][2][4][2], const Unit& u, int wr, int wc, int fr, int fq) const {
        const int b = u.pm / 17, s = (u.pm - b * 17 == 0) ? 4 : b;
        const float* gate = MOD + ((size_t)l * 5 + s) * 6144 + gsel * 1024;
        const int col0 = u.pn * BM + wc * 32 + 8 * fq;
        f32x4 gv[2][2];
#pragma unroll
        for (int bj = 0; bj < 2; ++bj)
#pragma unroll
            for (int n = 0; n < 2; ++n) gv[bj][n] = *(const f32x4*)(gate + col0 + bj * HALF + n * 4);
#pragma unroll
        for (int ai = 0; ai < 2; ++ai)
#pragma unroll
            for (int m = 0; m < 4; ++m) { bf16_t* rowp = X + (size_t)(u.pm * BM + ai * HALF + wr * 64 + m * 16 + fr) * 1024 + col0;
                u32x4 xw[2];
#pragma unroll
                for (int bj = 0; bj < 2; ++bj) xw[bj] = *(const u32x4*)(rowp + bj * HALF);
#pragma unroll
                for (int bj = 0; bj < 2; ++bj) { const f32x4 a0 = acc[ai][bj][m][0], a1 = acc[ai][bj][m][1], g0 = gv[bj][0], g1 = gv[bj][1]; const u32x4 x = xw[bj]; u32x4 w;
                    w.x = cvt_pk_bf16(__uint_as_float(x.x << 16) + g0[0] * a0[0], __uint_as_float(x.x & 0xffff0000u) + g0[1] * a0[1]);
                    w.y = cvt_pk_bf16(__uint_as_float(x.y << 16) + g0[2] * a0[2], __uint_as_float(x.y & 0xffff0000u) + g0[3] * a0[3]);
                    w.z = cvt_pk_bf16(__uint_as_float(x.z << 16) + g1[0] * a1[0], __uint_as_float(x.z & 0xffff0000u) + g1[1] * a1[1]);
                    w.w = cvt_pk_bf16(__uint_as_float(x.w << 16) + g1[2] * a1[2], __uint_as_float(x.w & 0xffff0000u) + g1[3] * a1[3]);
                    *(u32x4*)(rowp + bj * HALF) = w; }
                asm volatile("" ::: "memory"); }
    }
};
__device__ __forceinline__ float swiglu1(float g, float u) { return g * __builtin_amdgcn_rcpf(1.f + __expf(-g)) * u; }
struct EpiSwiglu {
    static constexpr bool PERM = true, AFTER_DRAIN = false;
    bf16_t* ACT; int Fh;
    __device__ __forceinline__ void operator()(const f32x4 (&acc)[2][2][4][2], const Unit& u, int wr, int wc, int fr, int fq) const {
        const int row0 = u.pm * BM + wr * 64 + fr, f0 = u.pn * HALF + wc * 32 + 8 * fq;
#pragma unroll
        for (int ai = 0; ai < 2; ++ai)
#pragma unroll
            for (int m = 0; m < 4; ++m) { const f32x4 g0 = acc[ai][0][m][0], g1 = acc[ai][0][m][1], u0 = acc[ai][1][m][0], u1 = acc[ai][1][m][1];
                u32x4 w; w.x = cvt_pk_bf16(swiglu1(g0[0], u0[0]), swiglu1(g0[1], u0[1])); w.y = cvt_pk_bf16(swiglu1(g0[2], u0[2]), swiglu1(g0[3], u0[3]));
                w.z = cvt_pk_bf16(swiglu1(g1[0], u1[0]), swiglu1(g1[1], u1[1])); w.w = cvt_pk_bf16(swiglu1(g1[2], u1[2]), swiglu1(g1[3], u1[3]));
                *(u32x4*)(ACT + (size_t)(row0 + ai * HALF + m * 16) * Fh + f0) = w; }
    }
};
struct EpiSlab {
    static constexpr bool PERM = false, AFTER_DRAIN = false;
    float* slab;
    __device__ __forceinline__ void operator()(const f32x4 (&acc)[2][2][4][2], const Unit& u, int wr, int wc, int fr, int fq) const {
        const int col0 = u.pn * BM + wc * 32 + 4 * fq;
#pragma unroll
        for (int ai = 0; ai < 2; ++ai)
#pragma unroll
            for (int m = 0; m < 4; ++m) { float* rowp = slab + (size_t)(u.aux + ai * HALF + wr * 64 + m * 16 + fr) * 1024 + col0;
#pragma unroll
                for (int bj = 0; bj < 2; ++bj)
#pragma unroll
                    for (int n = 0; n < 2; ++n) *(f32x4*)(rowp + bj * HALF + n * 16) = acc[ai][bj][m][n]; }
    }
};
struct CtxSplitOrder {
    int S, Kc, G, c;
    __device__ __forceinline__ bool next(int i, Unit& u) const { const int L = i * G + c; if (L >= 16 * S) return false; const int ks = L % S, t = L / S, ct = t >> 2;
        u.pm = 17 * ct; u.pn = t & 3; u.e = 0; u.koff = ks * Kc; u.aux = ks * 1024 + 256 * ct; return true; }
    __device__ __forceinline__ void a_ready(const Unit&) const {}
    __device__ __forceinline__ void done(const Unit&) const {}
};
struct LatOrder {
    StaticOrder s;
    __device__ void init(int N, int G, int c) { s.init(16384, N, G, c); }
    __device__ __forceinline__ bool next(int i, Unit& u) const { if (!s.next(i, u)) return false; u.pm = u.pm + u.pm / 16 + 1; return true; }
    __device__ __forceinline__ void a_ready(const Unit&) const {}
    __device__ __forceinline__ void done(const Unit&) const {}
};
struct RemSplitOrder {
    int T0, nrem, Kc, G, c, o1, o2, o3, o4, o5, o6, o7;
    __device__ __forceinline__ bool next(int i, Unit& u) const { const int L = i * G + c; if (L >= nrem * 16) return false; const int ks = L & 3, t = L >> 2;
        u.pm = T0 + (t >> 2); u.pn = t & 3; const int sl = u.pm * BM; u.e = (sl >= o1) + (sl >= o2) + (sl >= o3) + (sl >= o4) + (sl >= o5) + (sl >= o6) + (sl >= o7);
        u.koff = ks * Kc; u.aux = (ks * nrem + (u.pm - T0)) * BM; return true; }
    __device__ __forceinline__ void a_ready(const Unit&) const {}
    __device__ __forceinline__ void done(const Unit&) const {}
};
struct RowOrder {
    StaticOrder s; bool lat;
    __device__ void init(bool lat_, int N, int G, int c) { lat = lat_; s.init(lat_ ? 16384 : 17408, N, G, c); }
    __device__ __forceinline__ bool next(int i, Unit& u) const { if (!s.next(i, u)) return false; if (lat) u.pm = u.pm + u.pm / 16 + 1; return true; }
    __device__ __forceinline__ void a_ready(const Unit&) const {}
    __device__ __forceinline__ void done(const Unit&) const {}
};
struct MoeOrder {
    StaticOrder s; int o1, o2, o3, o4, o5, o6, o7;
    __device__ __forceinline__ bool next(int i, Unit& u) const { if (!s.next(i, u)) return false; const int sl = u.pm * BM;
        u.e = (sl >= o1) + (sl >= o2) + (sl >= o3) + (sl >= o4) + (sl >= o5) + (sl >= o6) + (sl >= o7); return true; }
    __device__ __forceinline__ void a_ready(const Unit&) const {}
    __device__ __forceinline__ void done(const Unit&) const {}
};
template <class Epi, class Sched, bool ALIGN_EPI = false, bool SP2 = false>
__device__ __forceinline__ void gemm_phase(PG8_LAS unsigned char* lds, const Gemm g, const Sched& S, const Epi& E, const int wave_id) {
    int wid_ = wave_id; asm volatile("" : "+s"(wid_)); int lane_; asm volatile("v_mbcnt_lo_u32_b32 %0, -1, 0\n\tv_mbcnt_hi_u32_b32 %0, -1, %0" : "=v"(lane_));
    const int wid = wid_, lane = lane_, tid = wid * 64 + lane, wr = wid >> 2, wc = wid & 3, fr = lane & 15, fq = lane >> 4;
    const int K = g.K, nt = g.Kloop / BK;
    unsigned voffA[2], voffB[2];
#pragma unroll
    for (int i = 0; i < 2; ++i) { int R, C; stage_rc(tid * 16 + i * 8192, R, C); const int Rb = Epi::PERM ? ((R & ~31) + perm32(R & 31)) : R;
        voffA[i] = (unsigned)(R * K + C) * 2u; voffB[i] = (unsigned)(Rb * K + C) * 2u; }
    const size_t kstep = (size_t)(BK * 2);
    const size_t hstep = (size_t)HALF * K * 2;
    const size_t tstep = 2 * hstep;
    const unsigned ldsw = (unsigned)wid * 1024u;
    const int aoff = lds_byte(wr * 64 + fr, fq * 8), boff = lds_byte(wc * 32 + fr, fq * 8);
#define PG8_SA(b, h) (((b) * 2 + (h)) * HTB)
#define PG8_SB(b, h) ((4 + (b) * 2 + (h)) * HTB)
#define PG8_STAGE(bufoff, gbase, voff) do { _Pragma("unroll") for (int _i = 0; _i < 2; ++_i) \
        __builtin_amdgcn_global_load_lds((const unsigned*)((const char*)(gbase) + (voff)[_i]), (PG8_LAS unsigned*)(lds + (bufoff) + ldsw + _i * 8192), 16, 0, 0); } while (0)
#define PG8_LDA(dst, b, h) do { _Pragma("unroll") for (int m = 0; m < 4; ++m) _Pragma("unroll") for (int k = 0; k < 2; ++k) dst[m][k] = *(const PG8_LAS bf16x8*)(lds + PG8_SA(b, h) + aoff + m * 2048 + k * 1024); } while (0)
#define PG8_LDB(dst, b, h) do { _Pragma("unroll") for (int n = 0; n < 2; ++n) _Pragma("unroll") for (int k = 0; k < 2; ++k) dst[n][k] = *(const PG8_LAS bf16x8*)(lds + PG8_SB(b, h) + boff + n * 2048 + k * 1024); } while (0)
#define PG8_MMA(ai, bj, At, Bt) do { __builtin_amdgcn_s_setprio(1); _Pragma("unroll") for (int m = 0; m < 4; ++m) _Pragma("unroll") for (int n = 0; n < 2; ++n) _Pragma("unroll") for (int k = 0; k < 2; ++k) \
        acc[ai][bj][m][n] = __builtin_amdgcn_mfma_f32_16x16x32_bf16(Bt[n][k], At[m][k], acc[ai][bj][m][n], 0, 0, 0); __builtin_amdgcn_s_setprio(0); } while (0)
#define PG8_WAIT_V(n) asm volatile("s_waitcnt vmcnt(" #n ")" ::: "memory")
#define PG8_WAIT_L(n) asm volatile("s_waitcnt lgkmcnt(" #n ")" ::: "memory")
#define PG8_BAR __builtin_amdgcn_s_barrier()
#define PG8_SCHED __builtin_amdgcn_sched_barrier(0)
    Unit cur, nxt; int ui = 0;
    if (!S.next(0, cur)) return;
    f32x4 acc[2][2][4][2];
#pragma unroll
    for (int a = 0; a < 2; ++a)
#pragma unroll
        for (int b = 0; b < 2; ++b)
#pragma unroll
            for (int m = 0; m < 4; ++m)
#pragma unroll
                for (int n = 0; n < 2; ++n) acc[a][b][m][n] = (f32x4){0.f, 0.f, 0.f, 0.f};
    bf16x8 At[4][2], B0[2][2], B1[2][2];
    const char* cA = (const char*)g.A + (size_t)cur.pm * tstep + (size_t)cur.koff * 2; const char* cB = (const char*)g.Bt + (size_t)cur.e * g.estride + (size_t)cur.pn * tstep + (size_t)cur.koff * 2;
    S.a_ready(cur);
    if constexpr (SP2) {
        PG8_STAGE(PG8_SB(0, 0), cB, voffB); PG8_STAGE(PG8_SB(0, 1), cB + hstep, voffB); PG8_STAGE(PG8_SA(0, 0), cA, voffA); PG8_STAGE(PG8_SA(0, 1), cA + hstep, voffA);
        if (wr == 1) PG8_BAR;
        PG8_WAIT_V(2); PG8_BAR;
        PG8_STAGE(PG8_SB(1, 0), cB + kstep, voffB); PG8_STAGE(PG8_SA(1, 0), cA + kstep, voffA); PG8_STAGE(PG8_SB(1, 1), cB + hstep + kstep, voffB);
        PG8_WAIT_V(6); PG8_BAR;
    } else {
        PG8_STAGE(PG8_SB(0, 0), cB, voffB); PG8_STAGE(PG8_SA(0, 0), cA, voffA); PG8_STAGE(PG8_SB(0, 1), cB + hstep, voffB); PG8_STAGE(PG8_SA(0, 1), cA + hstep, voffA);
        if (wr == 1) PG8_BAR;
        PG8_WAIT_V(4); PG8_BAR;
        PG8_STAGE(PG8_SB(1, 0), cB + kstep, voffB); PG8_STAGE(PG8_SA(1, 0), cA + kstep, voffA); PG8_STAGE(PG8_SB(1, 1), cB + hstep + kstep, voffB);
        PG8_WAIT_V(6); PG8_BAR;
    }
    for (;;) {
        const bool has_next = S.next(ui + 1, nxt);
        const char* nA = has_next ? (const char*)g.A + (size_t)nxt.pm * tstep + (size_t)nxt.koff * 2 : cA; const char* nB = has_next ? (const char*)g.Bt + (size_t)nxt.e * g.estride + (size_t)nxt.pn * tstep + (size_t)nxt.koff * 2 : cB;
        for (int t = 0; t < nt; t += 2) {
            const bool last = (t == nt - 2);
            const char* a1 = cA + (size_t)(t + 1) * kstep;
            const char* a2 = last ? nA : cA + (size_t)(t + 2) * kstep; const char* b2 = last ? nB : cB + (size_t)(t + 2) * kstep;
            const char* a3 = a2 + kstep; const char* b3 = b2 + kstep;
            if (last && has_next) S.a_ready(nxt);
            if constexpr (SP2) {
            PG8_LDB(B0, 0, 0); PG8_LDB(B1, 0, 1); PG8_SCHED; PG8_LDA(At, 0, 0); PG8_STAGE(PG8_SA(1, 1), a1 + hstep, voffA);
            PG8_WAIT_V(8); PG8_WAIT_L(0); PG8_BAR; PG8_MMA(0, 0, At, B0); PG8_MMA(0, 1, At, B1); PG8_BAR; PG8_SCHED;
            PG8_LDA(At, 0, 1); PG8_STAGE(PG8_SB(0, 0), b2, voffB); PG8_STAGE(PG8_SB(0, 1), b2 + hstep, voffB); PG8_STAGE(PG8_SA(0, 0), a2, voffA);
            PG8_WAIT_V(8); PG8_WAIT_L(0); PG8_BAR; PG8_MMA(1, 0, At, B0); PG8_MMA(1, 1, At, B1); PG8_BAR; PG8_SCHED;
            PG8_LDB(B0, 1, 0); PG8_LDB(B1, 1, 1); PG8_SCHED; PG8_LDA(At, 1, 0); PG8_STAGE(PG8_SA(0, 1), a2 + hstep, voffA);
            PG8_WAIT_V(8); PG8_WAIT_L(0); PG8_BAR; PG8_MMA(0, 0, At, B0); PG8_MMA(0, 1, At, B1); PG8_BAR; PG8_SCHED;
            PG8_LDA(At, 1, 1); PG8_STAGE(PG8_SB(1, 0), b3, voffB); PG8_STAGE(PG8_SB(1, 1), b3 + hstep, voffB); PG8_STAGE(PG8_SA(1, 0), a3, voffA);
            PG8_WAIT_V(8); PG8_WAIT_L(0); PG8_BAR; PG8_MMA(1, 0, At, B0); PG8_MMA(1, 1, At, B1); PG8_BAR; PG8_SCHED;
            } else {
            PG8_LDB(B0, 0, 0); PG8_SCHED; PG8_LDA(At, 0, 0); PG8_STAGE(PG8_SA(1, 1), a1 + hstep, voffA);
            PG8_WAIT_L(8); PG8_BAR; PG8_WAIT_L(0); PG8_MMA(0, 0, At, B0); PG8_BAR; PG8_SCHED;
            PG8_LDB(B1, 0, 1); PG8_STAGE(PG8_SB(0, 0), b2, voffB);
            PG8_BAR; PG8_WAIT_L(0); PG8_MMA(0, 1, At, B1); PG8_BAR;
            PG8_LDA(At, 0, 1); PG8_STAGE(PG8_SA(0, 0), a2, voffA);
            PG8_BAR; PG8_WAIT_L(0); PG8_MMA(1, 0, At, B0); PG8_BAR; PG8_SCHED;
            PG8_STAGE(PG8_SB(0, 1), b2 + hstep, voffB);
            PG8_WAIT_V(6); PG8_BAR; PG8_MMA(1, 1, At, B1); PG8_BAR;
            PG8_LDB(B0, 1, 0); PG8_SCHED; PG8_LDA(At, 1, 0); PG8_STAGE(PG8_SA(0, 1), a2 + hstep, voffA);
            PG8_WAIT_L(8); PG8_BAR; PG8_WAIT_L(0); PG8_MMA(0, 0, At, B0); PG8_BAR; PG8_SCHED;
            PG8_LDB(B1, 1, 1); PG8_STAGE(PG8_SB(1, 0), b3, voffB);
            PG8_BAR; PG8_WAIT_L(0); PG8_MMA(0, 1, At, B1); PG8_BAR;
            PG8_LDA(At, 1, 1); PG8_STAGE(PG8_SA(1, 0), a3, voffA);
            PG8_BAR; PG8_WAIT_L(0); PG8_MMA(1, 0, At, B0); PG8_BAR; PG8_SCHED;
            PG8_STAGE(PG8_SB(1, 1), b3 + hstep, voffB);
            PG8_WAIT_V(6); PG8_BAR; PG8_MMA(1, 1, At, B1); PG8_BAR;
            }
        }
        if constexpr (ALIGN_EPI) { if (wr == 0) PG8_BAR; }
        if constexpr (!Epi::AFTER_DRAIN) { int le_; asm volatile("v_mbcnt_lo_u32_b32 %0, -1, 0\n\tv_mbcnt_hi_u32_b32 %0, -1, %0" : "=v"(le_));
            E(acc, cur, wr, wc, le_ & 15, le_ >> 4); S.done(cur); }
        if (!has_next) break;
#pragma unroll
        for (int a = 0; a < 2; ++a)
#pragma unroll
            for (int b = 0; b < 2; ++b)
#pragma unroll
                for (int m = 0; m < 4; ++m)
#pragma unroll
                    for (int n = 0; n < 2; ++n) acc[a][b][m][n] = (f32x4){0.f, 0.f, 0.f, 0.f};
        cur = nxt; cA = nA; cB = nB; ++ui;
        if constexpr (ALIGN_EPI) { if (wr == 1) PG8_BAR; }
    }
    PG8_WAIT_V(0);
    if constexpr (!ALIGN_EPI) { if (wr == 0) PG8_BAR; }
    PG8_BAR;
    if constexpr (Epi::AFTER_DRAIN) { E.fused(acc, cur, wr, wc, fr, fq, lds, wid, lane); S.done(cur); }
#undef PG8_SA
#undef PG8_SB
#undef PG8_STAGE
#undef PG8_LDA
#undef PG8_LDB
#undef PG8_MMA
#undef PG8_WAIT_V
#undef PG8_WAIT_L
#undef PG8_BAR
#undef PG8_SCHED
}
}

constexpr int NJOBS = 18;
struct Job { const float* src; unsigned long long dst_off; int K, N, Nd, nb, mode, item0; };
struct Args {
    const float* x; const float* c; const float* ctx; const float* cctx;
    const float* w_mod[4]; const float* b_mod[4]; const float* g_mix[4]; const float* g_ffn[4];
    const float* q_gain[4]; const float* k_gain[4]; const float* w_router[4];
    const float* rel_bias; const float* g_dq; const float* g_dkv;
    float* out; unsigned char* ws;
    Job jobs[NJOBS];
    int n_items; int lo; int hi; int pad;
};

struct Frame {
    LAS unsigned char* lds;
    int tid, lane, wave, gw, NGW, wave0;
    unsigned char* ws;
    float* MOD; bf16* X; bf16* H;
};
DI void slab_sum(const float* sl, int S, int lane, f32x4 (&sum)[4]) {
#pragma unroll
    for (int j = 0; j < 4; ++j) sum[j] = (f32x4){0.f, 0.f, 0.f, 0.f};
#pragma unroll 1
    for (int k0 = 0; k0 < S; k0 += 2) { const int k1 = (k0 + 1 < S) ? k0 + 1 : k0; f32x4 t0[4], t1[4];
#pragma unroll
        for (int j = 0; j < 4; ++j) { t0[j] = *(const f32x4*)(sl + (size_t)k0 * 1024 * 1024 + 4 * lane + 256 * j); t1[j] = *(const f32x4*)(sl + (size_t)k1 * 1024 * 1024 + 4 * lane + 256 * j); }
#pragma unroll
        for (int j = 0; j < 4; ++j) { sum[j] += t0[j]; if (k0 + 1 < S) sum[j] += t1[j]; } }
}
DI int lane_id() { int ln; asm volatile("v_mbcnt_lo_u32_b32 %0, -1, 0\n\tv_mbcnt_hi_u32_b32 %0, -1, %0" : "=v"(ln)); return ln; }
DI void refresh(Frame& F) { int w = F.wave0; asm volatile("" : "+s"(w)); int ln = lane_id(); asm volatile("" : "+v"(ln)); F.wave = w; F.lane = ln; F.tid = w * 64 + ln; F.gw = blockIdx.x * 8 + w; }
DI int row_mod_idx(int m) { const int b = m / SB, p = m - b * SB; return p < NCTX ? 4 : b; }

DI void conv_item(const Args& a, Frame& F, LAS float* scr, int item) {
    int j = 0;
#pragma unroll 1
    for (int t = 1; t < NJOBS; ++t) if (item >= a.jobs[t].item0) j = t;
    const Job jb = a.jobs[j];
    const int it = item - jb.item0, nblk = jb.N / 32, kb = it / nblk, nbk = it % nblk;
    const int k0g = 64 * kb, n0 = 32 * nbk, e = k0g / jb.K, k0 = k0g - e * jb.K;
    const float* W = jb.src + (size_t)k0g * jb.N + n0;
    const int lane = F.lane;
    { f32x4 t[8]; const int kr = lane >> 3, n4 = (lane & 7) * 4;
#pragma unroll
      for (int i = 0; i < 8; ++i) t[i] = __builtin_nontemporal_load((const f32x4*)(W + (size_t)(8 * i + kr) * jb.N + n4));
#pragma unroll
      for (int i = 0; i < 8; ++i) { LAS float* d = scr + (8 * i + kr) * 33 + n4; d[0] = t[i].x; d[1] = t[i].y; d[2] = t[i].z; d[3] = t[i].w; } }
    asm volatile("s_waitcnt lgkmcnt(0)" ::: "memory");
    int drow = n0;
    if (jb.mode == 1) { const int Fh = jb.N / 2; if (n0 < Fh) drow = (n0 / 128) * 256 + (n0 % 128); else { const int n1 = n0 - Fh; drow = (n1 / 128) * 256 + 128 + (n1 % 128); } }
    bf16* dst = (bf16*)(a.ws + jb.dst_off) + ((size_t)e * jb.Nd + drow) * jb.K + k0;
    const int c = lane & 7;
#pragma unroll
    for (int jj = 0; jj < 4; ++jj) { const int n = (lane >> 3) + 8 * jj; const LAS float* s = scr + (8 * c) * 33 + n;
        u32x4 o; o.x = pk2(s[0 * 33], s[1 * 33]); o.y = pk2(s[2 * 33], s[3 * 33]); o.z = pk2(s[4 * 33], s[5 * 33]); o.w = pk2(s[6 * 33], s[7 * 33]);
        *(u32x4*)(dst + (size_t)n * jb.K + 8 * c) = o; }
    asm volatile("s_waitcnt lgkmcnt(0)" ::: "memory");
}
DI float silu_f(float v) { return v / (1.f + __expf(-v)); }
DI void p0_prologue(const Args& a, Frame& F) {
    refresh(F);
    LAS float* red = (LAS float*)F.lds;
    LAS float* sil = (LAS float*)(F.lds + 16384);
    for (int t = F.tid; t < 5 * 1024; t += 512) { const int sidx = t >> 10, k = t & 1023; sil[t] = silu_f(sidx < 4 ? a.c[sidx * 1024 + k] : a.cctx[k]); }
    __syncthreads();
    for (int it = blockIdx.x; it < 4 * 96; it += gridDim.x) {
        const int l = it / 96, j0 = (it % 96) * 64;
        const float* wm = a.w_mod[l] + (size_t)(128 * F.wave) * 6144 + j0 + F.lane;
        float acc[5] = {0.f, 0.f, 0.f, 0.f, 0.f};
#pragma unroll 1
        for (int k8 = 0; k8 < 128; k8 += 16) {
            float w[16];
#pragma unroll
            for (int u = 0; u < 16; ++u) w[u] = wm[(size_t)(k8 + u) * 6144];
#pragma unroll
            for (int u = 0; u < 16; ++u) { const int kk = 128 * F.wave + k8 + u;
#pragma unroll
                for (int sidx = 0; sidx < 5; ++sidx) acc[sidx] += sil[sidx * 1024 + kk] * w[u]; }
        }
#pragma unroll
        for (int sidx = 0; sidx < 5; ++sidx) red[(F.wave * 5 + sidx) * 64 + F.lane] = acc[sidx];
        __syncthreads();
        if (F.tid < 320) { const int sidx = F.tid >> 6, ln = F.tid & 63; float t = a.b_mod[l][j0 + ln];
#pragma unroll
            for (int w = 0; w < 8; ++w) t += red[(w * 5 + sidx) * 64 + ln];
            F.MOD[((size_t)l * 5 + sidx) * 6144 + j0 + ln] = t; }
        __syncthreads();
    }
    if (blockIdx.x == 0) {
        float* R64 = (float*)(a.ws + WS_ROPE); float* R32 = R64 + 64 * 16 * 2;
        for (int t = F.tid; t < 64 * 16; t += 512) { const int pos = t >> 4, i = t & 15; const float f = expf(-9.210340371976184f * (float)i / 16.f), ang = (float)pos * f; R64[2 * t] = cosf(ang); R64[2 * t + 1] = sinf(ang); }
        for (int t = F.tid; t < 64 * 8; t += 512) { const int pos = t >> 3, i = t & 7; const float f = expf(-9.210340371976184f * (float)i / 8.f), ang = (float)pos * f; R32[2 * t] = cosf(ang); R32[2 * t + 1] = sinf(ang); }
    }
    if (blockIdx.x == 1 && F.wave < 4) {
        const int l = F.wave, kind = l % 3; const float* qg = a.q_gain[l]; const float* kg = a.k_gain[l];
        float q0 = fabsf(qg[F.lane]), k0 = fabsf(kg[F.lane]), q1 = 0.f, k1 = 0.f, bm = 0.f;
        if (kind == 2 && F.lane < 32) { q1 = fabsf(qg[64 + F.lane]); k1 = fabsf(kg[64 + F.lane]); }
        if (kind == 1) for (int i = F.lane; i < 16 * 465; i += 64) bm = fmaxf(bm, fabsf(a.rel_bias[i]));
        q0 = wave_max(q0); k0 = wave_max(k0); q1 = wave_max(q1); k1 = wave_max(k1); bm = wave_max(bm);
        float bound;
        if (kind == 2) bound = sqrtf(64.f * q0 * q0 + 32.f * q1 * q1) * sqrtf(64.f * k0 * k0 + 32.f * k1 * k1) * C2_96;
        else bound = 64.f * q0 * k0 * C2_64 + bm * LOG2E;
        if (F.lane == 0) ((float*)(a.ws + WS_BOUND))[l] = bound;
    }
    { u32x4* z = (u32x4*)(a.ws + W_IN + (size_t)672 * 1024 * 2); const int n16 = 96 * 1024 * 2 / 16;
      for (int t = blockIdx.x * 512 + F.tid; t < n16; t += gridDim.x * 512) z[t] = (u32x4){0u, 0u, 0u, 0u}; }
    __syncthreads();
    LAS float* scr = (LAS float*)(F.lds + F.wave * 16384);
    for (int it = F.gw; it < a.n_items; it += F.NGW) conv_item(a, F, scr, it);
}

DI void norm_rows(const Args& a, Frame& F, int l, int which  , bool first, bool skip_ctx, int moe_idx, int pendS = 0, int pl = 0, int pg = 0) {
    refresh(F);
    constexpr int UNR = 9;
    const float* gvec = which == 0 ? a.g_mix[l] : a.g_ffn[l];
    f32x4 g[4];
#pragma unroll
    for (int j = 0; j < 4; ++j) g[j] = *(const f32x4*)(gvec + 4 * F.lane + 256 * j);
#pragma unroll 1
    for (int m0 = F.gw; m0 < M; m0 += UNR * F.NGW) {
        f32x4 v[UNR][4]; bool ok[UNR]; int bb[UNR]; bool ic[UNR];
#pragma unroll
        for (int u = 0; u < UNR; ++u) {
            const int m = m0 + u * F.NGW; const int mm = m < M ? m : 0; const int b = mm / SB, p = mm - b * SB; const bool isctx = p < NCTX;
            ok[u] = (m < M) && !(skip_ctx && isctx); bb[u] = b; ic[u] = isctx;
            const float* src = isctx ? a.ctx + ((size_t)b * NCTX + p) * D : a.x + ((size_t)b * SEQ + (p - NCTX)) * D;
#pragma unroll
            for (int j = 0; j < 4; ++j) v[u][j] = !ok[u] ? (f32x4){0.f, 0.f, 0.f, 0.f} : first ? *(const f32x4*)(src + 4 * F.lane + 256 * j) : ldx4(F.X + (size_t)mm * D + 4 * F.lane + 256 * j);
        }
#pragma unroll
        for (int u = 0; u < UNR; ++u) {
            if (!ok[u]) continue;
            const int m = m0 + u * F.NGW;
            if (pendS > 0 && ic[u]) {
                const int crow_ = bb[u] * NCTX + (m - bb[u] * SB); const float* sl = (const float*)(a.ws + WS_SLAB) + (size_t)crow_ * 1024; const float* gt = F.MOD + ((size_t)pl * 5 + 4) * 6144 + pg * 1024;
                f32x4 sum[4]; slab_sum(sl, pendS, F.lane, sum);
#pragma unroll
                for (int j = 0; j < 4; ++j) { v[u][j] += *(const f32x4*)(gt + 4 * F.lane + 256 * j) * sum[j]; stx4(F.X + (size_t)m * D + 4 * F.lane + 256 * j, v[u][j]); }
            }
            float ss = 0.f;
#pragma unroll
            for (int j = 0; j < 4; ++j) ss += (v[u][j].x * v[u][j].x + v[u][j].y * v[u][j].y) + (v[u][j].z * v[u][j].z + v[u][j].w * v[u][j].w);
            if (first) {
#pragma unroll
                for (int j = 0; j < 4; ++j) stx4(F.X + (size_t)m * D + 4 * F.lane + 256 * j, v[u][j]);
            }
            const float rstd = 1.0f / sqrtf(wave_sum(ss) * (1.f / D) + EPS);
            const float* md = F.MOD + ((size_t)l * 5 + (ic[u] ? 4 : bb[u])) * 6144 + (which ? 3072 : 0);
            f32x4 hv[4];
#pragma unroll
            for (int j = 0; j < 4; ++j) { const f32x4 sh = *(const f32x4*)(md + 4 * F.lane + 256 * j), sc = *(const f32x4*)(md + 1024 + 4 * F.lane + 256 * j);
                hv[j] = (v[u][j] * rstd) * g[j] * (1.f + sc) + sh;
                u32x2 o; o.x = pk2(hv[j].x, hv[j].y); o.y = pk2(hv[j].z, hv[j].w);
                *(u32x2*)(F.H + (size_t)m * D + 4 * F.lane + 256 * j) = o; }
        }
    }
}

DI void norm_route_rows(const Args& a, Frame& F, int l, bool skip_ctx, int moe_idx, int pendS) {
    refresh(F);
    constexpr int RPW = 16;
    LAS int* wcnt = (LAS int*)F.lds;
    LAS int* stg = (LAS int*)(F.lds + 256) + F.wave * RPW * 6;
    int brun[8] = {0, 0, 0, 0, 0, 0, 0, 0};
    const float* gvec = a.g_ffn[l];
    f32x4 g[4];
#pragma unroll
    for (int j = 0; j < 4; ++j) g[j] = *(const f32x4*)(gvec + 4 * F.lane + 256 * j);
    f32x4 wr0[4][4], wr1[4][4];
#pragma unroll
    for (int j = 0; j < 4; ++j)
#pragma unroll
        for (int i = 0; i < 4; ++i) { const int k = 4 * F.lane + 256 * j + i; wr0[j][i] = *(const f32x4*)(a.w_router[l] + (size_t)k * 8); wr1[j][i] = *(const f32x4*)(a.w_router[l] + (size_t)k * 8 + 4); }
    unsigned* cnt = (unsigned*)(a.ws + WS_CTL) + CW_CNT + 512 * moe_idx;
#pragma unroll 1
    for (int base = 0; base < M; base += RPW * F.NGW) {
        int cw[8] = {0, 0, 0, 0, 0, 0, 0, 0};
        u32x2 nx[4];
        { const int m1 = base + F.gw; const int mc = m1 < M ? m1 : 0;
#pragma unroll
          for (int j = 0; j < 4; ++j) nx[j] = *(const u32x2*)(F.X + (size_t)mc * D + 4 * F.lane + 256 * j); }
#pragma unroll 1
        for (int i = 0; i < RPW; ++i) {
            const int m = base + i * F.NGW + F.gw; if (m >= M) break;
            const int b = m / SB, p = m - b * SB; const bool isctx = p < NCTX;
            f32x4 v[4]; float ss = 0.f;
#pragma unroll
            for (int j = 0; j < 4; ++j) v[j] = (f32x4){bf2f(nx[j].x & 0xffffu), bf2f(nx[j].x >> 16), bf2f(nx[j].y & 0xffffu), bf2f(nx[j].y >> 16)};
            { const int m2 = m + F.NGW; const int mc = (m2 < M && i + 1 < RPW) ? m2 : m;
#pragma unroll
              for (int j = 0; j < 4; ++j) nx[j] = *(const u32x2*)(F.X + (size_t)mc * D + 4 * F.lane + 256 * j); }
            if (skip_ctx && isctx) { if (F.lane == 0) stg[i * 6] = -1; continue; }
            if (pendS > 0 && isctx) {
                const float* sl = (const float*)(a.ws + WS_SLAB) + (size_t)(b * NCTX + p) * 1024; const float* gt = F.MOD + ((size_t)l * 5 + 4) * 6144 + 2 * 1024;
                f32x4 sum[4]; slab_sum(sl, pendS, F.lane, sum);
#pragma unroll
                for (int j = 0; j < 4; ++j) { v[j] += *(const f32x4*)(gt + 4 * F.lane + 256 * j) * sum[j]; stx4(F.X + (size_t)m * D + 4 * F.lane + 256 * j, v[j]); }
            }
#pragma unroll
            for (int j = 0; j < 4; ++j) ss += (v[j].x * v[j].x + v[j].y * v[j].y) + (v[j].z * v[j].z + v[j].w * v[j].w);
            const float rstd = 1.0f / sqrtf(wave_sum(ss) * (1.f / D) + EPS);
            const float* md = F.MOD + ((size_t)l * 5 + (isctx ? 4 : b)) * 6144 + 3072;
            float lg[8] = {0.f, 0.f, 0.f, 0.f, 0.f, 0.f, 0.f, 0.f};
#pragma unroll
            for (int j = 0; j < 4; ++j) { const f32x4 sh = *(const f32x4*)(md + 4 * F.lane + 256 * j), sc = *(const f32x4*)(md + 1024 + 4 * F.lane + 256 * j);
                const f32x4 hv = (v[j] * rstd) * g[j] * (1.f + sc) + sh;
                u32x2 o; o.x = pk2(hv.x, hv.y); o.y = pk2(hv.z, hv.w);
                *(u32x2*)(F.H + (size_t)m * D + 4 * F.lane + 256 * j) = o;
#pragma unroll
                for (int ii = 0; ii < 4; ++ii) { const float hx = hv[ii]; const f32x4 w0 = wr0[j][ii], w1 = wr1[j][ii];
                    lg[0] += hx * w0.x; lg[1] += hx * w0.y; lg[2] += hx * w0.z; lg[3] += hx * w0.w; lg[4] += hx * w1.x; lg[5] += hx * w1.y; lg[6] += hx * w1.z; lg[7] += hx * w1.w; } }
#pragma unroll
            for (int e = 0; e < 8; ++e) lg[e] = wave_sum(lg[e]);
            int e0 = 0; float v0 = lg[0];
#pragma unroll
            for (int e = 1; e < 8; ++e) if (lg[e] > v0) { v0 = lg[e]; e0 = e; }
            int e1 = -1; float v1 = -INFINITY;
#pragma unroll
            for (int e = 0; e < 8; ++e) if (e != e0 && lg[e] > v1) { v1 = lg[e]; e1 = e; }
            const float ex = __expf(v1 - v0), w0 = 1.f / (1.f + ex), w1 = ex / (1.f + ex);
            int p0 = 0, p1 = 0;
#pragma unroll
            for (int e = 0; e < 8; ++e) { p0 = (e == e0) ? cw[e] : p0; p1 = (e == e1) ? cw[e] : p1; cw[e] += (e == e0) + (e == e1); }
            if (F.lane == 0) { stg[i * 6 + 0] = e0; stg[i * 6 + 1] = e1; stg[i * 6 + 2] = p0; stg[i * 6 + 3] = p1; stg[i * 6 + 4] = __float_as_int(w0); stg[i * 6 + 5] = __float_as_int(w1); }
        }
        if (F.lane == 0) {
#pragma unroll
            for (int e = 0; e < 8; ++e) wcnt[F.wave * 8 + e] = cw[e]; }
        __syncthreads();
        int pre[8];
#pragma unroll
        for (int e = 0; e < 8; ++e) { int pw = 0, tot = 0;
#pragma unroll
            for (int w = 0; w < 8; ++w) { const int c = wcnt[w * 8 + e]; pw += (w < F.wave) ? c : 0; tot += c; }
            pre[e] = brun[e] + pw; brun[e] += tot; }
        if (F.lane < RPW) { const int i = F.lane; const int m = base + i * F.NGW + F.gw;
            if (m < M) { const int e0 = stg[i * 6]; if (e0 >= 0) { const int e1 = stg[i * 6 + 1];
                int b0 = 0, b1 = 0;
#pragma unroll
                for (int e = 0; e < 8; ++e) { b0 = (e == e0) ? pre[e] : b0; b1 = (e == e1) ? pre[e] : b1; }
                int* r = (int*)(a.ws + WS_ROUTE) + (size_t)m * 8;
                r[0] = e0; r[1] = e1; r[2] = stg[i * 6 + 2] + b0; r[3] = stg[i * 6 + 3] + b1; r[4] = stg[i * 6 + 4]; r[5] = stg[i * 6 + 5]; r[6] = (int)blockIdx.x; } } }
        __syncthreads();
    }
    if (F.tid == 0) { int* bc = (int*)(a.ws + WS_BC) + ((size_t)moe_idx * 1024 + blockIdx.x) * 8;
#pragma unroll
        for (int e = 0; e < 8; ++e) { bc[e] = brun[e]; if (brun[e]) atomicAdd(cnt + 64 * e, (unsigned)brun[e]); } }
}


struct MoeOff { int o[9]; };
DI MoeOff moe_offsets(const Args& a, int moe_idx) {
    const unsigned* cnt = (const unsigned*)(a.ws + WS_CTL) + CW_CNT + 512 * moe_idx;
    MoeOff r; r.o[0] = 0;
#pragma unroll
    for (int e = 0; e < 8; ++e) { const int c = (int)__builtin_amdgcn_readfirstlane((int)__hip_atomic_load(cnt + 64 * e, __ATOMIC_RELAXED, __HIP_MEMORY_SCOPE_AGENT)); r.o[e + 1] = r.o[e] + ((c + 255) & ~255); }
    return r;
}
DI int moe_off_of(const MoeOff& mo, int e) { int r = 0;
#pragma unroll
    for (int i = 1; i < 8; ++i) if (e >= i) r = mo.o[i];
    return r; }
DI int moe_expert_of_slot(const MoeOff& mo, int slot) { int e = 0;
#pragma unroll
    for (int i = 1; i < 8; ++i) if (slot >= mo.o[i]) e = i;
    return e; }

DI int moe_split_t0(const MoeOff& mo, int G) { const int nM = mo.o[8] >> 8, rem_tiles = ((4 * nM) % G) >> 2; return (rem_tiles == 0 || rem_tiles > 16) ? nM : nM - rem_tiles; }
DI void moe_gather(const Args& a, Frame& F, int moe_idx, bool skip_ctx) {
    refresh(F);
    const MoeOff mo = moe_offsets(a, moe_idx);
    bf16* HP = (bf16*)(a.ws + WS_HP);
    const int G = gridDim.x, nb = (G + 63) / 64;
    LAS int* raw = (LAS int*)F.lds; LAS int* part = (LAS int*)(F.lds + 32768); LAS int* PB = (LAS int*)(F.lds + 36864);
    { const int* bc = (const int*)(a.ws + WS_BC) + (size_t)moe_idx * 1024 * 8; for (int i = F.tid; i < G * 8; i += 512) raw[i] = bc[i]; }
    __syncthreads();
    { const int e = F.wave; int sl = 0; for (int j = 0; j < nb; ++j) { const int b = F.lane * nb + j; if (b < G) sl += raw[b * 8 + e]; }
      int inc = sl;
#pragma unroll
      for (int d = 1; d < 64; d <<= 1) { const int o = __builtin_amdgcn_ds_bpermute((F.lane - d) << 2, inc); if (F.lane >= d) inc += o; }
      int run = inc - sl;
      for (int j = 0; j < nb; ++j) { const int b = F.lane * nb + j; if (b < G) { PB[b * 8 + e] = run; run += raw[b * 8 + e]; } } }
    (void)part;
    __syncthreads();
    constexpr int UNR = 8;
#pragma unroll 1
    for (int it0 = F.gw; it0 < 2 * M; it0 += UNR * F.NGW) {
        u32x4 d0[UNR], d1[UNR]; int slot[UNR]; bool ok[UNR];
#pragma unroll
        for (int u = 0; u < UNR; ++u) {
            const int it = it0 + u * F.NGW; const int itc = it < 2 * M ? it : 0; const int m = itc >> 1, k = itc & 1; const int p = m % SB;
            ok[u] = (it < 2 * M) && !(skip_ctx && p < NCTX);
            int* r = (int*)(a.ws + WS_ROUTE) + (size_t)m * 8;
            const int e = ok[u] ? r[k] : 0, pos = ok[u] ? r[2 + k] : 0, blk = ok[u] ? r[6] : 0; slot[u] = moe_off_of(mo, e) + PB[blk * 8 + e] + pos;
            if (ok[u] && F.lane == 0) r[2 + k] = slot[u];
            const u32x4* s = (const u32x4*)(F.H + (size_t)m * D);
            d0[u] = s[F.lane]; d1[u] = s[F.lane + 64];
        }
#pragma unroll
        for (int u = 0; u < UNR; ++u) if (ok[u]) { u32x4* d = (u32x4*)(HP + (size_t)slot[u] * D); d[F.lane] = d0[u]; d[F.lane + 64] = d1[u]; }
    }
}
DI void moe_combine(const Args& a, Frame& F, int l, int moe_idx) {
    refresh(F);
    const MoeOff mo = moe_offsets(a, moe_idx);
    const bf16* Y = (const bf16*)(a.ws + WS_HP); const float* SL = (const float*)(a.ws + WS_SLAB2);
    const int T0 = moe_split_t0(mo, (int)gridDim.x); const size_t kst = (size_t)((mo.o[8] >> 8) - T0) * 256 * 1024;
    const bool last = (l == 3);
    constexpr int UNR = 3;
    f32x4 g[4];
#pragma unroll
    for (int j = 0; j < 4; ++j) g[j] = last ? (f32x4){0.f, 0.f, 0.f, 0.f} : *(const f32x4*)(a.g_mix[l + 1] + 4 * F.lane + 256 * j);
#pragma unroll 1
    for (int m0 = F.gw; m0 < M; m0 += UNR * F.NGW) {
        f32x4 y0[UNR][4], y1[UNR][4]; f32x4 xv[UNR][4]; float w0[UNR], w1[UNR]; bool ok[UNR]; int bb[UNR], pp[UNR];
#pragma unroll
        for (int u = 0; u < UNR; ++u) {
            const int m = m0 + u * F.NGW; const int mm = m < M ? m : 0; const int b = mm / SB, p = mm - b * SB; const bool isctx = p < NCTX;
            ok[u] = (m < M) && !(last && isctx); bb[u] = b; pp[u] = p;
            const int* r = (const int*)(a.ws + WS_ROUTE) + (size_t)mm * 8;
            const int e0 = ok[u] ? r[0] : 0, e1 = ok[u] ? r[1] : 0, q0 = ok[u] ? r[2] : 0, q1 = ok[u] ? r[3] : 0;
            const int s0 = q0, s1 = q1; (void)e0; (void)e1; w0[u] = __int_as_float(r[4]); w1[u] = __int_as_float(r[5]);
#pragma unroll
            for (int j = 0; j < 4; ++j) { const int col = 4 * F.lane + 256 * j;
                y0[u][j] = ldx4(Y + (size_t)s0 * D + col); y1[u][j] = ldx4(Y + (size_t)s1 * D + col); xv[u][j] = ldx4(F.X + (size_t)mm * D + col); }
            if ((s0 >> 8) >= T0 || (s1 >> 8) >= T0) {
#pragma unroll
              for (int j = 0; j < 4; ++j) { const int col = 4 * F.lane + 256 * j;
                if ((s0 >> 8) >= T0) { const float* sp = SL + (size_t)(s0 - T0 * 256) * 1024 + col; y0[u][j] = (*(const f32x4*)sp + *(const f32x4*)(sp + kst)) + (*(const f32x4*)(sp + 2 * kst) + *(const f32x4*)(sp + 3 * kst)); y0[u][j] = (f32x4){bf2f(f2bf(y0[u][j].x)), bf2f(f2bf(y0[u][j].y)), bf2f(f2bf(y0[u][j].z)), bf2f(f2bf(y0[u][j].w))}; }
                if ((s1 >> 8) >= T0) { const float* sp = SL + (size_t)(s1 - T0 * 256) * 1024 + col; y1[u][j] = (*(const f32x4*)sp + *(const f32x4*)(sp + kst)) + (*(const f32x4*)(sp + 2 * kst) + *(const f32x4*)(sp + 3 * kst)); y1[u][j] = (f32x4){bf2f(f2bf(y1[u][j].x)), bf2f(f2bf(y1[u][j].y)), bf2f(f2bf(y1[u][j].z)), bf2f(f2bf(y1[u][j].w))}; } } }
        }
#pragma unroll
        for (int u = 0; u < UNR; ++u) {
            if (!ok[u]) continue;
            const int m = m0 + u * F.NGW; const int b = bb[u], p = pp[u]; const bool isctx = p < NCTX;
            const float* md = F.MOD + ((size_t)l * 5 + (isctx ? 4 : b)) * 6144 + 5 * 1024;
            f32x4 v[4]; float ss = 0.f;
#pragma unroll
            for (int j = 0; j < 4; ++j) { const int col = 4 * F.lane + 256 * j; const f32x4 g2 = *(const f32x4*)(md + col);
                const f32x4 f = w0[u] * y0[u][j] + w1[u] * y1[u][j];
                v[j] = xv[u][j] + g2 * f; ss += (v[j].x * v[j].x + v[j].y * v[j].y) + (v[j].z * v[j].z + v[j].w * v[j].w); }
            if (last) {
                float* o = a.out + ((size_t)b * SEQ + (p - NCTX)) * D;
#pragma unroll
                for (int j = 0; j < 4; ++j) *(f32x4*)(o + 4 * F.lane + 256 * j) = v[j];
            } else {
#pragma unroll
                for (int j = 0; j < 4; ++j) stx4(F.X + (size_t)m * D + 4 * F.lane + 256 * j, v[j]);
                const float rstd = 1.0f / sqrtf(wave_sum(ss) * (1.f / D) + EPS);
                const float* md2 = F.MOD + ((size_t)(l + 1) * 5 + (isctx ? 4 : b)) * 6144;
#pragma unroll
                for (int j = 0; j < 4; ++j) { const f32x4 sh = *(const f32x4*)(md2 + 4 * F.lane + 256 * j), sc = *(const f32x4*)(md2 + 1024 + 4 * F.lane + 256 * j);
                    const f32x4 hv = (v[j] * rstd) * g[j] * (1.f + sc) + sh; u32x2 o; o.x = pk2(hv.x, hv.y); o.y = pk2(hv.z, hv.w);
                    *(u32x2*)(F.H + (size_t)m * D + 4 * F.lane + 256 * j) = o; }
            }
        }
    }
}

DI void load16(const bf16* p, float* v) { const u32x4 a = *(const u32x4*)p, b = *(const u32x4*)(p + 8); unpack8(a, v); unpack8(b, v + 8); }
DI void store16(bf16* p, const float* v) { *(u32x4*)p = pack8(v); *(u32x4*)(p + 8) = pack8(v + 8); }
DI void rms64_gain(float* v, const float* gain, int part) {
    float ss = 0.f;
#pragma unroll
    for (int i = 0; i < 16; ++i) ss += v[i] * v[i];
    ss += swz_xor<1>(ss); ss += swz_xor<2>(ss);
    const float r = 1.0f / sqrtf(ss * (1.f / 64.f) + EPS);
#pragma unroll
    for (int i = 0; i < 16; ++i) v[i] = v[i] * r * gain[part * 16 + i];
}
DI void rope64(float* v, const float* R64, int part, int gr, int gc) {
    const int pos = part < 2 ? gr : gc; const float* cs = R64 + pos * 32;
#pragma unroll
    for (int i = 0; i < 16; ++i) { const float other = swz_xor<1>(v[i]); const float c = cs[2 * i], s = cs[2 * i + 1];
        v[i] = (part & 1) ? (other * s + v[i] * c) : (v[i] * c - other * s); }
}
DI void rms32_rope(float* v, const float* gain  , int part, bool do_rope, const float* R32, int gr, int gc) {
    float ss = 0.f;
#pragma unroll
    for (int i = 0; i < 16; ++i) ss += v[i] * v[i];
    ss += swz_xor<1>(ss);
    const float r = 1.0f / sqrtf(ss * (1.f / 32.f) + EPS);
#pragma unroll
    for (int i = 0; i < 16; ++i) v[i] = v[i] * r * gain[part * 16 + i];
    if (do_rope) { const int pos = part == 0 ? gr : gc; const float* cs = R32 + pos * 16;
#pragma unroll
        for (int i = 0; i < 8; ++i) { const float c = cs[2 * i], s = cs[2 * i + 1]; const float x1 = v[i], x2 = v[i + 8]; v[i] = x1 * c - x2 * s; v[i + 8] = x1 * s + x2 * c; } }
}
DI void unpack16(const u32x4 a, const u32x4 b, float* v) { unpack8(a, v); unpack8(b, v + 8); }
DI void prep_rows(const Args& a, Frame& F, int l, int kind, const bool full) {
    refresh(F);
    const float* R64 = (const float*)(a.ws + WS_ROPE); const float* R32 = R64 + 64 * 16 * 2;
    const float* qg = a.q_gain[l]; const float* kg = a.k_gain[l];
    bf16* QB = (bf16*)(a.ws + WS_QB); bf16* KB = (bf16*)(a.ws + WS_KB); bf16* VB = (bf16*)(a.ws + WS_VB);
    const int lane = F.lane, part = lane & 3;
    constexpr int UNR = 3;
#pragma unroll 1
    for (int m0 = F.gw; m0 < M; m0 += UNR * F.NGW) {
        u32x4 r0[UNR][2], r1[UNR][2], r2[UNR][2], r3[UNR][2], r4[UNR][2];
#pragma unroll
        for (int u = 0; u < UNR; ++u) {
            const int m = (m0 + u * F.NGW) < M ? (m0 + u * F.NGW) : 0;
            if (kind == 0) {
                const bf16* raw = (const bf16*)(a.ws + WS_RAW) + (size_t)m * 1536; const int l16 = lane & 15;
                if (full) { r0[u][0] = *(const u32x4*)(raw + lane * 16); r0[u][1] = *(const u32x4*)(raw + lane * 16 + 8); r2[u][0] = *(const u32x4*)(raw + 1280 + l16 * 16); r2[u][1] = *(const u32x4*)(raw + 1280 + l16 * 16 + 8); }
                r1[u][0] = *(const u32x4*)(raw + 1024 + l16 * 16); r1[u][1] = *(const u32x4*)(raw + 1024 + l16 * 16 + 8);
            } else if (kind == 1) {
                const bf16* raw = (const bf16*)(a.ws + WS_RAW) + (size_t)m * 3072;
                if (full) { r0[u][0] = *(const u32x4*)(raw + lane * 16); r0[u][1] = *(const u32x4*)(raw + lane * 16 + 8); r2[u][0] = *(const u32x4*)(raw + 2048 + lane * 16); r2[u][1] = *(const u32x4*)(raw + 2048 + lane * 16 + 8); }
                r1[u][0] = *(const u32x4*)(raw + 1024 + lane * 16); r1[u][1] = *(const u32x4*)(raw + 1024 + lane * 16 + 8);
            } else {
                const bf16* qraw = (const bf16*)(a.ws + RAW_Q) + (size_t)m * 1536; const bf16* kvraw = (const bf16*)(a.ws + RAW_KV) + (size_t)m * 2048; const bf16* rin = (const bf16*)(a.ws + RAW_IN) + (size_t)m * 768;
                const int h = lane >> 2, h2 = (lane >> 1) & 15, p2 = lane & 1;
                if (full) { r0[u][0] = *(const u32x4*)(qraw + h * 96 + part * 16); r0[u][1] = *(const u32x4*)(qraw + h * 96 + part * 16 + 8);
                    r1[u][0] = *(const u32x4*)(qraw + h2 * 96 + 64 + p2 * 16); r1[u][1] = *(const u32x4*)(qraw + h2 * 96 + 64 + p2 * 16 + 8);
                    r3[u][0] = *(const u32x4*)(kvraw + h * 128 + 64 + part * 16); r3[u][1] = *(const u32x4*)(kvraw + h * 128 + 64 + part * 16 + 8); }
                r2[u][0] = *(const u32x4*)(kvraw + h * 128 + part * 16); r2[u][1] = *(const u32x4*)(kvraw + h * 128 + part * 16 + 8);
                r4[u][0] = *(const u32x4*)(rin + 640 + p2 * 16); r4[u][1] = *(const u32x4*)(rin + 640 + p2 * 16 + 8);
            }
        }
#pragma unroll
        for (int u = 0; u < UNR; ++u) {
            const int m = m0 + u * F.NGW; if (m >= M) continue;
            const int p = m % SB; const bool isctx = p < NCTX; const int t = isctx ? 0 : p - NCTX; const int gr = t >> 6, gc = t & 63;
            float v[16];
            if (kind == 0) {
                const int l16 = lane & 15;
                if (full) { unpack16(r0[u][0], r0[u][1], v); rms64_gain(v, qg, part); if (!isctx) rope64(v, R64, part, gr, gc);
#pragma unroll
                    for (int i = 0; i < 16; ++i) v[i] *= C2_64;
                    store16(QB + (size_t)m * 1024 + lane * 16, v); }
                unpack16(r1[u][0], r1[u][1], v); rms64_gain(v, kg, part); if (!isctx) rope64(v, R64, part, gr, gc);
                if (lane < 16) store16(KB + (size_t)m * 256 + l16 * 16, v);
                if (full && lane >= 16 && lane < 32) { u32x4* d = (u32x4*)(VB + (size_t)m * 256 + l16 * 16); d[0] = r2[u][0]; d[1] = r2[u][1]; }
            } else if (kind == 1) {
                if (full) { unpack16(r0[u][0], r0[u][1], v); rms64_gain(v, qg, part);
#pragma unroll
                    for (int i = 0; i < 16; ++i) v[i] *= C2_64;
                    store16(QB + (size_t)m * 1024 + lane * 16, v); }
                unpack16(r1[u][0], r1[u][1], v); rms64_gain(v, kg, part); store16(KB + (size_t)m * 1024 + lane * 16, v);
                if (full) { u32x4* d = (u32x4*)(VB + (size_t)m * 1024 + lane * 16); d[0] = r2[u][0]; d[1] = r2[u][1]; }
            } else {
                const int h = lane >> 2, h2 = (lane >> 1) & 15, p2 = lane & 1;
                if (full) { unpack16(r0[u][0], r0[u][1], v); rms64_gain(v, qg, part);
#pragma unroll
                    for (int i = 0; i < 16; ++i) v[i] *= C2_96;
                    store16(QB + (size_t)m * 1536 + h * 96 + part * 16, v);
                    unpack16(r1[u][0], r1[u][1], v); rms32_rope(v, qg + 64, p2, !isctx, R32, gr, gc);
#pragma unroll
                    for (int i = 0; i < 16; ++i) v[i] *= C2_96;
                    if (lane < 32) store16(QB + (size_t)m * 1536 + h2 * 96 + 64 + p2 * 16, v); }
                unpack16(r2[u][0], r2[u][1], v); rms64_gain(v, kg, part); store16(KB + (size_t)m * 1536 + h * 96 + part * 16, v);
                if (full) { u32x4* d = (u32x4*)(VB + (size_t)m * 1024 + h * 64 + part * 16); d[0] = r3[u][0]; d[1] = r3[u][1]; }
                unpack16(r4[u][0], r4[u][1], v); rms32_rope(v, kg + 64, p2, !isctx, R32, gr, gc);
                if (lane < 32) store16(KB + (size_t)m * 1536 + h2 * 96 + 64 + p2 * 16, v);
            }
        }
    }
}
DI void mla_mid(const Args& a, Frame& F) {
    refresh(F);
    const int lane = F.lane;
    constexpr int UNR = 4;
    float gq[6], gk[4];
#pragma unroll
    for (int i = 0; i < 6; ++i) gq[i] = a.g_dq[6 * lane + i];
#pragma unroll
    for (int i = 0; i < 4; ++i) gk[i] = a.g_dkv[4 * lane + i];
#pragma unroll 1
    for (int m0 = F.gw; m0 < M; m0 += UNR * F.NGW) {
        unsigned qw[UNR][3]; u32x2 kw[UNR];
#pragma unroll
        for (int u = 0; u < UNR; ++u) { const int m = (m0 + u * F.NGW) < M ? (m0 + u * F.NGW) : 0; const bf16* rin = (const bf16*)(a.ws + RAW_IN) + (size_t)m * 768;
            const unsigned* q3 = (const unsigned*)(rin + 6 * lane); qw[u][0] = q3[0]; qw[u][1] = q3[1]; qw[u][2] = q3[2]; kw[u] = *(const u32x2*)(rin + 384 + 4 * lane); }
#pragma unroll
        for (int u = 0; u < UNR; ++u) {
            const int m = m0 + u * F.NGW; if (m >= M) continue;
            float q[6]; float ss = 0.f;
#pragma unroll
            for (int i = 0; i < 3; ++i) { q[2 * i] = bf2f(qw[u][i] & 0xffffu); q[2 * i + 1] = bf2f(qw[u][i] >> 16); }
#pragma unroll
            for (int i = 0; i < 6; ++i) ss += q[i] * q[i];
            float r = 1.0f / sqrtf(wave_sum(ss) * (1.f / 384.f) + EPS);
            unsigned* oq = (unsigned*)((bf16*)(a.ws + RAW_CQ) + (size_t)m * 384 + 6 * lane);
#pragma unroll
            for (int i = 0; i < 3; ++i) oq[i] = pk2(q[2 * i] * r * gq[2 * i], q[2 * i + 1] * r * gq[2 * i + 1]);
            float k[4] = {bf2f(kw[u].x & 0xffffu), bf2f(kw[u].x >> 16), bf2f(kw[u].y & 0xffffu), bf2f(kw[u].y >> 16)};
            ss = k[0] * k[0] + k[1] * k[1] + k[2] * k[2] + k[3] * k[3];
            r = 1.0f / sqrtf(wave_sum(ss) * (1.f / 256.f) + EPS);
            u32x2 ok; ok.x = pk2(k[0] * r * gk[0], k[1] * r * gk[1]); ok.y = pk2(k[2] * r * gk[2], k[3] * r * gk[3]);
            *(u32x2*)((bf16*)(a.ws + RAW_CKV) + (size_t)m * 256 + 4 * lane) = ok;
        }
    }
}

DI int crow(int r, int hi) { return (r & 3) + 8 * (r >> 2) + 4 * hi; }

namespace fa {
typedef __attribute__((address_space(3))) const char* lds_cptr;
typedef short v4i16_t __attribute__((ext_vector_type(4)));
typedef short s16x4 __attribute__((ext_vector_type(4)));
DI s16x4 vtr(lds_cptr p) { return __builtin_bit_cast(s16x4, __builtin_amdgcn_ds_read_tr16_b64_v4i16((__attribute__((address_space(3))) v4i16_t*)p)); }
DI unsigned cvtpk(float lo, float hi) { typedef float f2 __attribute__((ext_vector_type(2))); typedef __bf16 b2 __attribute__((ext_vector_type(2))); f2 v = {lo, hi}; b2 b = __builtin_convertvector(v, b2); return __builtin_bit_cast(unsigned, b); }
DI int clampi(int v, int lo, int hi) { return v < lo ? lo : (v > hi ? hi : v); }
#define FA_MFMA(a, b, c) __builtin_amdgcn_mfma_f32_32x32x16_bf16((a), (b), (c), 0, 0, 0)

template <int DK, int KIND>
DI void attn_fast(const Args& a, Frame& F, bool need_ctx) {
    refresh(F);
    constexpr int QP = NHEAD * DK, KP = KIND == 0 ? 256 : NHEAD * DK, VP = KIND == 0 ? 256 : 1024;
    constexpr int KSLOT = 64 * DK * 2, VSLOT = 8192, ND = DK / 16;
    constexpr int L_K = 0, L_V = 3 * KSLOT, L_WS = L_V + 3 * VSLOT, L_BIAS = L_WS + 2048;
    const bf16* QB = (const bf16*)(a.ws + WS_QB); const bf16* KB = (const bf16*)(a.ws + WS_KB); const bf16* VB = (const bf16*)(a.ws + WS_VB); bf16* O = (bf16*)(a.ws + WS_O);
    const int tid = F.tid, lane = F.lane, wid = F.wave, r32 = lane & 31, hi = lane >> 5;
    LAS unsigned char* lds = F.lds;
    LAS float* wsf = (LAS float*)(lds + L_WS) + wid * 64;
    LAS float* biasL = (LAS float*)(lds + L_BIAS);
    const int G = gridDim.x, bx = blockIdx.x; const int vcu = (G % 8 == 0) ? (bx % 8) * (G / 8) + bx / 8 : bx;
    const int nunits = 1024 + (need_ctx ? 64 : 0);
    const lds_cptr kfp = (lds_cptr)lds + L_K + hi * 1024 + r32 * 16;
    const lds_cptr vfp = (lds_cptr)lds + L_V + ((lane >> 4) & 1) * 32 + (lane & 3) * 8 + (4 * hi + ((lane & 15) >> 2)) * 64;
#pragma unroll 1
    for (int u = vcu; u < nunits; u += G) {
        int b, h, qrow0, nt, kr_lo = 0, gr0 = 0; bool isctx;
        if (u < 1024) { const int bh = u >> 4, qb = u & 15; b = bh >> 4; h = bh & 15; qrow0 = b * SB + NCTX + 256 * qb; isctx = false;
            if (KIND == 1) { gr0 = 4 * qb; kr_lo = clampi(gr0 - 4, 0, 56); const int kr_hi = clampi(gr0 - 1, 0, 56) + 7; nt = 4 + kr_hi - kr_lo + 1; } else nt = SB / 64; }
        else { const int j = u - 1024; b = j >> 4; h = j & 15; qrow0 = b * SB; nt = 4; isctx = true; }
        const int kvh = KIND == 0 ? (h >> 2) : h;
        const bf16* Kh = KB + (size_t)b * SB * KP + kvh * DK; const bf16* Vh = VB + (size_t)b * SB * VP + kvh * 64;
        if (KIND == 1 && !isctx) { for (int i = tid; i < 465; i += 512) biasL[i] = a.rel_bias[h * 465 + i] * LOG2E; }
        bf16x8 qr[ND];
        { const bf16* qp = QB + (size_t)(qrow0 + 32 * wid + r32) * QP + h * DK + 8 * hi;
#pragma unroll
          for (int d0 = 0; d0 < ND; ++d0) qr[d0] = *(const bf16x8*)(qp + 16 * d0); }
#define FA_ISSUE(t, slot) do { const int kr_ = 64 * (t) + ((t) >= 4 ? 64 * kr_lo : 0); \
            __builtin_amdgcn_global_load_lds((const unsigned*)(Kh + (size_t)(kr_ + lane) * KP + wid * 8), (LAS unsigned*)(lds + L_K + (slot) * KSLOT + wid * 1024), 16, 0, 0); \
            if (DK == 96) __builtin_amdgcn_global_load_lds((const unsigned*)(Kh + (size_t)(kr_ + lane) * KP + (8 + (wid & 3)) * 8), (LAS unsigned*)(lds + L_K + (slot) * KSLOT + (8 + (wid & 3)) * 1024), 16, 0, 0); \
            __builtin_amdgcn_global_load_lds((const unsigned*)(Vh + (size_t)(kr_ + 16 * (wid & 3) + (lane >> 2)) * VP + (wid >> 2) * 32 + (lane & 3) * 8), (LAS unsigned*)(lds + L_V + (slot) * VSLOT + wid * 1024), 16, 0, 0); } while (0)
        FA_ISSUE(0, 0); FA_ISSUE(1, 1);
        float m_run = -INFINITY, l_run = 0.f; f32x16 o0 = {}, o1 = {};
        int sl_cur = 0, sl_nn = 2;
#pragma unroll 1
        for (int t = 0; t < nt; ++t) {
            if (t + 1 < nt) { if (DK == 96) asm volatile("s_waitcnt vmcnt(3) lgkmcnt(0)" ::: "memory"); else asm volatile("s_waitcnt vmcnt(2) lgkmcnt(0)" ::: "memory"); }
            else asm volatile("s_waitcnt vmcnt(0) lgkmcnt(0)" ::: "memory");
            __builtin_amdgcn_s_barrier(); asm volatile("" ::: "memory");
            if (t + 2 < nt) FA_ISSUE(t + 2, sl_nn);
            bool active = true; int kr = 0, gr = 0;
            if (KIND == 1 && !isctx && t >= 4) { kr = kr_lo + t - 4; gr = gr0 + (wid >> 1); const int r0 = clampi(gr - 4, 0, 56); active = (kr >= r0) && (kr < r0 + 8); }
            if (active) {
                const lds_cptr kp = kfp + sl_cur * KSLOT; const lds_cptr vp = vfp + sl_cur * VSLOT;
                f32x16 s0 = {}, s1 = {};
#pragma unroll
                for (int d0 = 0; d0 < ND; ++d0) { const bf16x8 k0 = *(const __attribute__((address_space(3))) bf16x8*)(kp + d0 * 2048), k1 = *(const __attribute__((address_space(3))) bf16x8*)(kp + d0 * 2048 + 512);
                    s0 = FA_MFMA(k0, qr[d0], s0); s1 = FA_MFMA(k1, qr[d0], s1); }
                if (KIND == 1 && !isctx && t >= 4) {
                    const int gc = (wid & 1) * 32 + r32, c0 = clampi(gc - 8, 0, 48); const LAS float* bl = biasL + (kr - gr + 7) * 31 + 15 - gc;
#pragma unroll
                    for (int r = 0; r < 16; ++r) { const int kc = crow(r, hi);
                        s0[r] = (kc >= c0 && kc < c0 + 16) ? s0[r] + bl[kc] : -INFINITY;
                        s1[r] = (kc + 32 >= c0 && kc + 32 < c0 + 16) ? s1[r] + bl[kc + 32] : -INFINITY; }
                }
                float rm = fmaxf(s0[0], s1[0]);
#pragma unroll
                for (int r = 1; r < 16; ++r) rm = fmaxf(rm, fmaxf(s0[r], s1[r]));
                { auto rr = __builtin_amdgcn_permlane32_swap(__float_as_uint(rm), __float_as_uint(rm), false, false); rm = fmaxf(__uint_as_float(rr[0]), __uint_as_float(rr[1])); }
                const float mn = fmaxf(m_run, rm);
                if (__any(mn > m_run)) {
                    const float al = __builtin_amdgcn_exp2f(m_run - mn); l_run *= al;
                    if (hi == 0) wsf[r32] = al;
#pragma unroll
                    for (int r = 0; r < 16; ++r) { const float f = wsf[crow(r, hi)]; o0[r] *= f; o1[r] *= f; }
                }
                m_run = mn;
                float ps = 0.f;
#pragma unroll
                for (int r = 0; r < 16; ++r) { s0[r] = __builtin_amdgcn_exp2f(s0[r] - mn); s1[r] = __builtin_amdgcn_exp2f(s1[r] - mn); ps += s0[r] + s1[r]; }
                l_run += ps;
                u32x4 pw[4];
#pragma unroll
                for (int i = 0; i < 4; ++i) { pw[0][i] = cvtpk(s0[2 * i], s0[2 * i + 1]); pw[1][i] = cvtpk(s0[8 + 2 * i], s0[8 + 2 * i + 1]); pw[2][i] = cvtpk(s1[2 * i], s1[2 * i + 1]); pw[3][i] = cvtpk(s1[8 + 2 * i], s1[8 + 2 * i + 1]); }
#pragma unroll
                for (int ks = 0; ks < 4; ++ks) {
                    const s16x4 a0 = vtr(vp + ks * 1024), a1 = vtr(vp + ks * 1024 + 512), b0 = vtr(vp + 4096 + ks * 1024), b1 = vtr(vp + 4096 + ks * 1024 + 512);
                    const bf16x8 v0 = {a0[0], a0[1], a0[2], a0[3], a1[0], a1[1], a1[2], a1[3]}, v1 = {b0[0], b0[1], b0[2], b0[3], b1[0], b1[1], b1[2], b1[3]};
                    const bf16x8 pa = __builtin_bit_cast(bf16x8, pw[ks]);
                    o0 = FA_MFMA(pa, v0, o0); o1 = FA_MFMA(pa, v1, o1);
                }
            }
            sl_cur = sl_cur == 2 ? 0 : sl_cur + 1; sl_nn = sl_nn == 2 ? 0 : sl_nn + 1;
        }
        { auto rr = __builtin_amdgcn_permlane32_swap(__float_as_uint(l_run), __float_as_uint(l_run), false, false); l_run = __uint_as_float(rr[0]) + __uint_as_float(rr[1]); }
        if (hi == 0) wsf[32 + r32] = 1.0f / l_run;
        bf16* Ow = O + (size_t)(qrow0 + 32 * wid) * 1024 + h * 64 + r32;
#pragma unroll
        for (int r = 0; r < 16; ++r) { const int q = crow(r, hi); const float il = wsf[32 + q];
            Ow[(size_t)q * 1024] = (bf16)f2bf(o0[r] * il); Ow[(size_t)q * 1024 + 32] = (bf16)f2bf(o1[r] * il); }
        asm volatile("s_waitcnt lgkmcnt(0)" ::: "memory");
        __builtin_amdgcn_s_barrier(); asm volatile("" ::: "memory");
#undef FA_ISSUE
    }
}
#undef FA_MFMA
}


namespace fa2 {
using fa::lds_cptr; using fa::s16x4; using fa::v4i16_t;
#define SBAR() __builtin_amdgcn_sched_barrier(0)
constexpr int NSLOT = 3, SLOTB = 8192;
constexpr int LDS_K = 0, LDS_V = NSLOT * SLOTB, LDS_WS = 2 * NSLOT * SLOTB, LDS_OST = LDS_WS + 8 * 64 * 4, LDS_BIAS = LDS_OST + 8 * 4096, LDS_BYTES = LDS_BIAS + 2048;
DI void glds16(const void* gsrc, unsigned lds_dst) { unsigned keep;
    asm volatile("s_mov_b32 %0, m0\n\ts_mov_b32 m0, %2\n\ts_nop 0\n\tglobal_load_lds_dwordx4 %1, off\n\ts_mov_b32 m0, %0" : "=&s"(keep) : "v"(gsrc), "s"(lds_dst) : "memory"); }
DI void glds16s(const void* sbase, unsigned voff, unsigned lds_dst) { unsigned keep;
    asm volatile("s_mov_b32 %0, m0\n\ts_mov_b32 m0, %3\n\ts_nop 0\n\tglobal_load_lds_dwordx4 %1, %2\n\ts_mov_b32 m0, %0" : "=&s"(keep) : "v"(voff), "s"(sbase), "s"(lds_dst) : "memory"); }
DI float max3f(float a, float b, float c) { float r; asm("v_max3_f32 %0, %1, %2, %3" : "=v"(r) : "v"(a), "v"(b), "v"(c)); return r; }
DI float max2f(float a, float b) { float r; asm("v_max_f32_e32 %0, %1, %2" : "=v"(r) : "v"(a), "v"(b)); return r; }
DI float fadd_s(float a, float b) { float r; asm("v_add_f32_e32 %0, %1, %2" : "=v"(r) : "v"(a), "v"(b)); return r; }
DI float fsub_s(float a, float b) { float r; asm("v_sub_f32_e32 %0, %1, %2" : "=v"(r) : "v"(a), "v"(b)); return r; }
DI unsigned cvtpk_s(float lo, float hi) { return fa::cvtpk(lo, hi); }
#define WAIT_BAR(N) asm volatile("s_waitcnt vmcnt(" #N ") lgkmcnt(0)\n\ts_barrier" ::: "memory")
typedef const __attribute__((address_space(3))) bf16x8* lds_b8p;
DI void qkt(f32x16& p0, f32x16& p1, lds_cptr kb, const bf16x8* qr, const f32x16& negm) {
#pragma unroll
    for (int d0 = 0; d0 < 4; ++d0) {
        const bf16x8 b0 = *(lds_b8p)(kb + d0 * 2048); const bf16x8 b1 = *(lds_b8p)(kb + d0 * 2048 + 512);
        if (d0 == 0) { p0 = __builtin_amdgcn_mfma_f32_32x32x16_bf16(b0, qr[0], negm, 0, 0, 0); p1 = __builtin_amdgcn_mfma_f32_32x32x16_bf16(b1, qr[0], negm, 0, 0, 0); }
        else { p0 = __builtin_amdgcn_mfma_f32_32x32x16_bf16(b0, qr[d0], p0, 0, 0, 0); p1 = __builtin_amdgcn_mfma_f32_32x32x16_bf16(b1, qr[d0], p1, 0, 0, 0); } }
}
DI void kload8(bf16x8* kf, lds_cptr kp) {
    kf[0] = *(lds_b8p)(kp);        kf[1] = *(lds_b8p)(kp + 512);  kf[2] = *(lds_b8p)(kp + 2048); kf[3] = *(lds_b8p)(kp + 2560);
    kf[4] = *(lds_b8p)(kp + 4096); kf[5] = *(lds_b8p)(kp + 4608); kf[6] = *(lds_b8p)(kp + 6144); kf[7] = *(lds_b8p)(kp + 6656);
}
DI void kload2(bf16x8* kf, lds_cptr kp, int j) { kf[2 * j] = *(lds_b8p)(kp + j * 2048); kf[2 * j + 1] = *(lds_b8p)(kp + j * 2048 + 512); }
DI float rowmax(const f32x16& p0, const f32x16& p1) {
    float a = max3f(p0[0], p0[1], p1[0]), b = max3f(p0[2], p0[3], p1[1]); a = max3f(a, p1[2], p1[3]);
#pragma unroll
    for (int r = 4; r < 16; r += 4) { a = max3f(a, p0[r], p0[r + 1]); b = max3f(b, p0[r + 2], p0[r + 3]); a = max3f(a, p1[r], p1[r + 1]); b = max3f(b, p1[r + 2], p1[r + 3]); }
    const float m = max2f(a, b);
    auto rr = __builtin_amdgcn_permlane32_swap(__float_as_uint(m), __float_as_uint(m), false, false);
    return max2f(__uint_as_float(rr[0]), __uint_as_float(rr[1]));
}
DI void pv(f32x16* o, int vb, bf16x8 pa0, bf16x8 pa1, bf16x8 pa2, bf16x8 pa3) {
#pragma unroll
    for (int d0 = 0; d0 < 2; ++d0) { s16x4 lo[4], hi[4];
#pragma unroll
        for (int ks = 0; ks < 4; ++ks) {
            asm volatile("ds_read_b64_tr_b16 %0,%1 offset:%c2" : "=&v"(lo[ks]) : "v"(vb), "i"(d0 * 4096 + ks * 1024) : "memory");
            asm volatile("ds_read_b64_tr_b16 %0,%1 offset:%c2" : "=&v"(hi[ks]) : "v"(vb), "i"(d0 * 4096 + ks * 1024 + 512) : "memory"); }
        asm volatile("s_waitcnt lgkmcnt(0)" ::: "memory"); SBAR();
#define PK(k) (bf16x8){lo[k][0], lo[k][1], lo[k][2], lo[k][3], hi[k][0], hi[k][1], hi[k][2], hi[k][3]}
        o[d0] = __builtin_amdgcn_mfma_f32_32x32x16_bf16(pa0, PK(0), o[d0], 0, 0, 0);
        o[d0] = __builtin_amdgcn_mfma_f32_32x32x16_bf16(pa1, PK(1), o[d0], 0, 0, 0);
        o[d0] = __builtin_amdgcn_mfma_f32_32x32x16_bf16(pa2, PK(2), o[d0], 0, 0, 0);
        o[d0] = __builtin_amdgcn_mfma_f32_32x32x16_bf16(pa3, PK(3), o[d0], 0, 0, 0);
#undef PK
    }
}
DI float partner32(float v, int hi) { auto rr = __builtin_amdgcn_permlane32_swap(__float_as_uint(v), __float_as_uint(v), false, false); return __uint_as_float(hi ? rr[0] : rr[1]); }
DI void qfrag64(bf16x8* qr, const bf16* qp  , const float* qg, const float* R64, bool rope, int gr, int gc, int hi) {
    float v[4][8]; float ss = 0.f;
#pragma unroll
    for (int d0 = 0; d0 < 4; ++d0) { unpack8(*(const u32x4*)(qp + 16 * d0), v[d0]);
#pragma unroll
        for (int j = 0; j < 8; ++j) ss += v[d0][j] * v[d0][j]; }
    ss += partner32(ss, hi);
    const float rs = 1.0f / sqrtf(ss * (1.f / 64.f) + EPS);
#pragma unroll
    for (int d0 = 0; d0 < 4; ++d0)
#pragma unroll
        for (int j = 0; j < 8; ++j) v[d0][j] *= rs * qg[16 * d0 + 8 * hi + j];
    if (rope) { const float* cr = R64 + (gr * 16 + 8 * hi) * 2; const float* cc = R64 + (gc * 16 + 8 * hi) * 2;
#pragma unroll
        for (int j = 0; j < 8; ++j) { float c = cr[2 * j], sn = cr[2 * j + 1], x1 = v[0][j], x2 = v[1][j]; v[0][j] = x1 * c - x2 * sn; v[1][j] = x1 * sn + x2 * c;
            c = cc[2 * j]; sn = cc[2 * j + 1]; x1 = v[2][j]; x2 = v[3][j]; v[2][j] = x1 * c - x2 * sn; v[3][j] = x1 * sn + x2 * c; } }
#pragma unroll
    for (int d0 = 0; d0 < 4; ++d0) { float t8[8];
#pragma unroll
        for (int j = 0; j < 8; ++j) t8[j] = v[d0][j] * C2_64;
        qr[d0] = __builtin_bit_cast(bf16x8, pack8(t8)); }
}
DI void qfrag96(bf16x8* qr, const bf16* qp  , const float* qg, const float* R32, bool rope, int gr, int gc, int hi) {
    float v[6][8]; float sn_ = 0.f, sr_ = 0.f;
#pragma unroll
    for (int d0 = 0; d0 < 6; ++d0) { unpack8(*(const u32x4*)(qp + 16 * d0), v[d0]);
#pragma unroll
        for (int j = 0; j < 8; ++j) { if (d0 < 4) sn_ += v[d0][j] * v[d0][j]; else sr_ += v[d0][j] * v[d0][j]; } }
    sn_ += partner32(sn_, hi); sr_ += partner32(sr_, hi);
    const float rn = 1.0f / sqrtf(sn_ * (1.f / 64.f) + EPS), rr = 1.0f / sqrtf(sr_ * (1.f / 32.f) + EPS);
#pragma unroll
    for (int d0 = 0; d0 < 6; ++d0)
#pragma unroll
        for (int j = 0; j < 8; ++j) v[d0][j] *= (d0 < 4 ? rn : rr) * qg[16 * d0 + 8 * hi + j];
    if (rope) {
#pragma unroll
        for (int blk = 4; blk < 6; ++blk) { const float* cs = R32 + ((blk == 4 ? gr : gc) * 8) * 2;
#pragma unroll
            for (int j = 0; j < 8; ++j) { const float other = partner32(v[blk][j], hi), c = cs[2 * j], sn = cs[2 * j + 1];
                v[blk][j] = hi ? (other * sn + v[blk][j] * c) : (v[blk][j] * c - other * sn); } } }
#pragma unroll
    for (int d0 = 0; d0 < 6; ++d0) { float t8[8];
#pragma unroll
        for (int j = 0; j < 8; ++j) t8[j] = v[d0][j] * C2_96;
        qr[d0] = __builtin_bit_cast(bf16x8, pack8(t8)); }
}
DI void nat_mask(f32x16& p0, f32x16& p1, int kr, int gr, int gc, int hi, const LAS float* biasL) {
    const int r0 = fa::clampi(gr - 4, 0, 56); const bool row_ok = (kr >= r0) && (kr < r0 + 8);
    if (!row_ok) {
#pragma unroll
        for (int r = 0; r < 16; ++r) { p0[r] = -INFINITY; p1[r] = -INFINITY; }
        return;
    }
    const int c0 = fa::clampi(gc - 8, 0, 48);
    const LAS float* bl = biasL + (kr - gr + 7) * 31 + 15 - gc + 4 * hi;
    const unsigned d0 = (unsigned)(4 * hi - c0);
#pragma unroll
    for (int r = 0; r < 16; ++r) { const int kq = (r & 3) + 8 * (r >> 2);
        const float b0 = bl[kq], b1 = bl[kq + 32];
        p0[r] = (d0 + (unsigned)kq < 16u) ? p0[r] + b0 : -INFINITY;
        p1[r] = (d0 + (unsigned)(kq + 32) < 16u) ? p1[r] + b1 : -INFINITY; }
}

template <int KIND, int QP, int KP, int VP>
DI void attn_unit(const bf16* Qw, const bf16* Kh, const bf16* Vh, bf16* Ow, const int NT, const int nt_real, const int kr_lo, const int gr, LAS unsigned char* shm, const int lane, const int wid,
                  const float* qg, const float* R64, const bool rope_q, const int qt0  ) {
    const int r32 = lane & 31, hi = lane >> 5;
    const unsigned lds0 = (unsigned)(size_t)shm;
    LAS float* wsf = (LAS float*)(shm + LDS_WS) + wid * 64;
    const LAS float* biasL = (const LAS float*)(shm + LDS_BIAS);
    const unsigned koff = (unsigned)(lane * KP + wid * 8) * 2u;
    const unsigned voff = (unsigned)((16 * (wid & 3) + (lane >> 2)) * VP + (wid >> 2) * 32 + (lane & 3) * 8) * 2u;
    const unsigned kdst = lds0 + LDS_K + wid * 1024, vdst = lds0 + LDS_V + wid * 1024;
#define TROW(t) ((KIND == 1) ? (((t) >= nt_real) ? 0 : 64 * (t) + ((t) >= 4 ? 64 * kr_lo : 0)) : 64 * (t))
#define DMA_K(t, slot) glds16s(Kh + (long)TROW(t) * KP, koff, (unsigned)__builtin_amdgcn_readfirstlane(kdst + (slot)))
#define DMA_V(t, slot) glds16s(Vh + (long)TROW(t) * VP, voff, (unsigned)__builtin_amdgcn_readfirstlane(vdst + (slot)))
    bf16x8 kf[8];
    const lds_cptr shm3 = (lds_cptr)shm; const lds_cptr kp0 = shm3 + LDS_K + hi * 1024 + r32 * 16; const lds_cptr vp0 = shm3 + LDS_V + ((lane >> 4) & 1) * 32 + (lane & 3) * 8 + (4 * hi + ((lane & 15) >> 2)) * 64;
    DMA_K(0, 0); DMA_V(0, 0); DMA_K(1, SLOTB);
    bf16x8 qr[4];
#pragma unroll
    for (int d0 = 0; d0 < 4; ++d0) qr[d0] = bf16x8{};
    qfrag64(qr, Qw + (long)r32 * QP + hi * 8, qg, R64, rope_q, (qt0 + r32) >> 6, (qt0 + r32) & 63, hi);
    float l_reg = 0.f; f32x16 o[2]; o[0] = f32x16{}; o[1] = f32x16{}; const f32x16 zero16 = f32x16{};
    const int gc = (wid & 1) * 32 + r32;
#define CMASK(P0, P1, t) do { if (KIND == 1 && (t) >= 4) nat_mask(P0, P1, ((t) < nt_real) ? kr_lo + (t) - 4 : -100, gr, gc, hi, biasL); } while (0)
    f32x16 pA0, pA1, pB0, pB1;
    int sl_prev = 0, sl_cur = 0, sl_next = SLOTB;
#define ROT() do { sl_prev = sl_cur; sl_cur = sl_next; sl_next = (sl_next == (NSLOT - 1) * SLOTB) ? 0 : sl_next + SLOTB; } while (0)
    DMA_K(2, 2 * SLOTB);
    WAIT_BAR(3);
    qkt(pA0, pA1, kp0, qr, zero16); asm volatile("s_nop 15\n\ts_nop 7" : "+v"(pA0), "+v"(pA1));
    _Pragma("unroll") for (int r = 0; r < 16; ++r) { pA0[r] = __builtin_amdgcn_exp2f(pA0[r]); pA1[r] = __builtin_amdgcn_exp2f(pA1[r]); }
    WAIT_BAR(0);
    DMA_K(3, 0); DMA_V(1, SLOTB);
    ROT();
    kload8(kf, kp0 + sl_cur);
    WAIT_BAR(2);
    s16x4 vlo[8], vhi[8]; u32x4 pw0, pw1, pw2, pw3;
#define PKW(P, B) cvtpk_s(P[B], P[B + 1])
#define PAF(k) __builtin_bit_cast(bf16x8, pw##k)
#define VFR(i) (bf16x8){vlo[i][0], vlo[i][1], vlo[i][2], vlo[i][3], vhi[i][0], vhi[i][1], vhi[i][2], vhi[i][3]}
#define PIN(x) asm volatile("" : "+v"(x))
#define GAPA(MF, A0, A1, A2, A3, W0, W1, PW) do { MF; sacc += A0; sacc += A1; sacc += A2; sacc += A3; PIN(sacc); W0; W1; PIN(PW); SBAR(); } while (0)
#define EX(v) __builtin_amdgcn_exp2f(v)
#define GAPB(MF, X, B) do { MF; X[B] = EX(X[B]); X[B + 1] = EX(X[B + 1]); X[B + 2] = EX(X[B + 2]); X[B + 3] = EX(X[B + 3]); PIN(X); SBAR(); } while (0)
#define VRD(i) do { vlo[i] = fa::vtr(vp_ + (((i) >> 2) * 4096 + ((i) & 3) * 1024)); vhi[i] = fa::vtr(vp_ + (((i) >> 2) * 4096 + ((i) & 3) * 1024 + 512)); } while (0)
#define KRD(G, j) do { if (G) { kload2(kf, kp0 + sl_next, j); SBAR(); } } while (0)
#define STEP(C0, C1, P0, P1, t, GK, GV, GL) do { SBAR(); \
    const lds_cptr vp_ = vp0 + sl_prev; \
    VRD(0); SBAR(); float sacc = (P0[0] + P0[1]); \
    GAPA(C0 = __builtin_amdgcn_mfma_f32_32x32x16_bf16(kf[0], qr[0], zero16, 0, 0, 0), P0[2], P0[3], P0[4], P0[5],     pw0[0] = PKW(P0, 0), pw0[1] = PKW(P0, 2), pw0); \
    VRD(4); SBAR(); GAPA(C1 = __builtin_amdgcn_mfma_f32_32x32x16_bf16(kf[1], qr[0], zero16, 0, 0, 0), P0[6], P0[7], P0[8], P0[9],     pw0[2] = PKW(P0, 4), pw0[3] = PKW(P0, 6), pw0); \
    VRD(1); SBAR(); GAPA(C0 = __builtin_amdgcn_mfma_f32_32x32x16_bf16(kf[2], qr[1], C0, 0, 0, 0),   P0[10], P0[11], P0[12], P0[13], pw1[0] = PKW(P0, 8), pw1[1] = PKW(P0, 10), pw1); \
    VRD(5); SBAR(); GAPA(C1 = __builtin_amdgcn_mfma_f32_32x32x16_bf16(kf[3], qr[1], C1, 0, 0, 0),   P0[14], P0[15], P1[0], P1[1],   pw1[2] = PKW(P0, 12), pw1[3] = PKW(P0, 14), pw1); \
    VRD(2); SBAR(); GAPA(C0 = __builtin_amdgcn_mfma_f32_32x32x16_bf16(kf[4], qr[2], C0, 0, 0, 0),   P1[2], P1[3], P1[4], P1[5],     pw2[0] = PKW(P1, 0), pw2[1] = PKW(P1, 2), pw2); \
    VRD(6); SBAR(); GAPA(C1 = __builtin_amdgcn_mfma_f32_32x32x16_bf16(kf[5], qr[2], C1, 0, 0, 0),   P1[6], P1[7], P1[8], P1[9],     pw2[2] = PKW(P1, 4), pw2[3] = PKW(P1, 6), pw2); \
    VRD(3); SBAR(); GAPA(C0 = __builtin_amdgcn_mfma_f32_32x32x16_bf16(kf[6], qr[3], C0, 0, 0, 0),   P1[10], P1[11], P1[12], P1[13], pw3[0] = PKW(P1, 8), pw3[1] = PKW(P1, 10), pw3); \
    VRD(7); SBAR(); GAPA(C1 = __builtin_amdgcn_mfma_f32_32x32x16_bf16(kf[7], qr[3], C1, 0, 0, 0),   P1[14], P1[15], 0.f, 0.f,       pw3[2] = PKW(P1, 12), pw3[3] = PKW(P1, 14), pw3); \
    l_reg += sacc; \
    if (GK) { DMA_K((t) + 3, sl_cur); } if (GV) { DMA_V((t) + 1, sl_next); } \
    CMASK(C0, C1, t); \
    SBAR(); \
    GAPB(o[0] = __builtin_amdgcn_mfma_f32_32x32x16_bf16(PAF(0), VFR(0), o[0], 0, 0, 0), C0, 0); \
    GAPB(o[1] = __builtin_amdgcn_mfma_f32_32x32x16_bf16(PAF(0), VFR(4), o[1], 0, 0, 0), C0, 4); \
    KRD(GL, 0); GAPB(o[0] = __builtin_amdgcn_mfma_f32_32x32x16_bf16(PAF(1), VFR(1), o[0], 0, 0, 0), C0, 8); \
    KRD(GL, 1); GAPB(o[1] = __builtin_amdgcn_mfma_f32_32x32x16_bf16(PAF(1), VFR(5), o[1], 0, 0, 0), C0, 12); \
    KRD(GL, 2); GAPB(o[0] = __builtin_amdgcn_mfma_f32_32x32x16_bf16(PAF(2), VFR(2), o[0], 0, 0, 0), C1, 0); \
    KRD(GL, 3); GAPB(o[1] = __builtin_amdgcn_mfma_f32_32x32x16_bf16(PAF(2), VFR(6), o[1], 0, 0, 0), C1, 4); \
    GAPB(o[0] = __builtin_amdgcn_mfma_f32_32x32x16_bf16(PAF(3), VFR(3), o[0], 0, 0, 0), C1, 8); \
    GAPB(o[1] = __builtin_amdgcn_mfma_f32_32x32x16_bf16(PAF(3), VFR(7), o[1], 0, 0, 0), C1, 12); \
    } while (0)
    int t = 1;
#define ENDW(tt) do { if ((tt) + 3 < NT) { WAIT_BAR(2); } else if ((tt) + 2 < NT) { WAIT_BAR(1); } else { WAIT_BAR(0); } } while (0)
    if (KIND == 0) {
#undef CMASK
#define CMASK(P0, P1, t) do { } while (0)
        for (; t + 5 < NT; t += 2) {
            STEP(pB0, pB1, pA0, pA1, t, true, true, true);     WAIT_BAR(2); ROT();
            STEP(pA0, pA1, pB0, pB1, t + 1, true, true, true); WAIT_BAR(2); ROT();
        }
#undef CMASK
#define CMASK(P0, P1, t) do { if (KIND == 1 && (t) >= 4) nat_mask(P0, P1, ((t) < nt_real) ? kr_lo + (t) - 4 : -100, gr, gc, hi, biasL); } while (0)
    }
    for (; t + 1 < NT; t += 2) {
        STEP(pB0, pB1, pA0, pA1, t, (t + 3 < NT), (t + 1 < NT), (t + 1 < NT));         ENDW(t);     ROT();
        STEP(pA0, pA1, pB0, pB1, t + 1, (t + 4 < NT), (t + 2 < NT), (t + 2 < NT));     ENDW(t + 1); ROT();
    }
    STEP(pB0, pB1, pA0, pA1, NT - 1, false, false, false);
    { float sacc = pB0[0] + pB0[1]; _Pragma("unroll") for (int r = 2; r < 16; ++r) sacc += pB0[r]; _Pragma("unroll") for (int r = 0; r < 16; ++r) sacc += pB1[r]; l_reg += sacc;
      pw0 = (u32x4){PKW(pB0, 0), PKW(pB0, 2), PKW(pB0, 4), PKW(pB0, 6)}; pw1 = (u32x4){PKW(pB0, 8), PKW(pB0, 10), PKW(pB0, 12), PKW(pB0, 14)}; pw2 = (u32x4){PKW(pB1, 0), PKW(pB1, 2), PKW(pB1, 4), PKW(pB1, 6)}; pw3 = (u32x4){PKW(pB1, 8), PKW(pB1, 10), PKW(pB1, 12), PKW(pB1, 14)};
      const int vb0 = (int)(lds0 + LDS_V) + ((lane >> 4) & 1) * 32 + (lane & 3) * 8 + (4 * hi + ((lane & 15) >> 2)) * 64;
      SBAR(); pv(o, vb0 + sl_cur, PAF(0), PAF(1), PAF(2), PAF(3)); }
    { auto rr = __builtin_amdgcn_permlane32_swap(__float_as_uint(l_reg), __float_as_uint(l_reg), false, false); l_reg = __uint_as_float(rr[0]) + __uint_as_float(rr[1]); }
    if (hi == 0) wsf[32 + r32] = l_reg; asm volatile("s_waitcnt lgkmcnt(0)" ::: "memory");
    float rli[16];
#pragma unroll
    for (int r = 0; r < 16; ++r) rli[r] = __builtin_amdgcn_rcpf(wsf[32 + crow(r, hi)]);
    { LAS bf16* stg = (LAS bf16*)(shm + LDS_OST) + wid * 2048;
#pragma unroll
      for (int r = 0; r < 16; ++r) { const int orow = crow(r, hi);
#pragma unroll
          for (int d0 = 0; d0 < 2; ++d0) stg[orow * 64 + d0 * 32 + r32] = (bf16)f2bf(o[d0][r] * rli[r]); }
      asm volatile("s_waitcnt lgkmcnt(0)" ::: "memory");
#pragma unroll
      for (int i = 0; i < 4; ++i) { const int row = i * 8 + (lane >> 3), ch = lane & 7; const u32x4 v = *(const LAS u32x4*)(stg + row * 64 + ch * 8); *(u32x4*)(Ow + (long)row * 1024 + ch * 8) = v; } }
    asm volatile("s_waitcnt lgkmcnt(0)\n\ts_barrier" ::: "memory");
#undef TROW
#undef DMA_K
#undef DMA_V
#undef CMASK
#undef ROT
#undef PKW
#undef PAF
#undef VFR
#undef PIN
#undef GAPA
#undef GAPB
#undef EX
#undef VRD
#undef KRD
#undef STEP
#undef ENDW
}
#undef SBAR
#undef WAIT_BAR

template <int KIND>
DI void attn_phase(const Args& a, Frame& F, bool need_ctx, int l) {
    refresh(F);
    constexpr int KP = KIND == 0 ? 256 : 1024, RP = KIND == 0 ? 1536 : 3072  , VOFF = KIND == 0 ? 1280 : 2048;
    const bf16* RAW = (const bf16*)(a.ws + WS_RAW); const bf16* KB = (const bf16*)(a.ws + WS_KB); bf16* O = (bf16*)(a.ws + WS_O);
    const float* qg = a.q_gain[l]; const float* R64 = (const float*)(a.ws + WS_ROPE);
    const int wid = F.wave;
    LAS unsigned char* lds = F.lds; LAS float* biasL = (LAS float*)(lds + LDS_BIAS);
    const int G = gridDim.x, bx = blockIdx.x; const int vcu = (G % 8 == 0) ? (bx % 8) * (G / 8) + bx / 8 : bx;
    const int nunits = 1024 + (need_ctx ? 64 : 0);
#pragma unroll 1
    for (int u = vcu; u < nunits; u += G) {
        int b, h, qrow0, nt, kr_lo = 0, gr0 = 0, qt0 = 0; bool isctx;
        if (u < 1024) { const int bh = u >> 4, qb = u & 15; b = bh >> 4; h = bh & 15; qrow0 = b * SB + NCTX + 256 * qb; qt0 = 256 * qb + 32 * wid; isctx = false;
            if (KIND == 1) { gr0 = 4 * qb; kr_lo = fa::clampi(gr0 - 4, 0, 56); const int kr_hi = fa::clampi(gr0 - 1, 0, 56) + 7; nt = 4 + kr_hi - kr_lo + 1; } else nt = SB / 64; }
        else { const int j = u - 1024; b = j >> 4; h = j & 15; qrow0 = b * SB; nt = 4; isctx = true; }
        const int kvh = KIND == 0 ? (h >> 2) : h;
        const bf16* Kh = KB + (size_t)b * SB * KP + kvh * 64; const bf16* Vh = RAW + (size_t)b * SB * RP + VOFF + kvh * 64;
        const bf16* Qw = RAW + (size_t)(qrow0 + 32 * wid) * RP + h * 64; bf16* Ow = O + (size_t)(qrow0 + 32 * wid) * 1024 + h * 64;
        const int lane_u = lane_id();
        if (KIND == 1 && !isctx) { const int i = wid * 64 + lane_u; if (i < 465) biasL[i] = a.rel_bias[h * 465 + i] * LOG2E; }
        const int NT = (nt + 1) & ~1;
        if (KIND == 1 && !isctx) attn_unit<1, RP, KP, RP>(Qw, Kh, Vh, Ow, NT, nt, kr_lo, gr0 + (wid >> 1), lds, lane_u, wid, qg, R64, false, 0);
        else attn_unit<0, RP, KP, RP>(Qw, Kh, Vh, Ow, NT, nt, 0, 0, lds, lane_u, wid, qg, R64, KIND == 0 && !isctx, qt0);
    }
}
}


namespace fa2 {
#define SBAR() __builtin_amdgcn_sched_barrier(0)
#define WAIT_BAR(N) asm volatile("s_waitcnt vmcnt(" #N ") lgkmcnt(0)\n\ts_barrier" ::: "memory")
constexpr int SLOTK96 = 12288;
constexpr int L96_K = 0, L96_V = NSLOT * SLOTK96, L96_WS = L96_V + NSLOT * SLOTB, L96_OST = L96_WS + 8 * 64 * 4, L96_BYTES = L96_OST + 8 * 4096;
DI void attn_unit96(const bf16* Qw, const bf16* Kh, const bf16* Vh, bf16* Ow, const int NT, LAS unsigned char* shm, const int lane, const int wid, const float* qg, const float* R32, const bool rope_q, const int qt0) {
    constexpr int QP = 1536, KP = 1536, VP = 2048;
    const int r32 = lane & 31, hi = lane >> 5;
    const unsigned lds0 = (unsigned)(size_t)shm;
    LAS float* wsf = (LAS float*)(shm + L96_WS) + wid * 64;
    const unsigned koff = (unsigned)(lane * KP + wid * 8) * 2u;
    const unsigned voff = (unsigned)((16 * (wid & 3) + (lane >> 2)) * VP + (wid >> 2) * 32 + (lane & 3) * 8) * 2u;
    const int c2d = (8 + (wid & 3) - wid) * 8;
    const unsigned kdst = lds0 + L96_K + wid * 1024, kdst2 = lds0 + L96_K + (8 + (wid & 3)) * 1024, vdst = lds0 + L96_V + wid * 1024;
#define DMA_K(t, si) do { glds16s(Kh + (long)(64 * (t)) * KP, koff, (unsigned)__builtin_amdgcn_readfirstlane(kdst + (si) * SLOTK96)); glds16s(Kh + (long)(64 * (t)) * KP + c2d, koff, (unsigned)__builtin_amdgcn_readfirstlane(kdst2 + (si) * SLOTK96)); } while (0)
#define DMA_V(t, si) glds16s(Vh + (long)(64 * (t)) * VP, voff, (unsigned)__builtin_amdgcn_readfirstlane(vdst + (si) * SLOTB))
    bf16x8 kf[12];
    const lds_cptr shm3 = (lds_cptr)shm; const lds_cptr kp0 = shm3 + L96_K + hi * 1024 + r32 * 16; const lds_cptr vp0 = shm3 + L96_V + ((lane >> 4) & 1) * 32 + (lane & 3) * 8 + (4 * hi + ((lane & 15) >> 2)) * 64;
    DMA_K(0, 0); DMA_V(0, 0); DMA_K(1, 1);
    bf16x8 qr[6];
#pragma unroll
    for (int d0 = 0; d0 < 6; ++d0) qr[d0] = bf16x8{};
    qfrag96(qr, Qw + (long)r32 * QP + hi * 8, qg, R32, rope_q, (qt0 + r32) >> 6, (qt0 + r32) & 63, hi);
    float l_reg = 0.f; f32x16 o[2]; o[0] = f32x16{}; o[1] = f32x16{}; const f32x16 zero16 = f32x16{};
    f32x16 pA0, pA1, pB0, pB1;
    int i_prev = 0, i_cur = 0, i_next = 1;
#define ROT() do { i_prev = i_cur; i_cur = i_next; i_next = (i_next == NSLOT - 1) ? 0 : i_next + 1; } while (0)
    DMA_K(2, 2);
    WAIT_BAR(5);
    { pA0 = zero16; pA1 = zero16;
#pragma unroll
      for (int d0 = 0; d0 < 6; ++d0) { const bf16x8 b0 = *(lds_b8p)(kp0 + d0 * 2048); const bf16x8 b1 = *(lds_b8p)(kp0 + d0 * 2048 + 512);
          pA0 = __builtin_amdgcn_mfma_f32_32x32x16_bf16(b0, qr[d0], pA0, 0, 0, 0); pA1 = __builtin_amdgcn_mfma_f32_32x32x16_bf16(b1, qr[d0], pA1, 0, 0, 0); } }
    asm volatile("s_nop 15\n\ts_nop 7" : "+v"(pA0), "+v"(pA1));
    _Pragma("unroll") for (int r = 0; r < 16; ++r) { pA0[r] = __builtin_amdgcn_exp2f(pA0[r]); pA1[r] = __builtin_amdgcn_exp2f(pA1[r]); }
    WAIT_BAR(0);
    DMA_K(3, 0); DMA_V(1, 1);
    ROT();
    { const lds_cptr kp = kp0 + i_cur * SLOTK96;
#pragma unroll
      for (int j = 0; j < 6; ++j) { kf[2 * j] = *(lds_b8p)(kp + j * 2048); kf[2 * j + 1] = *(lds_b8p)(kp + j * 2048 + 512); } }
    WAIT_BAR(3);
    s16x4 vlo[8], vhi[8]; u32x4 pw0, pw1, pw2, pw3;
#define PKW(P, B) cvtpk_s(P[B], P[B + 1])
#define PAF(k) __builtin_bit_cast(bf16x8, pw##k)
#define VFR(i) (bf16x8){vlo[i][0], vlo[i][1], vlo[i][2], vlo[i][3], vhi[i][0], vhi[i][1], vhi[i][2], vhi[i][3]}
#define PIN(x) asm volatile("" : "+v"(x))
#define GAPA(MF, A0, A1, A2, W0, W1, PW) do { MF; sacc += A0; sacc += A1; sacc += A2; PIN(sacc); W0; W1; PIN(PW); SBAR(); } while (0)
#define GAPN(MF, A0, A1, A2) do { MF; sacc += A0; sacc += A1; sacc += A2; PIN(sacc); SBAR(); } while (0)
#define GAP0(MF) do { MF; SBAR(); } while (0)
#define EX(v) __builtin_amdgcn_exp2f(v)
#define GAPB(MF, X, B) do { MF; X[B] = EX(X[B]); X[B + 1] = EX(X[B + 1]); X[B + 2] = EX(X[B + 2]); X[B + 3] = EX(X[B + 3]); PIN(X); SBAR(); } while (0)
#define VRD(i) do { vlo[i] = fa::vtr(vp_ + (((i) >> 2) * 4096 + ((i) & 3) * 1024)); vhi[i] = fa::vtr(vp_ + (((i) >> 2) * 4096 + ((i) & 3) * 1024 + 512)); } while (0)
#define KRD(G, j) do { if (G) { kload2(kf, kn_, j); SBAR(); } } while (0)
#define MF(C, i, d, CIN) C = __builtin_amdgcn_mfma_f32_32x32x16_bf16(kf[i], qr[d], CIN, 0, 0, 0)
#define STEP(C0, C1, P0, P1, t, GK, GV, GL) do { SBAR(); \
    const lds_cptr vp_ = vp0 + i_prev * SLOTB; const lds_cptr kn_ = kp0 + i_next * SLOTK96; \
    VRD(0); SBAR(); float sacc = (P0[0] + P0[1]); \
    GAPA(MF(C0, 0, 0, zero16), P0[2], P0[3], P0[4],     pw0[0] = PKW(P0, 0), pw0[1] = PKW(P0, 2), pw0); \
    VRD(4); SBAR(); GAPA(MF(C1, 1, 0, zero16), P0[5], P0[6], P0[7],     pw0[2] = PKW(P0, 4), pw0[3] = PKW(P0, 6), pw0); \
    VRD(1); SBAR(); GAPA(MF(C0, 2, 1, C0), P0[8], P0[9], P0[10],   pw1[0] = PKW(P0, 8), pw1[1] = PKW(P0, 10), pw1); \
    VRD(5); SBAR(); GAPA(MF(C1, 3, 1, C1), P0[11], P0[12], P0[13], pw1[2] = PKW(P0, 12), pw1[3] = PKW(P0, 14), pw1); \
    VRD(2); SBAR(); GAPA(MF(C0, 4, 2, C0), P0[14], P0[15], P1[0],  pw2[0] = PKW(P1, 0), pw2[1] = PKW(P1, 2), pw2); \
    VRD(6); SBAR(); GAPA(MF(C1, 5, 2, C1), P1[1], P1[2], P1[3],    pw2[2] = PKW(P1, 4), pw2[3] = PKW(P1, 6), pw2); \
    VRD(3); SBAR(); GAPA(MF(C0, 6, 3, C0), P1[4], P1[5], P1[6],    pw3[0] = PKW(P1, 8), pw3[1] = PKW(P1, 10), pw3); \
    VRD(7); SBAR(); GAPA(MF(C1, 7, 3, C1), P1[7], P1[8], P1[9],    pw3[2] = PKW(P1, 12), pw3[3] = PKW(P1, 14), pw3); \
    GAPN(MF(C0, 8, 4, C0), P1[10], P1[11], P1[12]); \
    GAPN(MF(C1, 9, 4, C1), P1[13], P1[14], P1[15]); \
    GAP0(MF(C0, 10, 5, C0)); \
    GAP0(MF(C1, 11, 5, C1)); \
    l_reg += sacc; \
    if (GK) { DMA_K((t) + 3, i_cur); } if (GV) { DMA_V((t) + 1, i_next); } \
    SBAR(); \
    GAPB(o[0] = __builtin_amdgcn_mfma_f32_32x32x16_bf16(PAF(0), VFR(0), o[0], 0, 0, 0), C0, 0); \
    KRD(GL, 0); GAPB(o[1] = __builtin_amdgcn_mfma_f32_32x32x16_bf16(PAF(0), VFR(4), o[1], 0, 0, 0), C0, 4); \
    KRD(GL, 1); GAPB(o[0] = __builtin_amdgcn_mfma_f32_32x32x16_bf16(PAF(1), VFR(1), o[0], 0, 0, 0), C0, 8); \
    KRD(GL, 2); GAPB(o[1] = __builtin_amdgcn_mfma_f32_32x32x16_bf16(PAF(1), VFR(5), o[1], 0, 0, 0), C0, 12); \
    KRD(GL, 3); GAPB(o[0] = __builtin_amdgcn_mfma_f32_32x32x16_bf16(PAF(2), VFR(2), o[0], 0, 0, 0), C1, 0); \
    KRD(GL, 4); GAPB(o[1] = __builtin_amdgcn_mfma_f32_32x32x16_bf16(PAF(2), VFR(6), o[1], 0, 0, 0), C1, 4); \
    KRD(GL, 5); GAPB(o[0] = __builtin_amdgcn_mfma_f32_32x32x16_bf16(PAF(3), VFR(3), o[0], 0, 0, 0), C1, 8); \
    GAPB(o[1] = __builtin_amdgcn_mfma_f32_32x32x16_bf16(PAF(3), VFR(7), o[1], 0, 0, 0), C1, 12); \
    } while (0)
    int t = 1;
#define ENDW(tt) do { if ((tt) + 3 < NT) { WAIT_BAR(3); } else if ((tt) + 2 < NT) { WAIT_BAR(1); } else { WAIT_BAR(0); } } while (0)
    for (; t + 5 < NT; t += 2) {
        STEP(pB0, pB1, pA0, pA1, t, true, true, true);     WAIT_BAR(3); ROT();
        STEP(pA0, pA1, pB0, pB1, t + 1, true, true, true); WAIT_BAR(3); ROT();
    }
    for (; t + 1 < NT; t += 2) {
        STEP(pB0, pB1, pA0, pA1, t, (t + 3 < NT), (t + 1 < NT), (t + 1 < NT));         ENDW(t);     ROT();
        STEP(pA0, pA1, pB0, pB1, t + 1, (t + 4 < NT), (t + 2 < NT), (t + 2 < NT));     ENDW(t + 1); ROT();
    }
    STEP(pB0, pB1, pA0, pA1, NT - 1, false, false, false);
    { float sacc = pB0[0] + pB0[1]; _Pragma("unroll") for (int r = 2; r < 16; ++r) sacc += pB0[r]; _Pragma("unroll") for (int r = 0; r < 16; ++r) sacc += pB1[r]; l_reg += sacc;
      pw0 = (u32x4){PKW(pB0, 0), PKW(pB0, 2), PKW(pB0, 4), PKW(pB0, 6)}; pw1 = (u32x4){PKW(pB0, 8), PKW(pB0, 10), PKW(pB0, 12), PKW(pB0, 14)}; pw2 = (u32x4){PKW(pB1, 0), PKW(pB1, 2), PKW(pB1, 4), PKW(pB1, 6)}; pw3 = (u32x4){PKW(pB1, 8), PKW(pB1, 10), PKW(pB1, 12), PKW(pB1, 14)};
      const int vb0 = (int)(lds0 + L96_V) + ((lane >> 4) & 1) * 32 + (lane & 3) * 8 + (4 * hi + ((lane & 15) >> 2)) * 64;
      SBAR(); pv(o, vb0 + i_cur * SLOTB, PAF(0), PAF(1), PAF(2), PAF(3)); }
    { auto rr = __builtin_amdgcn_permlane32_swap(__float_as_uint(l_reg), __float_as_uint(l_reg), false, false); l_reg = __uint_as_float(rr[0]) + __uint_as_float(rr[1]); }
    if (hi == 0) wsf[32 + r32] = l_reg; asm volatile("s_waitcnt lgkmcnt(0)" ::: "memory");
    float rli[16];
#pragma unroll
    for (int r = 0; r < 16; ++r) rli[r] = __builtin_amdgcn_rcpf(wsf[32 + crow(r, hi)]);
    { LAS bf16* stg = (LAS bf16*)(shm + L96_OST) + wid * 2048;
#pragma unroll
      for (int r = 0; r < 16; ++r) { const int orow = crow(r, hi);
#pragma unroll
          for (int d0 = 0; d0 < 2; ++d0) stg[orow * 64 + d0 * 32 + r32] = (bf16)f2bf(o[d0][r] * rli[r]); }
      asm volatile("s_waitcnt lgkmcnt(0)" ::: "memory");
#pragma unroll
      for (int i = 0; i < 4; ++i) { const int row = i * 8 + (lane >> 3), ch = lane & 7; const u32x4 v = *(const LAS u32x4*)(stg + row * 64 + ch * 8); *(u32x4*)(Ow + (long)row * 1024 + ch * 8) = v; } }
    asm volatile("s_waitcnt lgkmcnt(0)\n\ts_barrier" ::: "memory");
#undef DMA_K
#undef DMA_V
#undef ROT
#undef PKW
#undef PAF
#undef VFR
#undef PIN
#undef GAPA
#undef GAPN
#undef GAP0
#undef GAPB
#undef EX
#undef VRD
#undef KRD
#undef MF
#undef STEP
#undef ENDW
}
#undef SBAR
#undef WAIT_BAR
DI void attn_phase96(const Args& a, Frame& F, bool need_ctx, int l) {
    refresh(F);
    const bf16* QR = (const bf16*)(a.ws + RAW_Q); const bf16* KB = (const bf16*)(a.ws + WS_KB); const bf16* KV = (const bf16*)(a.ws + RAW_KV); bf16* O = (bf16*)(a.ws + WS_O);
    const float* qg = a.q_gain[l]; const float* R32 = (const float*)(a.ws + WS_ROPE) + 64 * 16 * 2;
    const int wid = F.wave;
    const int G = gridDim.x, bx = blockIdx.x; const int vcu = (G % 8 == 0) ? (bx % 8) * (G / 8) + bx / 8 : bx;
    const int nunits = 1024 + (need_ctx ? 64 : 0);
#pragma unroll 1
    for (int u = vcu; u < nunits; u += G) {
        int b, h, qrow0, nt, qt0 = 0; bool isctx = false;
        if (u < 1024) { const int bh = u >> 4, qb = u & 15; b = bh >> 4; h = bh & 15; qrow0 = b * SB + NCTX + 256 * qb; qt0 = 256 * qb + 32 * wid; nt = SB / 64; }
        else { const int j = u - 1024; b = j >> 4; h = j & 15; qrow0 = b * SB; nt = 4; isctx = true; }
        const bf16* Kh = KB + (size_t)b * SB * 1536 + h * 96; const bf16* Vh = KV + (size_t)b * SB * 2048 + h * 128 + 64;
        const bf16* Qw = QR + (size_t)(qrow0 + 32 * wid) * 1536 + h * 96; bf16* Ow = O + (size_t)(qrow0 + 32 * wid) * 1024 + h * 64;
        const int lane_u = lane_id();
        attn_unit96(Qw, Kh, Vh, Ow, nt, F.lds, lane_u, wid, qg, R32, !isctx, qt0);
    }
}
}

constexpr int LDS_BYTES = 147456;
constexpr int MISC_OFF = 131072 + 320;
enum { PJ_NORM1 = 0, PJ_QKV = 1, PJ_MLAMID = 2, PJ_MLAUP = 3, PJ_PREP = 4, PJ_ATTN = 5, PJ_WO = 6, PJ_NORM2 = 7, PJ_GATHER = 8, PJ_GU = 9, PJ_DOWN = 10, PJ_COMBINE = 11 };
__host__ __device__ constexpr int pid_of(int l, int j) { return 1 + 16 * l + j; }
__host__ __device__ inline bool phase_exists(int l, int j) {
    const int kind = l % 3; const bool moe = (l & 1) != 0;
    switch (j) {
        case PJ_NORM1: return l == 0 || l == 1 || l == 3;
        case PJ_MLAMID: case PJ_MLAUP: return kind == 2;
        case PJ_GATHER: case PJ_COMBINE: return moe;
        case PJ_QKV: case PJ_PREP: case PJ_ATTN: case PJ_WO: case PJ_NORM2: case PJ_GU: case PJ_DOWN: return true;
        default: return false;
    }
}

__global__ void __launch_bounds__(512, 2) fwd_kernel(Args a) {
    extern __shared__ __attribute__((aligned(16))) unsigned char lds_raw[];
    Frame F;
    F.lds = (LAS unsigned char*)lds_raw;
    F.tid = threadIdx.x; F.lane = F.tid & 63; F.wave = __builtin_amdgcn_readfirstlane(F.tid >> 6); F.wave0 = F.wave;
    F.gw = blockIdx.x * 8 + F.wave; F.NGW = gridDim.x * 8;
    F.ws = a.ws; F.MOD = (float*)(a.ws + WS_MOD); F.X = (bf16*)(a.ws + WS_X); F.H = (bf16*)(a.ws + WS_H);
    volatile LAS unsigned* MISC = (volatile LAS unsigned*)(F.lds + MISC_OFF);
    if (F.tid < 32) MISC[F.tid] = 0u;
    __syncthreads();
    const int lo = a.lo, hi = a.hi;
    const bool one_launch = (hi - lo) > 1;
    XcdBarrier bar; bar.bar = (unsigned*)(a.ws + WS_CTL) + CW_BAR; bar.x = 0; bar.st = nullptr;
    if (one_launch) bar = xcd_barrier_post((unsigned*)(a.ws + WS_CTL) + CW_BAR, MISC + 8);
#define IN(k) (lo <= (k) && (k) < hi)
    volatile LAS unsigned long long* TP = (volatile LAS unsigned long long*)(F.lds + MISC_OFF + 64);
    if (PROBE_TMASK && threadIdx.x == 0) { TP[0] = __builtin_amdgcn_s_memrealtime(); TP[1] = 0ull; }
#define SEAM(k) do { if (one_launch && IN(k) && (k) + 1 < hi) { xcd_barrier(bar); } \
        if (PROBE_TMASK && F.wave0 == 0 && lane_id() == 0) { const unsigned long long now_ = __builtin_amdgcn_s_memrealtime(); const int k_ = (k); const bool sel_ = k_ == 0 ? (((PROBE_TMASK) >> 12) & 1) : TSEL((k_ - 1) >> 4, (k_ - 1) & 15); if (sel_) TP[1] = TP[1] + (now_ - TP[0]); TP[0] = now_; } } while (0)

    if (IN(0)) p0_prologue(a, F); SEAM(0);

#pragma unroll 1
    for (int l = 0; l < 4; ++l) {
        const int kind = l % 3; const bool moe = (l & 1) != 0; const bool need_ctx = l < 3; const int moe_idx = l >> 1;
        const int P = 1 + 16 * l;
        if (l != 2) { if (IN(P + PJ_NORM1)) { norm_rows(a, F, l, 0, l == 0, false, 0, (l == 1 || l == 3) ? FF / 256 : 0, l - 1, 5); } SEAM(P + PJ_NORM1); }
        if (IN(P + PJ_QKV)) {
            const int N = kind == 0 ? 1536 : (kind == 1 ? 3072 : 768);
            const bf16* Wt = (const bf16*)(a.ws + (l == 0 ? W_QKV0 : l == 1 ? W_QKV1 : l == 2 ? W_IN : W_QKV3));
            pg8::Gemm g{F.H, Wt, M, N, D, 0, D}; pg8::StaticOrder S; S.init(M, N, (int)gridDim.x, (int)blockIdx.x);
            pg8::EpiQkvK E{(bf16*)(a.ws + WS_RAW), N, kind == 2 ? 0 : 4, kind == 0 ? 5 : (kind == 1 ? 8 : 0), (bf16*)(a.ws + WS_KB), kind == 0 ? 256 : 1024, a.k_gain[l], (const float*)(a.ws + WS_ROPE), kind == 0,
                           (LAS float*)(F.lds + 135168), kind == 2};
            pg8::gemm_phase<pg8::EpiQkvK, pg8::StaticOrder, true, true>(F.lds, g, S, E, F.wave0);
        } SEAM(P + PJ_QKV);
        if (kind == 2) {
            if (IN(P + PJ_MLAMID)) mla_mid(a, F); SEAM(P + PJ_MLAMID);
            if (IN(P + PJ_MLAUP)) {
                { pg8::Gemm g{(const bf16*)(a.ws + RAW_CQ), (const bf16*)(a.ws + W_UQ), M, 1536, QLORA, 0, QLORA}; pg8::StaticOrder S; S.init(M, 1536, (int)gridDim.x, (int)blockIdx.x); pg8::EpiRaw2 E{(bf16*)(a.ws + RAW_Q), 1536};
                  pg8::gemm_phase<pg8::EpiRaw2, pg8::StaticOrder, true, true>(F.lds, g, S, E, F.wave0); }
                { pg8::Gemm g{(const bf16*)(a.ws + RAW_CKV), (const bf16*)(a.ws + W_UKV), M, 2048, KVLORA, 0, KVLORA}; pg8::StaticOrder S; S.init(M, 2048, (int)gridDim.x, (int)((blockIdx.x + 104u) % gridDim.x)); pg8::EpiUkvK E{(bf16*)(a.ws + RAW_KV), 2048, (bf16*)(a.ws + WS_KB), a.k_gain[l], (LAS float*)(F.lds + 135168)};
                  pg8::gemm_phase<pg8::EpiUkvK, pg8::StaticOrder, true, true>(F.lds, g, S, E, F.wave0); }
            } SEAM(P + PJ_MLAUP);
        }
        { const bool full = !(((const float*)(a.ws + WS_BOUND))[l] <= 64.f);
          if (full) { if (IN(P + PJ_PREP)) prep_rows(a, F, l, kind, full); SEAM(P + PJ_PREP); } }
        if (IN(P + PJ_ATTN)) {
            const bool bounded = ((const float*)(a.ws + WS_BOUND))[l] <= 64.f;
            if (kind == 0) { if (bounded) fa2::attn_phase<0>(a, F, need_ctx, l); else fa::attn_fast<64, 0>(a, F, need_ctx); }
            else if (kind == 1) { if (bounded) fa2::attn_phase<1>(a, F, need_ctx, l); else fa::attn_fast<64, 1>(a, F, need_ctx); }
            else { if (bounded) fa2::attn_phase96(a, F, need_ctx, l); else fa::attn_fast<96, 2>(a, F, need_ctx); }
        } SEAM(P + PJ_ATTN);
        if (IN(P + PJ_WO)) {
            pg8::Gemm g{(const bf16*)(a.ws + WS_O), (const bf16*)(a.ws + W_O + (size_t)l * 2 * MiB), M, D, D, 0, D}; pg8::RowOrder S; S.init(true, D, (int)gridDim.x, (int)blockIdx.x); pg8::EpiResG E{F.X, F.MOD, l, 2};
            pg8::gemm_phase<pg8::EpiResG, pg8::RowOrder, true, true>(F.lds, g, S, E, F.wave0);
            if (need_ctx) { pg8::Gemm g2 = g; g2.Kloop = 256; pg8::CtxSplitOrder S2{4, 256, (int)gridDim.x, (int)blockIdx.x}; pg8::EpiSlab E2{(float*)(a.ws + WS_SLAB)};
                pg8::gemm_phase<pg8::EpiSlab, pg8::CtxSplitOrder, true, true>(F.lds, g2, S2, E2, F.wave0); }
        } SEAM(P + PJ_WO);
        if (IN(P + PJ_NORM2)) { if (moe) norm_route_rows(a, F, l, !need_ctx, moe_idx, need_ctx ? 4 : 0); else norm_rows(a, F, l, 1, false, !need_ctx, 0, need_ctx ? 4 : 0, l, 2); } SEAM(P + PJ_NORM2);
        if (!moe) {
            const int di = l >> 1;
            if (IN(P + PJ_GU)) {
                pg8::Gemm g{F.H, (const bf16*)(a.ws + W_GU + (size_t)di * 11 * MiB), M, 2 * FF, D, 0, D}; pg8::StaticOrder S; S.init(M, 2 * FF, (int)gridDim.x, (int)blockIdx.x); pg8::EpiSwiglu E{(bf16*)(a.ws + WS_ACT), FF};
                pg8::gemm_phase<pg8::EpiSwiglu, pg8::StaticOrder, true, true>(F.lds, g, S, E, F.wave0);
            } SEAM(P + PJ_GU);
            if (IN(P + PJ_DOWN)) {
                pg8::Gemm g{(const bf16*)(a.ws + WS_ACT), (const bf16*)(a.ws + W_DN + (size_t)di * 11 * MiB / 2), M, D, FF, 0, FF}; pg8::RowOrder S; S.init(true, D, (int)gridDim.x, (int)blockIdx.x); pg8::EpiResG E{F.X, F.MOD, l, 5};
                pg8::gemm_phase<pg8::EpiResG, pg8::RowOrder, true, true>(F.lds, g, S, E, F.wave0);
                { pg8::Gemm g2 = g; g2.Kloop = 256; pg8::CtxSplitOrder S2{FF / 256, 256, (int)gridDim.x, (int)blockIdx.x}; pg8::EpiSlab E2{(float*)(a.ws + WS_SLAB)};
                  pg8::gemm_phase<pg8::EpiSlab, pg8::CtxSplitOrder, true, true>(F.lds, g2, S2, E2, F.wave0); }
            } SEAM(P + PJ_DOWN);
        } else {
            if (IN(P + PJ_GATHER)) moe_gather(a, F, moe_idx, !need_ctx); SEAM(P + PJ_GATHER);
            if (IN(P + PJ_GU)) {
                const MoeOff mo = moe_offsets(a, moe_idx);
                pg8::Gemm g{(const bf16*)(a.ws + WS_HP), (const bf16*)(a.ws + WE_GU(0) + (size_t)moe_idx * 168 * MiB), mo.o[8], 2 * FFE, D, (size_t)2 * FFE * D * 2, D};
                pg8::MoeOrder S; S.s.init(mo.o[8], 2 * FFE, (int)gridDim.x, (int)blockIdx.x); S.o1 = mo.o[1]; S.o2 = mo.o[2]; S.o3 = mo.o[3]; S.o4 = mo.o[4]; S.o5 = mo.o[5]; S.o6 = mo.o[6]; S.o7 = mo.o[7];
                pg8::EpiSwiglu E{(bf16*)(a.ws + WS_ACT), FFE};
                pg8::gemm_phase<pg8::EpiSwiglu, pg8::MoeOrder, true, true>(F.lds, g, S, E, F.wave0);
            } SEAM(P + PJ_GU);
            if (IN(P + PJ_DOWN)) {
                const MoeOff mo = moe_offsets(a, moe_idx);
                pg8::Gemm g{(const bf16*)(a.ws + WS_ACT), (const bf16*)(a.ws + WE_DN(0) + (size_t)moe_idx * 168 * MiB), mo.o[8], D, FFE, (size_t)D * FFE * 2, FFE};
                const int nM = mo.o[8] >> 8, T0 = moe_split_t0(mo, (int)gridDim.x);
                pg8::MoeOrder S; S.s.init(T0 * 256, D, (int)gridDim.x, (int)blockIdx.x); S.o1 = mo.o[1]; S.o2 = mo.o[2]; S.o3 = mo.o[3]; S.o4 = mo.o[4]; S.o5 = mo.o[5]; S.o6 = mo.o[6]; S.o7 = mo.o[7];
                pg8::EpiRaw2 E{(bf16*)(a.ws + WS_HP), D};
                pg8::gemm_phase<pg8::EpiRaw2, pg8::MoeOrder, true, true>(F.lds, g, S, E, F.wave0);
                if (T0 < nM) { pg8::Gemm g2 = g; g2.Kloop = FFE / 4; pg8::RemSplitOrder S2{T0, nM - T0, FFE / 4, (int)gridDim.x, (int)blockIdx.x, mo.o[1], mo.o[2], mo.o[3], mo.o[4], mo.o[5], mo.o[6], mo.o[7]};
                    pg8::EpiSlab E2{(float*)(a.ws + WS_SLAB2)}; pg8::gemm_phase<pg8::EpiSlab, pg8::RemSplitOrder, true, true>(F.lds, g2, S2, E2, F.wave0); }
            } SEAM(P + PJ_DOWN);
            if (IN(P + PJ_COMBINE)) moe_combine(a, F, l, moe_idx); SEAM(P + PJ_COMBINE);
        }
    }
    if (PROBE_TMASK && blockIdx.x == 0 && F.wave0 == 0 && lane_id() == 0) { const unsigned long long t0 = __builtin_amdgcn_s_memrealtime(), tw = 4ull * TP[1]; while (__builtin_amdgcn_s_memrealtime() - t0 < tw) __builtin_amdgcn_s_sleep(8); }
#undef IN
#undef SEAM
}

extern "C" void kernel_launch(void* const* d_in, const int* in_sizes, int n_in, void* d_out, int out_size, void* d_ws, size_t ws_size, hipStream_t stream) {
    static int grid = 0;
    if (grid == 0) {
        if (n_in != 51 || ws_size < WS_END || out_size != NB * SEQ * D) { fprintf(stderr, "kernel_launch: unexpected problem (n_in %d, ws %zu, out %d)\n", n_in, ws_size, out_size); grid = -1; return; }
        int dev = 0, cus = 0;
        if (hipGetDevice(&dev) != hipSuccess || hipDeviceGetAttribute(&cus, hipDeviceAttributeMultiprocessorCount, dev) != hipSuccess) { grid = -1; return; }
        if (hipFuncSetAttribute((const void*)fwd_kernel, hipFuncAttributeMaxDynamicSharedMemorySize, LDS_BYTES) != hipSuccess) { fprintf(stderr, "kernel_launch: hipFuncSetAttribute failed\n"); grid = -1; return; }
        int per_cu = 0;
        if (hipOccupancyMaxActiveBlocksPerMultiprocessor(&per_cu, (const void*)fwd_kernel, 512, LDS_BYTES) != hipSuccess || per_cu < 1) { fprintf(stderr, "kernel_launch: occupancy query says %d\n", per_cu); }
        (void)hipGetLastError();
        grid = cus;
    }
    if (grid < 0) return;
    (void)hipMemsetAsync((char*)d_ws + WS_CTL, 0, CTL_BYTES, stream);
    Args a{};
    const float* const* in = (const float* const*)d_in;
    a.x = in[0]; a.c = in[1]; a.ctx = in[2]; a.cctx = in[3];
    const int base[4] = {4, 14, 26, 40};
    for (int l = 0; l < 4; ++l) { a.w_mod[l] = in[base[l]]; a.b_mod[l] = in[base[l] + 1]; a.g_mix[l] = in[base[l] + 2]; a.g_ffn[l] = in[base[l] + 3]; a.w_router[l] = nullptr; }
    a.q_gain[0] = in[9]; a.k_gain[0] = in[10]; a.q_gain[1] = in[19]; a.k_gain[1] = in[20]; a.q_gain[2] = in[35]; a.k_gain[2] = in[36]; a.q_gain[3] = in[45]; a.k_gain[3] = in[46];
    a.w_router[1] = in[23]; a.w_router[3] = in[48]; a.rel_bias = in[21]; a.g_dq = in[31]; a.g_dkv = in[32];
    a.out = (float*)d_out; a.ws = (unsigned char*)d_ws;
    int nj = 0, item0 = 0;
    auto job = [&](int idx, size_t off, int K, int N, int Nd, int nb, int mode) { Job& j = a.jobs[nj++]; j.src = in[idx]; j.dst_off = off; j.K = K; j.N = N; j.Nd = Nd; j.nb = nb; j.mode = mode; j.item0 = item0; item0 += (nb * K / 64) * (N / 32); };
    job(8, W_QKV0, 1024, 1536, 1536, 1, 0); job(18, W_QKV1, 1024, 3072, 3072, 1, 0); job(30, W_IN, 1024, 672, 768, 1, 0); job(33, W_UQ, 384, 1536, 1536, 1, 0); job(34, W_UKV, 256, 2048, 2048, 1, 0); job(44, W_QKV3, 1024, 1536, 1536, 1, 0);
    job(11, W_O, 1024, 1024, 1024, 1, 0); job(22, W_O + 2 * MiB, 1024, 1024, 1024, 1, 0); job(37, W_O + 4 * MiB, 1024, 1024, 1024, 1, 0); job(47, W_O + 6 * MiB, 1024, 1024, 1024, 1, 0);
    job(12, W_GU, 1024, 2 * FF, 2 * FF, 1, 1); job(38, W_GU + 11 * MiB, 1024, 2 * FF, 2 * FF, 1, 1); job(13, W_DN, FF, 1024, 1024, 1, 0); job(39, W_DN + 11 * MiB / 2, FF, 1024, 1024, 1, 0);
    job(24, WE_GU(0), 1024, 2 * FFE, 2 * FFE, 8, 1); job(25, WE_DN(0), FFE, 1024, 1024, 8, 0); job(49, WE_GU(1), 1024, 2 * FFE, 2 * FFE, 8, 1); job(50, WE_DN(1), FFE, 1024, 1024, 8, 0);
    a.n_items = item0; a.pad = 0;
#if N_LAUNCH_MODE == 1
    a.lo = 0; a.hi = pid_of(3, PJ_COMBINE) + 1;
    hipLaunchKernelGGL(fwd_kernel, dim3(grid), dim3(512), LDS_BYTES, stream, a);
#else
    a.lo = 0; a.hi = 1;
    hipLaunchKernelGGL(fwd_kernel, dim3(grid), dim3(512), LDS_BYTES, stream, a);
    for (int l = 0; l < 4; ++l) for (int j = 0; j < 12; ++j) if (phase_exists(l, j)) { a.lo = pid_of(l, j); a.hi = a.lo + 1; hipLaunchKernelGGL(fwd_kernel, dim3(grid), dim3(512), LDS_BYTES, stream, a); }
#endif
}
```
